# Optimizing an MI355X kernel written in HIP

```python
import jax
import jax.numpy as jnp
from jax import lax
import numpy as np

D_MODEL = 1024
BATCH = 32
SEQ = 2048
DEPTH = 1

HEAD_DIM = 64
NSA_HEADS = 8
NSA_GROUPS = 2
NSA_CMP_LEN = 32
NSA_CMP_STRIDE = 16
NSA_CMP_HIDDEN = 128
NSA_SLC_LEN = 64
NSA_SLC_TOPN = 16
NSA_WINDOW = 512
DSA_HEADS = 8
IDX_HEADS = 8
IDX_DIM = 64
DSA_TOPK_MAX = 256
D_FF = ((8 * D_MODEL + 3 * 256 - 1) // (3 * 256)) * 256
N_ADA = 6
Q_BLOCK = 128
SLC_Q_BLOCK = 16
RMS_EPS = 1e-6
FORCE_SCORE = 1e9

IN_SIZES = (
    NSA_HEADS * HEAD_DIM,
    NSA_GROUPS * HEAD_DIM,
    NSA_GROUPS * HEAD_DIM,
    NSA_GROUPS * HEAD_DIM,
    NSA_GROUPS * HEAD_DIM,
    NSA_GROUPS * HEAD_DIM,
    NSA_GROUPS * HEAD_DIM,
    NSA_HEADS * 3,
    DSA_HEADS * HEAD_DIM,
    HEAD_DIM,
    HEAD_DIM,
    IDX_HEADS * IDX_DIM,
    IDX_DIM,
    IDX_HEADS,
    D_MODEL,
    D_MODEL,
)
D_IN = sum(IN_SIZES)

kernel_name = 'hybrid_nsa_dsa_gated_block'


def rms_norm(x, g):
    xf = x.astype(jnp.float32)
    y = xf * lax.rsqrt(jnp.mean(xf * xf, axis=-1, keepdims=True) + RMS_EPS)
    return (y * g.astype(jnp.float32)).astype(x.dtype)


def masked_softmax(s, mask):
    s = jnp.where(mask, s.astype(jnp.float32), -jnp.inf)
    m = jnp.max(s, axis=-1, keepdims=True)
    m = jnp.where(jnp.isfinite(m), m, 0.0)
    e = jnp.where(mask, jnp.exp(s - m), 0.0)
    return e / jnp.maximum(jnp.sum(e, axis=-1, keepdims=True), 1e-30)


def alibi_slopes(n_heads):
    return jnp.exp2(-8.0 * jnp.arange(1, n_heads + 1, dtype=jnp.float32) / n_heads)


def block_map(fn, n_rows, block):
    out = lax.map(fn, jnp.arange(n_rows // block))
    out = jnp.moveaxis(out, 0, 1)
    return out.reshape((out.shape[0], n_rows) + out.shape[3:])


def nsa_compress(t, pe, w1, w2):
    b, s, g, hd = t.shape
    n_cmp = (s - NSA_CMP_LEN) // NSA_CMP_STRIDE + 1
    idx = (jnp.arange(n_cmp) * NSA_CMP_STRIDE)[:, None] + jnp.arange(NSA_CMP_LEN)[None, :]
    blk = t[:, idx] + pe[:, None, :].astype(t.dtype)
    blk = jnp.moveaxis(blk, 3, 2).reshape(b, n_cmp, g, NSA_CMP_LEN * hd)
    return jax.nn.silu(blk @ w1) @ w2


def nsa_mixer(q, k_cmp, v_cmp, k_slc, v_slc, k_win, v_win, gates,
              g_q, g_kc, g_ks, g_kw, pe_ck, pe_cv, w_ck1, w_ck2, w_cv1, w_cv2):
    b, s, h, hd = q.shape
    g = k_cmp.shape[2]
    r = h // g
    f32 = jnp.float32
    slopes = alibi_slopes(h).reshape(g, r, 1, 1)
    qg = (rms_norm(q, g_q) * hd ** -0.5).reshape(b, s, g, r, hd)
    pos = jnp.arange(s)

    kc = rms_norm(nsa_compress(k_cmp, pe_ck, w_ck1, w_ck2), g_kc)
    vc = nsa_compress(v_cmp, pe_cv, w_cv1, w_cv2)
    n_cmp = kc.shape[1]
    cmp_start = jnp.arange(n_cmp) * NSA_CMP_STRIDE
    dist_c = (pos[:, None] - (cmp_start + NSA_CMP_LEN - 1)[None, :]).astype(f32)
    s_c = jnp.einsum('bsgrd,bngd->bgrsn', qg, kc).astype(f32) - slopes * dist_c
    p_c = masked_softmax(s_c, dist_c >= 0)
    o_cmp = jnp.einsum('bgrsn,bngd->bsgrd', p_c.astype(vc.dtype), vc)

    n_slc = s // NSA_SLC_LEN
    j = jnp.arange(n_slc)
    overlap = ((cmp_start[:, None] < (j[None, :] + 1) * NSA_SLC_LEN) &
               (cmp_start[:, None] + NSA_CMP_LEN > j[None, :] * NSA_SLC_LEN)).astype(f32)
    imp = jnp.einsum('bgrsn,nj->bgsj', p_c, overlap)
    cur = (pos // NSA_SLC_LEN)[:, None]
    forced = (j[None, :] == 0) | (j[None, :] == cur) | (j[None, :] == cur - 1)
    visible = j[None, :] * NSA_SLC_LEN <= pos[:, None]
    imp = jnp.where(forced, FORCE_SCORE, jnp.where(visible, imp, -FORCE_SCORE))
    n_top = min(NSA_SLC_TOPN, n_slc)
    _, sel = lax.top_k(imp, n_top)

    ks_blk = rms_norm(k_slc, g_ks).reshape(b, n_slc, NSA_SLC_LEN, g, hd).transpose(0, 3, 1, 2, 4)
    vs_blk = v_slc.reshape(b, n_slc, NSA_SLC_LEN, g, hd).transpose(0, 3, 1, 2, 4)
    take_blocks = jax.vmap(jax.vmap(lambda blocks, ix: blocks[ix]))
    n_keys = n_top * NSA_SLC_LEN

    def slc_block(i):
        q0 = i * SLC_Q_BLOCK
        qc = lax.dynamic_slice_in_dim(qg, q0, SLC_Q_BLOCK, axis=1)
        ic = lax.dynamic_slice_in_dim(sel, q0, SLC_Q_BLOCK, axis=2)
        kg = take_blocks(ks_blk, ic).reshape(b, g, SLC_Q_BLOCK, n_keys, hd)
        vg = take_blocks(vs_blk, ic).reshape(b, g, SLC_Q_BLOCK, n_keys, hd)
        kpos = (ic[..., None] * NSA_SLC_LEN + jnp.arange(NSA_SLC_LEN)).reshape(b, g, SLC_Q_BLOCK, n_keys)
        tq = q0 + jnp.arange(SLC_Q_BLOCK)
        dist = (tq[None, None, :, None] - kpos).astype(f32)[:, :, None]
        sc = jnp.einsum('bqgrd,bgqkd->bgrqk', qc, kg).astype(f32) - slopes * dist
        p = masked_softmax(sc, dist >= 0)
        return jnp.einsum('bgrqk,bgqkd->bqgrd', p.astype(vg.dtype), vg)

    o_slc = block_map(slc_block, s, SLC_Q_BLOCK)

    pad = ((0, 0), (NSA_WINDOW, 0), (0, 0), (0, 0))
    kw_p = jnp.pad(rms_norm(k_win, g_kw), pad)
    vw_p = jnp.pad(v_win, pad)
    span = NSA_WINDOW + Q_BLOCK

    def win_block(i):
        q0 = i * Q_BLOCK
        qc = lax.dynamic_slice_in_dim(qg, q0, Q_BLOCK, axis=1)
        kb = lax.dynamic_slice_in_dim(kw_p, q0, span, axis=1)
        vb = lax.dynamic_slice_in_dim(vw_p, q0, span, axis=1)
        tq = q0 + jnp.arange(Q_BLOCK)
        kpos = q0 - NSA_WINDOW + jnp.arange(span)
        dist_i = tq[:, None] - kpos[None, :]
        mask = (dist_i >= 0) & (dist_i < NSA_WINDOW) & (kpos[None, :] >= 0)
        sc = jnp.einsum('bqgrd,bkgd->bgrqk', qc, kb).astype(f32) - slopes * dist_i.astype(f32)
        p = masked_softmax(sc, mask)
        return jnp.einsum('bgrqk,bkgd->bqgrd', p.astype(vb.dtype), vb)

    o_win = block_map(win_block, s, Q_BLOCK)

    gt = jax.nn.sigmoid(gates.astype(f32)).astype(q.dtype).reshape(b, s, g, r, 3)
    o = gt[..., 0:1] * o_cmp + gt[..., 1:2] * o_slc + gt[..., 2:3] * o_win
    return o.reshape(b, s, h * hd)


def dsa_mixer(q, k, v, iq, ik, iw, g_q, g_k):
    b, s, h, hd = q.shape
    f32 = jnp.float32
    topk = min(DSA_TOPK_MAX, s // 4)
    slopes = alibi_slopes(h)[:, None, None]
    qn = rms_norm(q, g_q) * hd ** -0.5
    kn = rms_norm(k, g_k)
    iq = iq * IDX_DIM ** -0.5
    iw = iw * IDX_HEADS ** -0.5
    pos = jnp.arange(s)
    take_keys = jax.vmap(lambda t, ix: t[ix])

    def dsa_block(i):
        q0 = i * Q_BLOCK
        tq = q0 + jnp.arange(Q_BLOCK)
        iqc = lax.dynamic_slice_in_dim(iq, q0, Q_BLOCK, axis=1)
        iwc = lax.dynamic_slice_in_dim(iw, q0, Q_BLOCK, axis=1)
        logits = jax.nn.relu(jnp.einsum('bqhd,bsd->bqhs', iqc, ik))
        score = jnp.einsum('bqh,bqhs->bqs', iwc, logits).astype(f32)
        score = jnp.where(pos[None, None, :] <= tq[None, :, None], score, -jnp.inf)
        _, sel = lax.top_k(score, topk)
        kg = take_keys(kn, sel)
        vg = take_keys(v, sel)
        dist = (tq[None, :, None] - sel).astype(f32)[:, None]
        qc = lax.dynamic_slice_in_dim(qn, q0, Q_BLOCK, axis=1)
        sc = jnp.einsum('bqhd,bqkd->bhqk', qc, kg).astype(f32) - slopes * dist
        p = masked_softmax(sc, dist >= 0)
        return jnp.einsum('bhqk,bqkd->bqhd', p.astype(vg.dtype), vg)

    o = block_map(dsa_block, s, Q_BLOCK)
    return o.reshape(b, s, h * hd)


def hybrid_layer(x, c, w_ada, b_ada, g_norm1, g_norm2, w_in, g_q_a, g_kc_a, g_ks_a, g_kw_a,
                 pe_ck, pe_cv, w_ck1, w_ck2, w_cv1, w_cv2, g_q_b, g_k_b, w_o_a, w_o_b, w_out,
                 w_ff_gate, w_ff_up, w_ff_down):
    b, s, _ = x.shape
    mod = (jax.nn.silu(c) @ w_ada + b_ada)[:, None, :]
    shift1, scale1, gate1, shift2, scale2, gate2 = jnp.split(mod, N_ADA, axis=-1)

    h = rms_norm(x, g_norm1) * (1.0 + scale1) + shift1
    proj = h @ w_in
    (q_a, kc_a, vc_a, ks_a, vs_a, kw_a, vw_a, gate_nsa,
     q_b, k_b, v_b, iq_b, ik_b, iw_b, gate_a, gate_b) = jnp.split(
        proj, np.cumsum(IN_SIZES)[:-1].tolist(), axis=-1)

    def heads(t, n):
        return t.reshape(b, s, n, HEAD_DIM)

    o_a = nsa_mixer(heads(q_a, NSA_HEADS), heads(kc_a, NSA_GROUPS), heads(vc_a, NSA_GROUPS),
                    heads(ks_a, NSA_GROUPS), heads(vs_a, NSA_GROUPS),
                    heads(kw_a, NSA_GROUPS), heads(vw_a, NSA_GROUPS),
                    gate_nsa.reshape(b, s, NSA_HEADS, 3),
                    g_q_a, g_kc_a, g_ks_a, g_kw_a, pe_ck, pe_cv, w_ck1, w_ck2, w_cv1, w_cv2)
    o_b = dsa_mixer(heads(q_b, DSA_HEADS), k_b, v_b, iq_b.reshape(b, s, IDX_HEADS, IDX_DIM),
                    ik_b, iw_b, g_q_b, g_k_b)
    y = jax.nn.sigmoid(gate_a) * (o_a @ w_o_a) + jax.nn.sigmoid(gate_b) * (o_b @ w_o_b)
    x = x + gate1 * (y @ w_out)

    h2 = rms_norm(x, g_norm2) * (1.0 + scale2) + shift2
    ff = (jax.nn.silu(h2 @ w_ff_gate) * (h2 @ w_ff_up)) @ w_ff_down
    return x + gate2 * ff


def setup_inputs(seed: int = 0) -> dict:
    key = jax.random.key(seed)
    ks = jax.random.split(key, 32)
    f32 = jnp.float32
    hd = HEAD_DIM
    L = DEPTH

    def nrm(k, shape, scale):
        return jax.random.normal(k, shape, f32) * scale

    def gain(k, n):
        return 1.0 + 0.1 * jax.random.normal(k, (L, n), f32)

    cmp_in = NSA_CMP_LEN * hd
    return {
        'x': nrm(ks[0], (BATCH, SEQ, D_MODEL), 1.0),
        'c': nrm(ks[1], (BATCH, D_MODEL), 1.0),
        'w_ada': nrm(ks[2], (L, D_MODEL, N_ADA * D_MODEL), 0.5 * D_MODEL ** -0.5),
        'b_ada': nrm(ks[3], (L, N_ADA * D_MODEL), 0.01),
        'g_norm1': gain(ks[4], D_MODEL),
        'g_norm2': gain(ks[5], D_MODEL),
        'w_in': nrm(ks[6], (L, D_MODEL, D_IN), D_MODEL ** -0.5),
        'g_q_a': gain(ks[7], hd),
        'g_kc_a': gain(ks[8], hd),
        'g_ks_a': gain(ks[9], hd),
        'g_kw_a': gain(ks[10], hd),
        'pe_ck': nrm(ks[11], (L, NSA_CMP_LEN, hd), 0.1),
        'pe_cv': nrm(ks[12], (L, NSA_CMP_LEN, hd), 0.1),
        'w_ck1': nrm(ks[13], (L, cmp_in, NSA_CMP_HIDDEN), cmp_in ** -0.5),
        'w_ck2': nrm(ks[14], (L, NSA_CMP_HIDDEN, hd), NSA_CMP_HIDDEN ** -0.5),
        'w_cv1': nrm(ks[15], (L, cmp_in, NSA_CMP_HIDDEN), cmp_in ** -0.5),
        'w_cv2': nrm(ks[16], (L, NSA_CMP_HIDDEN, hd), NSA_CMP_HIDDEN ** -0.5),
        'g_q_b': gain(ks[17], hd),
        'g_k_b': gain(ks[18], hd),
        'w_o_a': nrm(ks[19], (L, NSA_HEADS * hd, D_MODEL), (NSA_HEADS * hd) ** -0.5),
        'w_o_b': nrm(ks[20], (L, DSA_HEADS * hd, D_MODEL), (DSA_HEADS * hd) ** -0.5),
        'w_out': nrm(ks[21], (L, D_MODEL, D_MODEL), D_MODEL ** -0.5),
        'w_ff_gate': nrm(ks[22], (L, D_MODEL, D_FF), D_MODEL ** -0.5),
        'w_ff_up': nrm(ks[23], (L, D_MODEL, D_FF), D_MODEL ** -0.5),
        'w_ff_down': nrm(ks[24], (L, D_FF, D_MODEL), D_FF ** -0.5),
    }


def reference(x, c, w_ada, b_ada, g_norm1, g_norm2, w_in, g_q_a, g_kc_a, g_ks_a, g_kw_a,
              pe_ck, pe_cv, w_ck1, w_ck2, w_cv1, w_cv2, g_q_b, g_k_b, w_o_a, w_o_b, w_out,
              w_ff_gate, w_ff_up, w_ff_down):
    for l in range(DEPTH):
        x = hybrid_layer(x, c, w_ada[l], b_ada[l], g_norm1[l], g_norm2[l], w_in[l],
                         g_q_a[l], g_kc_a[l], g_ks_a[l], g_kw_a[l], pe_ck[l], pe_cv[l],
                         w_ck1[l], w_ck2[l], w_cv1[l], w_cv2[l], g_q_b[l], g_k_b[l],
                         w_o_a[l], w_o_b[l], w_out[l], w_ff_gate[l], w_ff_up[l], w_ff_down[l])
    return x
```

```cpp
#include <hip/hip_runtime.h>
#include <hip/hip_cooperative_groups.h>
#include <cstdio>
#include <cstdint>
namespace cg = cooperative_groups;
#define RUNG 99
#define N_LAUNCH_MODE 1
#define REPMASK 0
#define REP(k) for (int rp_ = 0; rp_ < (((REPMASK) >> (k)) & 1) + 1; ++rp_)
namespace pg8 {
#define PG8_LAS __attribute__((address_space(3)))
typedef unsigned short bf16_t;
typedef short bf16x8 __attribute__((ext_vector_type(8)));
typedef float f32x4 __attribute__((ext_vector_type(4)));
typedef unsigned u32x4 __attribute__((ext_vector_type(4)));
typedef int i32x4 __attribute__((ext_vector_type(4)));
typedef int i32x8 __attribute__((ext_vector_type(8)));
constexpr int BM = 256, BK = 64, HALF = 128, HTB = HALF * BK * 2  , STAGE_BYTES = 8 * HTB, NXCD = 8, WGM = 4;

__host__ __device__ __forceinline__ int lds_byte(int r, int c) { const int st = (r >> 4) * 2 + (c >> 5), rr = r & 15, cc = c & 31, ob = rr * 64 + cc * 2; return st * 1024 + (ob ^ (((ob >> 9) & 1) << 5)); }
__host__ __device__ __forceinline__ void stage_rc(int b, int& R, int& C) { const int st = b / 1024, sb = b % 1024, swz = sb ^ (((sb >> 9) & 1) << 5); R = (st >> 1) * 16 + swz / 64; C = (st & 1) * 32 + (swz % 64) / 2; }
__host__ __device__ __forceinline__ int perm32(int rho) { const int n = rho >> 4, i = rho & 15; return 8 * (i >> 2) + 4 * n + (i & 3); }

struct Unit { int pm, pn; };
struct Gemm { const bf16_t* A; const bf16_t* Bt; int M, N, K; };

struct StaticOrder {
    int nM, nN, nwg, G, c, wgm;
    __host__ __device__ void init(int M, int N, int G_, int c_, int wgm_ = WGM) { nM = M / BM; nN = N / BM; nwg = nM * nN; G = G_; c = c_; wgm = wgm_; }
    __host__ __device__ bool next(int i, Unit& u) const {
        const long L = (long)i * G + c; if (L >= nwg) return false;
        int wgid = (int)L; { const int q = nwg / NXCD, r = nwg % NXCD, xcd = wgid % NXCD, off = wgid / NXCD; wgid = (xcd < r ? xcd * (q + 1) : r * (q + 1) + (xcd - r) * q) + off; }
        const int nig = wgm * nN, gid = wgid / nig, fm = gid * wgm, gsz = (nM - fm) < wgm ? (nM - fm) : wgm;
        u.pm = fm + ((wgid % nig) % gsz); u.pn = (wgid % nig) / gsz; return true;
    }
    __device__ __forceinline__ void a_ready(const Unit&) const {}
    __device__ __forceinline__ void done(const Unit&) const {}
};

template <class Epi, class Sched, bool ALIGN_EPI = false, bool SP2 = false, bool I8 = false, bool F8 = false>
__device__ __forceinline__ void gemm_phase(PG8_LAS unsigned char* lds, const Gemm g, const Sched& S, const Epi& E) {
    const int tid = threadIdx.x, wid = __builtin_amdgcn_readfirstlane(tid >> 6), lane = tid & 63, wr = wid >> 2, wc = wid & 3, fr = lane & 15, fq = lane >> 4;
    const int K = g.K, nt = K / BK;
    unsigned voffA[2], voffB[2];
#pragma unroll
    for (int i = 0; i < 2; ++i) { int R, C; stage_rc(tid * 16 + i * 8192, R, C); const int Rb = Epi::PERM ? ((R & ~31) + perm32(R & 31)) : R;
        voffA[i] = (unsigned)(R * K + C) * 2u; voffB[i] = (unsigned)(Rb * K + C) * 2u; }
    const size_t kstep = (size_t)(BK * 2);
    const size_t hstep = (size_t)HALF * K * 2;
    const size_t tstep = 2 * hstep;
    const unsigned ldsw = (unsigned)wid * 1024u;
    const int aoff = lds_byte(wr * 64 + fr, fq * 8), boff = lds_byte(wc * 32 + fr, fq * 8);
#define PG8_SA(b, h) (((b) * 2 + (h)) * HTB)
#define PG8_SB(b, h) ((4 + (b) * 2 + (h)) * HTB)
#define PG8_STAGE(bufoff, gbase, voff) do { _Pragma("unroll") for (int _i = 0; _i < 2; ++_i) \
        __builtin_amdgcn_global_load_lds((const unsigned*)((const char*)(gbase) + (voff)[_i]), (PG8_LAS unsigned*)(lds + (bufoff) + ldsw + _i * 8192), 16, 0, 0); } while (0)
#define PG8_LD8(p) PG8_CAT8(*(const PG8_LAS bf16x8*)(p), *(const PG8_LAS bf16x8*)((p) + 1024))
#define PG8_LDA8(dst, b, h) do { _Pragma("unroll") for (int m = 0; m < 4; ++m) dst##8[m] = PG8_LD8(lds + PG8_SA(b, h) + aoff + m * 2048); } while (0)
#define PG8_LDB8(dst, b, h) do { _Pragma("unroll") for (int n = 0; n < 2; ++n) dst##8[n] = PG8_LD8(lds + PG8_SB(b, h) + boff + n * 2048); } while (0)
#define PG8_LDA_(dst, b, h) do { _Pragma("unroll") for (int m = 0; m < 4; ++m) _Pragma("unroll") for (int k = 0; k < 2; ++k) dst[m][k] = *(const PG8_LAS bf16x8*)(lds + PG8_SA(b, h) + aoff + m * 2048 + k * 1024); } while (0)
#define PG8_LDB_(dst, b, h) do { _Pragma("unroll") for (int n = 0; n < 2; ++n) _Pragma("unroll") for (int k = 0; k < 2; ++k) dst[n][k] = *(const PG8_LAS bf16x8*)(lds + PG8_SB(b, h) + boff + n * 2048 + k * 1024); } while (0)
#define PG8_LDA(dst, b, h) do { if constexpr (F8) PG8_LDA8(dst, b, h); else PG8_LDA_(dst, b, h); } while (0)
#define PG8_LDB(dst, b, h) do { if constexpr (F8) PG8_LDB8(dst, b, h); else PG8_LDB_(dst, b, h); } while (0)
#define PG8_MMA(ai, bj, At, Bt) do { __builtin_amdgcn_s_setprio(1); _Pragma("unroll") for (int m = 0; m < 4; ++m) _Pragma("unroll") for (int n = 0; n < 2; ++n) _Pragma("unroll") for (int k = 0; k < 2; ++k) \
        { if constexpr (F8) { if (k == 0) asm volatile("v_mfma_scale_f32_16x16x128_f8f6f4 %0, %1, %2, %0, %3, %3 op_sel_hi:[0,0,0]" : "+v"(acc[ai][bj][m][n]) : "v"(Bt##8[n]), "v"(At##8[m]), "v"(f8scl)); } \
          else if constexpr (I8) acc[ai][bj][m][n] = __builtin_bit_cast(f32x4, __builtin_amdgcn_mfma_i32_16x16x64_i8(__builtin_bit_cast(i32x4, Bt[n][k]), __builtin_bit_cast(i32x4, At[m][k]), __builtin_bit_cast(i32x4, acc[ai][bj][m][n]), 0, 0, 0)); \
          else acc[ai][bj][m][n] = __builtin_amdgcn_mfma_f32_16x16x32_bf16(Bt[n][k], At[m][k], acc[ai][bj][m][n], 0, 0, 0); } __builtin_amdgcn_s_setprio(0); } while (0)
#define PG8_CAT8(x, y) __builtin_shufflevector(__builtin_bit_cast(i32x4, x), __builtin_bit_cast(i32x4, y), 0, 1, 2, 3, 4, 5, 6, 7)
#define PG8_WAIT_V(n) asm volatile("s_waitcnt vmcnt(" #n ")" ::: "memory")
#define PG8_WAIT_L(n) asm volatile("s_waitcnt lgkmcnt(" #n ")" ::: "memory")
#define PG8_BAR __builtin_amdgcn_s_barrier()
#define PG8_SCHED __builtin_amdgcn_sched_barrier(0)
    Unit cur, nxt; int ui = 0;
    if (!S.next(0, cur)) return;
    f32x4 acc[2][2][4][2];
#pragma unroll
    for (int a = 0; a < 2; ++a)
#pragma unroll
        for (int b = 0; b < 2; ++b)
#pragma unroll
            for (int m = 0; m < 4; ++m)
#pragma unroll
                for (int n = 0; n < 2; ++n) acc[a][b][m][n] = (f32x4){0.f, 0.f, 0.f, 0.f};
    bf16x8 At[4][2], B0[2][2], B1[2][2], Bn[2][2];
    const int f8scl = 0x7f7f7f7f;
    i32x8 At8[4], B08[2], B18[2], Bn8[2];
    const char* cA = (const char*)g.A + (size_t)cur.pm * tstep; const char* cB = (const char*)g.Bt + (size_t)cur.pn * tstep;
    S.a_ready(cur);
    if constexpr (SP2) {
        PG8_STAGE(PG8_SB(0, 0), cB, voffB); PG8_STAGE(PG8_SB(0, 1), cB + hstep, voffB); PG8_STAGE(PG8_SA(0, 0), cA, voffA); PG8_STAGE(PG8_SA(0, 1), cA + hstep, voffA);
        if (wr == 1) PG8_BAR;
        PG8_WAIT_V(2); PG8_BAR;
        PG8_STAGE(PG8_SB(1, 0), cB + kstep, voffB); PG8_STAGE(PG8_SA(1, 0), cA + kstep, voffA); PG8_STAGE(PG8_SB(1, 1), cB + hstep + kstep, voffB);
        PG8_WAIT_V(6); PG8_BAR;
    } else {
        PG8_STAGE(PG8_SB(0, 0), cB, voffB); PG8_STAGE(PG8_SA(0, 0), cA, voffA); PG8_STAGE(PG8_SB(0, 1), cB + hstep, voffB); PG8_STAGE(PG8_SA(0, 1), cA + hstep, voffA);
        if (wr == 1) PG8_BAR;
        PG8_WAIT_V(4); PG8_BAR;
        PG8_STAGE(PG8_SB(1, 0), cB + kstep, voffB); PG8_STAGE(PG8_SA(1, 0), cA + kstep, voffA); PG8_STAGE(PG8_SB(1, 1), cB + hstep + kstep, voffB);
        PG8_WAIT_V(6); PG8_BAR;
    }
    for (;;) {
        const bool has_next = S.next(ui + 1, nxt);
        const char* nA = has_next ? (const char*)g.A + (size_t)nxt.pm * tstep : cA; const char* nB = has_next ? (const char*)g.Bt + (size_t)nxt.pn * tstep : cB;
        if constexpr (SP2) PG8_LDB(B0, 0, 0);
        for (int t = 0; t < nt; t += 2) {
            const bool last = (t == nt - 2);
            const char* a1 = cA + (size_t)(t + 1) * kstep;
            const char* a2 = last ? nA : cA + (size_t)(t + 2) * kstep; const char* b2 = last ? nB : cB + (size_t)(t + 2) * kstep;
            const char* a3 = a2 + kstep; const char* b3 = b2 + kstep;
            if (last && has_next) S.a_ready(nxt);
            if constexpr (SP2) {
            PG8_LDB(B1, 0, 1); PG8_SCHED; PG8_LDA(At, 0, 0); PG8_STAGE(PG8_SA(1, 1), a1 + hstep, voffA);
            PG8_WAIT_V(6); PG8_WAIT_L(0); PG8_BAR; PG8_MMA(0, 0, At, B0); PG8_MMA(0, 1, At, B1); PG8_BAR; PG8_SCHED;
            PG8_LDA(At, 0, 1); PG8_LDB(Bn, 1, 0); PG8_STAGE(PG8_SB(0, 0), b2, voffB); PG8_STAGE(PG8_SB(0, 1), b2 + hstep, voffB); PG8_STAGE(PG8_SA(0, 0), a2, voffA);
            PG8_WAIT_V(8); PG8_WAIT_L(0); PG8_BAR; PG8_MMA(1, 0, At, B0); PG8_MMA(1, 1, At, B1); PG8_BAR; PG8_SCHED;
            PG8_LDB(B1, 1, 1); PG8_SCHED; PG8_LDA(At, 1, 0); PG8_STAGE(PG8_SA(0, 1), a2 + hstep, voffA);
            PG8_WAIT_V(6); PG8_WAIT_L(0); PG8_BAR; PG8_MMA(0, 0, At, Bn); PG8_MMA(0, 1, At, B1); PG8_BAR; PG8_SCHED;
            PG8_LDA(At, 1, 1); PG8_LDB(B0, 0, 0); PG8_STAGE(PG8_SB(1, 0), b3, voffB); PG8_STAGE(PG8_SB(1, 1), b3 + hstep, voffB); PG8_STAGE(PG8_SA(1, 0), a3, voffA);
            PG8_WAIT_V(8); PG8_WAIT_L(0); PG8_BAR; PG8_MMA(1, 0, At, Bn); PG8_MMA(1, 1, At, B1); PG8_BAR; PG8_SCHED;
            } else {
            PG8_LDB(B0, 0, 0); PG8_SCHED; PG8_LDA(At, 0, 0); PG8_STAGE(PG8_SA(1, 1), a1 + hstep, voffA);
            PG8_WAIT_L(8); PG8_BAR; PG8_WAIT_L(0); PG8_MMA(0, 0, At, B0); PG8_BAR; PG8_SCHED;
            PG8_LDB(B1, 0, 1); PG8_STAGE(PG8_SB(0, 0), b2, voffB);
            PG8_BAR; PG8_WAIT_L(0); PG8_MMA(0, 1, At, B1); PG8_BAR;
            PG8_LDA(At, 0, 1); PG8_STAGE(PG8_SA(0, 0), a2, voffA);
            PG8_BAR; PG8_WAIT_L(0); PG8_MMA(1, 0, At, B0); PG8_BAR; PG8_SCHED;
            PG8_STAGE(PG8_SB(0, 1), b2 + hstep, voffB);
            PG8_WAIT_V(6); PG8_BAR; PG8_MMA(1, 1, At, B1); PG8_BAR;
            PG8_LDB(B0, 1, 0); PG8_SCHED; PG8_LDA(At, 1, 0); PG8_STAGE(PG8_SA(0, 1), a2 + hstep, voffA);
            PG8_WAIT_L(8); PG8_BAR; PG8_WAIT_L(0); PG8_MMA(0, 0, At, B0); PG8_BAR; PG8_SCHED;
            PG8_LDB(B1, 1, 1); PG8_STAGE(PG8_SB(1, 0), b3, voffB);
            PG8_BAR; PG8_WAIT_L(0); PG8_MMA(0, 1, At, B1); PG8_BAR;
            PG8_LDA(At, 1, 1); PG8_STAGE(PG8_SA(1, 0), a3, voffA);
            PG8_BAR; PG8_WAIT_L(0); PG8_MMA(1, 0, At, B0); PG8_BAR; PG8_SCHED;
            PG8_STAGE(PG8_SB(1, 1), b3 + hstep, voffB);
            PG8_WAIT_V(6); PG8_BAR; PG8_MMA(1, 1, At, B1); PG8_BAR;
            }
        }
        if constexpr (F8) asm volatile("s_nop 15\n\ts_nop 15" ::: "memory");
        if constexpr (ALIGN_EPI) { if (wr == 0) PG8_BAR; }
        if constexpr (I8) {
#pragma unroll
            for (int a = 0; a < 2; ++a)
#pragma unroll
                for (int b2 = 0; b2 < 2; ++b2)
#pragma unroll
                    for (int m = 0; m < 4; ++m)
#pragma unroll
                        for (int n = 0; n < 2; ++n) acc[a][b2][m][n] = __builtin_convertvector(__builtin_bit_cast(i32x4, acc[a][b2][m][n]), f32x4);
        }
        if constexpr (!Epi::AFTER_DRAIN) { E(acc, cur, wr, wc, fr, fq); S.done(cur); }
        if (!has_next) break;
#pragma unroll
        for (int a = 0; a < 2; ++a)
#pragma unroll
            for (int b = 0; b < 2; ++b)
#pragma unroll
                for (int m = 0; m < 4; ++m)
#pragma unroll
                    for (int n = 0; n < 2; ++n) acc[a][b][m][n] = (f32x4){0.f, 0.f, 0.f, 0.f};
        cur = nxt; cA = nA; cB = nB; ++ui;
        if constexpr (ALIGN_EPI) { if (wr == 1) PG8_BAR; }
    }
    PG8_WAIT_V(0);
    if constexpr (!ALIGN_EPI) { if (wr == 0) PG8_BAR; }
    PG8_BAR;
    if constexpr (Epi::AFTER_DRAIN) { E.fused(acc, cur, wr, wc, fr, fq, lds, wid, lane); S.done(cur); }
#undef PG8_SA
#undef PG8_SB
#undef PG8_STAGE
#undef PG8_LDA
#undef PG8_LDA_
#undef PG8_LDB_
#undef PG8_LDA8
#undef PG8_LDB8
#undef PG8_LD8
#undef PG8_LDB
#undef PG8_MMA
#undef PG8_CAT8
#undef PG8_WAIT_V
#undef PG8_WAIT_L
#undef PG8_BAR
#undef PG8_SCHED
}
}

#define LAS __attribute__((address_space(3)))
typedef unsigned short bf16;
typedef short bf16x8 __attribute__((ext_vector_type(8)));
typedef short s16x4 __attribute__((ext_vector_type(4)));
typedef short v4i16_t __attribute__((ext_vector_type(4)));
typedef float f32x4 __attribute__((ext_vector_type(4)));
typedef float f32x16 __attribute__((ext_vector_type(16)));
typedef unsigned u32x4 __attribute__((ext_vector_type(4)));
typedef unsigned u32x2 __attribute__((ext_vector_type(2)));

constexpr int NB = 32, SEQ = 2048, DM = 1024, MROWS = NB * SEQ;
constexpr int DIN = 4576, DINP = 4608, DFF = 2816, NADA = 6 * DM;
constexpr float LOG2E = 1.4426950408889634f;
constexpr float QSCALE = 0.125f * LOG2E;
constexpr float RMS_EPS = 1e-6f;
constexpr int NWAVES = 8, NTHREADS = 512;
constexpr int LDS_BYTES = 147456;
constexpr int MAXGRID = 256;

constexpr size_t MiB = 1ull << 20;
constexpr size_t WS_MOD = 1 * MiB, WS_BIAS = 2 * MiB,
    WS_WIN = 4 * MiB, WS_WOA = 13 * MiB, WS_WOB = 14 * MiB, WS_WOUT = 15 * MiB, WS_WGU = 17 * MiB, WS_WD = 28 * MiB,
    WS_WCK1 = 34 * MiB, WS_WCV1 = 34 * MiB + 512 * 1024, WS_KCO = 35 * MiB, WS_VCO = 36 * MiB,
    WS_H = 40 * MiB, WS_OA = 40 * MiB, WS_OB = 104 * MiB, WS_H2 = 40 * MiB,
    WS_QA = 168 * MiB, WS_QB = 232 * MiB, WS_IQ = 296 * MiB, WS_GA = 360 * MiB, WS_GB = 488 * MiB,
    WS_KC = 616 * MiB, WS_VC = 632 * MiB, WS_KS = 648 * MiB, WS_VS = 664 * MiB, WS_KW = 680 * MiB, WS_VW = 696 * MiB,
    WS_KB = 712 * MiB, WS_VB = 720 * MiB, WS_IK = 728 * MiB, WS_GN = 736 * MiB, WS_IW = 744 * MiB,
    WS_SCR = 748 * MiB, WS_Y = 812 * MiB, WS_ACT = 168 * MiB, WS_END = 940 * MiB,
    WS_ROWSS = 65536  , WS_CB = 3 * MiB  ,
    WS_X1B = 620 * MiB  ;
constexpr size_t ZERO_BYTES = 65536 + 3 * 4 * 65536;
constexpr size_t WS_HQ = 812 * MiB  , WS_WINGQ = WS_WIN + 4 * MiB  ;
constexpr size_t WS_SBWIN = 2 * MiB + 65536, WS_SBWGU = 2 * MiB + 131072, WS_SA1 = 2 * MiB + 262144, WS_SA2 = 2 * MiB + 524288;
constexpr size_t WS_SBO = 2 * MiB + 200704  , WS_ROWNA = 327680, WS_ROWNB = 589824  ;
constexpr size_t WS_Y8 = 168 * MiB  ;
constexpr size_t WS_VMAX = 32768  , WS_SBWO = 2 * MiB + 212992  ;
constexpr size_t WS_OB8 = WS_OA + 32 * MiB  , WS_WOB8 = WS_WOA + 512 * 1024;
__device__ __forceinline__ float so_scale_a(const float* vm) { const float bd = (vm[0] + vm[1] + vm[2]) * (1.01f / 440.f); return (bd > 0.f) ? bd : 1.f; }
__device__ __forceinline__ float so_scale_b(const float* vm) { const float bd = vm[3] * (1.01f / 440.f); return (bd > 0.f) ? bd : 1.f; }
constexpr size_t WS_SBD = 2 * MiB + 196608  , WS_SACT = 2 * MiB + 786432  , WS_WNMAX = 2 * MiB + 208896  , WS_WNI = 2 * MiB + 204800  ;

struct Args { const float* in[25]; float* out; unsigned char* ws; int ph_lo, ph_hi; };

enum { I_X = 0, I_C, I_WADA, I_BADA, I_GN1, I_GN2, I_WIN, I_GQA, I_GKC, I_GKS, I_GKW, I_PECK, I_PECV, I_WCK1, I_WCK2, I_WCV1, I_WCV2,
       I_GQB, I_GKB, I_WOA, I_WOB, I_WOUT, I_WFG, I_WFU, I_WFD };

typedef float f32x2_t __attribute__((ext_vector_type(2))); typedef __bf16 bf16x2_t __attribute__((ext_vector_type(2)));
__device__ __forceinline__ unsigned cvt_pk(float lo, float hi) { const f32x2_t v = {lo, hi}; const bf16x2_t b = __builtin_convertvector(v, bf16x2_t); return __builtin_bit_cast(unsigned, b); }
__device__ __forceinline__ float bf2f(unsigned short v) { return __uint_as_float((unsigned)v << 16); }
__device__ __forceinline__ float sigmoidf_(float x) { return __builtin_amdgcn_rcpf(1.f + __builtin_amdgcn_exp2f(x * -LOG2E)); }
__device__ __forceinline__ float siluf_(float x) { return x * __builtin_amdgcn_rcpf(1.f + __builtin_amdgcn_exp2f(x * -LOG2E)); }
__device__ __forceinline__ float sy_scale(float rna, float rnb, float wa, float wb) { const float bd = (sqrtf(rna) * wa + sqrtf(rnb) * wb) * (1.02f / 440.f); return (bd > 0.f) ? bd : 1.f; }
__device__ __forceinline__ float wave_sum(float v) {
#pragma unroll
    for (int o = 1; o < 64; o <<= 1) v += __shfl_xor(v, o);
    return v;
}
#define LDS_WAIT() asm volatile("s_waitcnt lgkmcnt(0)" ::: "memory")
#define DPP_STEP_F(x, op, ctrl, rmask, bc, ident) { const float y_ = __int_as_float(__builtin_amdgcn_update_dpp(__float_as_int(ident), __float_as_int(x), ctrl, rmask, 0xf, bc)); x = op(x, y_); }
__device__ __forceinline__ float fadd_(float a, float b) { return a + b; }
__device__ __forceinline__ float wave_sum_dpp(float x) {
    DPP_STEP_F(x, fadd_, 0x111, 0xf, true, 0.f) DPP_STEP_F(x, fadd_, 0x112, 0xf, true, 0.f) DPP_STEP_F(x, fadd_, 0x114, 0xf, true, 0.f) DPP_STEP_F(x, fadd_, 0x118, 0xf, true, 0.f)
    DPP_STEP_F(x, fadd_, 0x142, 0xa, false, 0.f) DPP_STEP_F(x, fadd_, 0x143, 0xc, false, 0.f)
    return __int_as_float(__builtin_amdgcn_readlane(__float_as_int(x), 63));
}
__device__ __forceinline__ float wave_max_dpp(float x) {
    DPP_STEP_F(x, fmaxf, 0x111, 0xf, true, 0.f) DPP_STEP_F(x, fmaxf, 0x112, 0xf, true, 0.f) DPP_STEP_F(x, fmaxf, 0x114, 0xf, true, 0.f) DPP_STEP_F(x, fmaxf, 0x118, 0xf, true, 0.f)
    DPP_STEP_F(x, fmaxf, 0x142, 0xa, false, 0.f) DPP_STEP_F(x, fmaxf, 0x143, 0xc, false, 0.f)
    return __int_as_float(__builtin_amdgcn_readlane(__float_as_int(x), 63));
}

__device__ __forceinline__ int win_src_col(int np) {
    const int T = np >> 8, r = np & 255;
    if (T >= 10) return 2528 + (T - 10) * 256 + r;
    const int slot = (r & 127) >> 5, d = ((r >> 7) << 5) + (r & 31);
    switch (T) {
        case 0: return slot * 64 + d;
        case 1: return 256 + slot * 64 + d;
        case 2: return 512 + slot * 64 + d;
        case 3: return 768 + slot * 64 + d;
        case 4: return 1024 + slot * 64 + d;
        case 5: return 1304 + slot * 64 + d;
        case 6: return 1560 + slot * 64 + d;
        case 7: if (slot == 0) return 1816 + d;
                if (slot == 1) return 1880 + d;
                if (slot == 2) return 2456 + d;
                if (d < 24) return 1280 + d;
                if (d < 32) return 2520 + (d - 24);
                return -1;
        case 8: return 1944 + slot * 64 + d;
        default: return 2200 + slot * 64 + d;
    }
}

constexpr int NBFT = 3, NI8T = 15;
__device__ __forceinline__ int tmap_bf(int t) { return t + 7; }
__device__ __forceinline__ int tmap_i8(int t) { return t < 7 ? t : t + 3; }
constexpr int NBFROWS = NBFT * 256, NI8ROWS = NI8T * 256, NBFG = NBFROWS / 32, NI8G = NI8ROWS / 32;
__device__ __forceinline__ int win_src_col_bf(int np) { return win_src_col(tmap_bf(np >> 8) * 256 + (np & 255)); }
__device__ __forceinline__ int win_src_col_i8(int np) { return win_src_col(tmap_i8(np >> 8) * 256 + (np & 255)); }
__device__ __forceinline__ void transpose_item(const float* __restrict__ W, int ldw, int K, bf16* __restrict__ WT, int n0p, int k0, int col, LAS float* scr, int lane) {
#pragma unroll 8
    for (int i = 0; i < 32; ++i) { const int kk = 2 * i + (lane >> 5); scr[kk * 33 + (lane & 31)] = (col >= 0) ? W[(size_t)(k0 + kk) * ldw + col] : 0.f; }
    LDS_WAIT(); asm volatile("" ::: "memory");
    const int c = lane & 7;
#pragma unroll
    for (int j = 0; j < 4; ++j) { const int n = (lane >> 3) + 8 * j; const LAS float* s = scr + (8 * c) * 33 + n;
        u32x4 o; o.x = cvt_pk(s[0 * 33], s[1 * 33]); o.y = cvt_pk(s[2 * 33], s[3 * 33]); o.z = cvt_pk(s[4 * 33], s[5 * 33]); o.w = cvt_pk(s[6 * 33], s[7 * 33]);
        *(u32x4*)(WT + (size_t)(n0p + n) * K + k0 + 8 * c) = o; }
    LDS_WAIT(); asm volatile("" ::: "memory");
}

__device__ __forceinline__ void phase0(const Args& a, LAS unsigned char* lds) {
    const int tid = threadIdx.x, lane = tid & 63, wave = __builtin_amdgcn_readfirstlane(tid >> 6);
    unsigned char* ws = a.ws;
    for (size_t i = (size_t)blockIdx.x * NTHREADS + tid; i < ZERO_BYTES / 16; i += (size_t)gridDim.x * NTHREADS) ((u32x4*)ws)[i] = u32x4{0u, 0u, 0u, 0u};
    {
        LAS float* scr = (LAS float*)(lds + wave * 16384);
        const int gw = blockIdx.x * NWAVES + wave, NGW = gridDim.x * NWAVES;
        constexpr int I0 = 16 * NBFG  , I1 = 0, I2 = 0  , I3 = 0  , I4 = 0  , I5 = 0  , I6 = 32 * 4, I7 = 32 * 4;
        constexpr int NIT = I0 + I1 + I2 + I3 + I4 + I5 + I6 + I7;
        for (int it = gw; it < NIT; it += NGW) {
            int r = it;
            if (r < I0) { const int kb = r / (NBFG > 0 ? NBFG : 1), nb = r % (NBFG > 0 ? NBFG : 1), np = nb * 32 + (lane & 31);
                transpose_item(a.in[I_WIN], DIN, DM, (bf16*)(ws + WS_WIN), nb * 32, kb * 64, win_src_col_bf(np), scr, lane); continue; } r -= I0;
            if (r < I1) { const int kb = r / 32, nb = r % 32;
                transpose_item(a.in[I_WOA], DM, 512, (bf16*)(ws + WS_WOA), nb * 32, kb * 64, nb * 32 + (lane & 31), scr, lane); continue; } r -= I1;
            if (r < I2) { const int kb = r / 32, nb = r % 32;
                transpose_item(a.in[I_WOB], DM, 512, (bf16*)(ws + WS_WOB), nb * 32, kb * 64, nb * 32 + (lane & 31), scr, lane); continue; } r -= I2;
            if (r < I3) { const int kb = r / 32, nb = r % 32;
                transpose_item(a.in[I_WOUT], DM, DM, (bf16*)(ws + WS_WOUT), nb * 32, kb * 64, nb * 32 + (lane & 31), scr, lane); continue; } r -= I3;
            if (r < I4) { const int kb = r / 176, nb = r % 176, np0 = nb * 32, T = np0 >> 8, rr = np0 & 255;
                const float* src = (rr < 128) ? a.in[I_WFG] : a.in[I_WFU];
                transpose_item(src, DFF, DM, (bf16*)(ws + WS_WGU), np0, kb * 64, T * 128 + (rr & 127) + (lane & 31), scr, lane); continue; } r -= I4;
            if (r < I5) { const int kb = r / 32, nb = r % 32;
                transpose_item(a.in[I_WFD], DM, DFF, (bf16*)(ws + WS_WD), nb * 32, kb * 64, nb * 32 + (lane & 31), scr, lane); continue; } r -= I5;
            if (r < I6) { const int kb = r / 4, nb = r % 4;
                transpose_item(a.in[I_WCK1], 128, 2048, (bf16*)(ws + WS_WCK1), nb * 32, kb * 64, nb * 32 + (lane & 31), scr, lane); continue; } r -= I6;
            { const int kb = r / 4, nb = r % 4;
                transpose_item(a.in[I_WCV1], 128, 2048, (bf16*)(ws + WS_WCV1), nb * 32, kb * 64, nb * 32 + (lane & 31), scr, lane); }
        }
    }
    LAS float* sc = (LAS float*)lds;
    for (int it = blockIdx.x; it < 208 + 176 + NI8G + 32 + 96; it += gridDim.x) {
        __syncthreads();
        if (it >= 208 + 176 + NI8G + 32) {
            const int j = it - (208 + 176 + NI8G + 32), which = j >> 5, col = (j & 31) * 32 + (lane & 31);
            const float* W = a.in[which == 0 ? I_WOUT : (which == 1 ? I_WOA : I_WOB)]; const int kw = which == 0 ? 128 : 64;
            float m = 0.f, s2 = 0.f;
#pragma unroll 8
            for (int i = 0; i < kw / 2; ++i) { const int k = kw * wave + 2 * i + (lane >> 5); const float v = W[(size_t)k * DM + col]; m = fmaxf(m, fabsf(v)); s2 += v * v; }
            m = fmaxf(m, __shfl_xor(m, 32)); s2 += __shfl_xor(s2, 32);
            if (lane < 32) { sc[wave * 32 + lane] = m; sc[256 + wave * 32 + lane] = s2; }
            __syncthreads();
            if (tid < 32) { float mm = 0.f, ss = 0.f;
#pragma unroll
                for (int w = 0; w < 8; ++w) { mm = fmaxf(mm, sc[w * 32 + tid]); ss += sc[256 + w * 32 + tid]; }
                if (which == 0) ((float*)(ws + WS_SBO))[(j & 31) * 32 + tid] = (mm > 0.f) ? mm * (1.f / 448.f) : 1.f;
                else { ((float*)(ws + WS_SBWO))[(which - 1) * 1024 + (j & 31) * 32 + tid] = (mm > 0.f) ? mm * (1.f / 448.f) : 1.f;
                    float cn = sqrtf(ss) * 1.0635f;
#pragma unroll
                    for (int o = 1; o < 32; o <<= 1) cn = fmaxf(cn, __shfl_xor(cn, o));
                    if (tid == 0) ((float*)(ws + WS_WNI))[176 + (which - 1) * 32 + (j & 31)] = cn; } }
        } else if (it >= 208 + 176 + NI8G) {
            const int g32 = it - 208 - 176 - NI8G, col = g32 * 32 + (lane & 31); const float* W = a.in[I_WFD];
            float m = 0.f;
#pragma unroll 8
            for (int i = 0; i < 176; ++i) { const int k = 352 * wave + 2 * i + (lane >> 5); m = fmaxf(m, fabsf(W[(size_t)k * DM + col])); }
            m = fmaxf(m, __shfl_xor(m, 32));
            if (lane < 32) sc[wave * 32 + lane] = m;
            __syncthreads();
            if (tid < 32) { float mm = 0.f;
#pragma unroll
                for (int w = 0; w < 8; ++w) mm = fmaxf(mm, sc[w * 32 + tid]);
                ((float*)(ws + WS_SBD))[g32 * 32 + tid] = (mm > 0.f) ? mm * (1.f / 448.f) : 1.f; }
        } else if (it >= 208 + 176) {
            const int g32 = it - 208 - 176, col = win_src_col_i8(g32 * 32 + (lane & 31)); const float* W = a.in[I_WIN];
            float m = 0.f;
#pragma unroll 8
            for (int i = 0; i < 64; ++i) { const int k = 128 * wave + 2 * i + (lane >> 5); const float v = (col >= 0) ? W[(size_t)k * DIN + col] : 0.f; m = fmaxf(m, fabsf(v)); }
            m = fmaxf(m, __shfl_xor(m, 32));
            if (lane < 32) sc[wave * 32 + lane] = m;
            __syncthreads();
            if (tid < 32) { float mm = 0.f;
#pragma unroll
                for (int w = 0; w < 8; ++w) mm = fmaxf(mm, sc[w * 32 + tid]);
                ((float*)(ws + WS_SBWIN))[g32 * 32 + tid] = (mm > 0.f) ? mm * (1.f / 127.f) : 1.f; }
        } else if (it >= 208) {
            const int g32 = it - 208, np0 = g32 * 32, T = np0 >> 8, rr = np0 & 255; const float* W = (rr < 128) ? a.in[I_WFG] : a.in[I_WFU];
            const int col = T * 128 + (rr & 127) + (lane & 31);
            float m = 0.f, s2 = 0.f;
#pragma unroll 8
            for (int i = 0; i < 64; ++i) { const int k = 128 * wave + 2 * i + (lane >> 5); const float v = W[(size_t)k * DFF + col]; m = fmaxf(m, fabsf(v)); s2 += v * v; }
            m = fmaxf(m, __shfl_xor(m, 32)); s2 += __shfl_xor(s2, 32);
            if (lane < 32) { sc[wave * 32 + lane] = m; sc[256 + wave * 32 + lane] = s2; }
            __syncthreads();
            if (tid < 32) { float mm = 0.f, ss = 0.f;
#pragma unroll
                for (int w = 0; w < 8; ++w) { mm = fmaxf(mm, sc[w * 32 + tid]); ss += sc[256 + w * 32 + tid]; }
                const float sb = (mm > 0.f) ? mm * (1.f / 127.f) : 1.f;
                ((float*)(ws + WS_SBWGU))[g32 * 32 + tid] = sb;
                float cn = sqrtf(ss) * 1.0001f + 16.f * sb;
#pragma unroll
                for (int o = 1; o < 32; o <<= 1) cn = fmaxf(cn, __shfl_xor(cn, o));
                if (tid == 0) ((float*)(ws + WS_WNI))[g32] = cn; }
        } else if (it < 192) {
            const float* c = a.in[I_C];
            for (int i = tid; i < NB * DM; i += NTHREADS) { const int bb = i >> 10, kk = i & 1023; sc[kk * 32 + bb] = siluf_(c[i]); }
            __syncthreads();
            const int cl = tid & 31, ks = tid >> 5, col = it * 32 + cl;
            float acc[32];
#pragma unroll
            for (int j = 0; j < 32; ++j) acc[j] = 0.f;
            const float* W = a.in[I_WADA] + (size_t)(ks * 64) * NADA + col;
#pragma unroll 1
            for (int k0 = 0; k0 < 64; k0 += 8) {
                float w[8];
#pragma unroll
                for (int u = 0; u < 8; ++u) w[u] = W[(size_t)(k0 + u) * NADA];
#pragma unroll
                for (int u = 0; u < 8; ++u) { const LAS f32x4* sp = (const LAS f32x4*)(sc + (ks * 64 + k0 + u) * 32);
#pragma unroll
                    for (int q = 0; q < 8; ++q) { const f32x4 v = sp[q]; acc[4 * q] += v.x * w[u]; acc[4 * q + 1] += v.y * w[u]; acc[4 * q + 2] += v.z * w[u]; acc[4 * q + 3] += v.w * w[u]; } }
            }
            __syncthreads();
#pragma unroll
            for (int j = 0; j < 32; ++j) sc[(ks * 32 + j) * 32 + cl] = acc[j];
            __syncthreads();
            float* mod = (float*)(ws + WS_MOD);
            for (int o = tid; o < 1024; o += NTHREADS) { const int b = o >> 5, c2 = o & 31;
                float s2 = 0.f;
#pragma unroll
                for (int q = 0; q < 16; ++q) s2 += sc[(q * 32 + b) * 32 + c2];
                mod[b * NADA + it * 32 + c2] = s2 + a.in[I_BADA][it * 32 + c2]; }
        } else {
            const int which = (it - 192) >> 3, kq = (it - 192) & 7;
            const float* pe = a.in[which ? I_PECV : I_PECK]; const float* w1 = a.in[which ? I_WCV1 : I_WCK1];
            const int col = tid & 127, ks = tid >> 7; float s = 0.f;
#pragma unroll 8
            for (int k = kq * 256 + ks * 64; k < kq * 256 + ks * 64 + 64; ++k) s += pe[k] * w1[(size_t)k * 128 + col];
            sc[ks * 128 + col] = s;
            __syncthreads();
            if (tid < 128) ((float*)(ws + WS_BIAS))[(which * 8 + kq) * 128 + tid] = sc[tid] + sc[128 + tid] + sc[256 + tid] + sc[384 + tid];
        }
    }
    __syncthreads();
}

__device__ __forceinline__ void transpose_item_i8(const float* __restrict__ W, int ldw, int K, signed char* __restrict__ WQ, const float* __restrict__ SB, int n0p, int k0, int col, LAS float* scr, int lane) {
#pragma unroll 8
    for (int i = 0; i < 32; ++i) { const int kk = 2 * i + (lane >> 5); scr[kk * 33 + (lane & 31)] = (col >= 0) ? W[(size_t)(k0 + kk) * ldw + col] : 0.f; }
    LDS_WAIT(); asm volatile("" ::: "memory");
    const int n = lane >> 1, kh = (lane & 1) * 32; const float inv = 1.f / SB[n0p + n];
#pragma unroll
    for (int c = 0; c < 2; ++c) { unsigned w[4];
#pragma unroll
        for (int d = 0; d < 4; ++d) { unsigned pk = 0u;
#pragma unroll
            for (int j = 0; j < 4; ++j) { const float v = scr[(kh + 16 * c + 4 * d + j) * 33 + n] * inv; int q = (int)rintf(v); q = q > 127 ? 127 : (q < -127 ? -127 : q); pk |= ((unsigned)q & 0xffu) << (8 * j); }
            w[d] = pk; }
        *(u32x4*)(WQ + (size_t)(n0p + n) * K + k0 + kh + 16 * c) = u32x4{w[0], w[1], w[2], w[3]}; }
    LDS_WAIT(); asm volatile("" ::: "memory");
}
__device__ __forceinline__ void wing_quant_items(const Args& a, LAS unsigned char* lds) {
    const int tid = threadIdx.x, lane = tid & 63, wave = __builtin_amdgcn_readfirstlane(tid >> 6); unsigned char* ws = a.ws;
    LAS float* scr = (LAS float*)(lds + wave * 16384);
    const int gw = blockIdx.x * NWAVES + wave, NGW = gridDim.x * NWAVES;
    for (int it = gw; it < 16 * NI8G; it += NGW) { const int kb = it / NI8G, nb = it % NI8G;
        transpose_item_i8(a.in[I_WIN], DIN, DM, (signed char*)(ws + WS_WINGQ), (const float*)(ws + WS_SBWIN), nb * 32, kb * 64, win_src_col_i8(nb * 32 + (lane & 31)), scr, lane); }
}
__device__ __forceinline__ void wgu_quant_items(const Args& a, LAS unsigned char* lds) {
    const int tid = threadIdx.x, lane = tid & 63, wave = __builtin_amdgcn_readfirstlane(tid >> 6); unsigned char* ws = a.ws;
    LAS float* scr = (LAS float*)(lds + wave * 16384);
    const int gw = blockIdx.x * NWAVES + wave, NGW = gridDim.x * NWAVES;
    for (int it = gw; it < 16 * 176; it += NGW) { const int kb = it / 176, nb = it % 176, np0 = nb * 32, T = np0 >> 8, rr = np0 & 255;
        const float* src = (rr < 128) ? a.in[I_WFG] : a.in[I_WFU];
        transpose_item_i8(src, DFF, DM, (signed char*)(ws + WS_WGU), (const float*)(ws + WS_SBWGU), np0, kb * 64, T * 128 + (rr & 127) + (lane & 31), scr, lane); }
}
__device__ __forceinline__ void transpose_item_f8(const float* __restrict__ W, int ldw, int K, unsigned char* __restrict__ WQ, const float* __restrict__ SB, int n0p, int k0, int col, LAS float* scr, int lane) {
#pragma unroll 8
    for (int i = 0; i < 32; ++i) { const int kk = 2 * i + (lane >> 5); scr[kk * 33 + (lane & 31)] = W[(size_t)(k0 + kk) * ldw + col]; }
    LDS_WAIT(); asm volatile("" ::: "memory");
    const int n = lane >> 1, kh = (lane & 1) * 32; const float inv = 1.f / SB[n0p + n];
#pragma unroll
    for (int c = 0; c < 2; ++c) { unsigned w[4];
#pragma unroll
        for (int d = 0; d < 4; ++d) { const LAS float* sp = scr + (kh + 16 * c + 4 * d) * 33 + n;
            int pk = __builtin_amdgcn_cvt_pk_fp8_f32(sp[0] * inv, sp[33] * inv, 0, false); pk = __builtin_amdgcn_cvt_pk_fp8_f32(sp[66] * inv, sp[99] * inv, pk, true);
            w[d] = (unsigned)pk; }
        *(u32x4*)(WQ + (size_t)(n0p + n) * K + k0 + kh + 16 * c) = u32x4{w[0], w[1], w[2], w[3]}; }
    LDS_WAIT(); asm volatile("" ::: "memory");
}
__device__ __forceinline__ void wd_quant_items(const Args& a, LAS unsigned char* lds) {
    const int tid = threadIdx.x, lane = tid & 63, wave = __builtin_amdgcn_readfirstlane(tid >> 6); unsigned char* ws = a.ws;
    LAS float* scr = (LAS float*)(lds + wave * 16384);
    const int gw = blockIdx.x * NWAVES + wave, NGW = gridDim.x * NWAVES;
    for (int it = gw; it < 44 * 32; it += NGW) { const int kb = it / 32, nb = it % 32;
        transpose_item_f8(a.in[I_WFD], DM, DFF, ws + WS_WD, (const float*)(ws + WS_SBD), nb * 32, kb * 64, nb * 32 + (lane & 31), scr, lane); }
}
__device__ __forceinline__ void woab_quant_items(const Args& a, LAS unsigned char* lds) {
    const int tid = threadIdx.x, lane = tid & 63, wave = __builtin_amdgcn_readfirstlane(tid >> 6); unsigned char* ws = a.ws;
    LAS float* scr = (LAS float*)(lds + wave * 16384);
    const int gw = blockIdx.x * NWAVES + wave, NGW = gridDim.x * NWAVES;
    for (int it = gw; it < 2 * 8 * 32; it += NGW) { const int which = it >> 8, r = it & 255, kb = r / 32, nb = r % 32;
        transpose_item_f8(a.in[which ? I_WOB : I_WOA], DM, 512, ws + WS_WOA, (const float*)(ws + WS_SBWO), which * 1024 + nb * 32, kb * 64, nb * 32 + (lane & 31), scr, lane); }
}
__device__ __forceinline__ void wout_quant_items(const Args& a, LAS unsigned char* lds) {
    const int tid = threadIdx.x, lane = tid & 63, wave = __builtin_amdgcn_readfirstlane(tid >> 6); unsigned char* ws = a.ws;
    LAS float* scr = (LAS float*)(lds + wave * 16384);
    const int gw = blockIdx.x * NWAVES + wave, NGW = gridDim.x * NWAVES;
    for (int it = gw; it < 16 * 32; it += NGW) { const int kb = it / 32, nb = it % 32;
        transpose_item_f8(a.in[I_WOUT], DM, DM, ws + WS_WOUT, (const float*)(ws + WS_SBO), nb * 32, kb * 64, nb * 32 + (lane & 31), scr, lane); }
}
__device__ __forceinline__ void wnmax_item(unsigned char* ws) {
    const int lane = threadIdx.x & 63; const float* wni = (const float*)(ws + WS_WNI);
    float g = 0.f, u = 0.f;
    for (int i = lane; i < 176; i += 64) { const float v = wni[i]; if ((i & 7) < 4) g = fmaxf(g, v); else u = fmaxf(u, v); }
    float oa = (lane < 32) ? wni[176 + lane] : 0.f, ob = (lane < 32) ? wni[208 + lane] : 0.f;
    g = wave_max_dpp(g); u = wave_max_dpp(u); oa = wave_max_dpp(oa); ob = wave_max_dpp(ob);
    if (lane == 0) *(f32x4*)(ws + WS_WNMAX) = f32x4{g, u, oa, ob};
}
__device__ __forceinline__ void norm2_quant_phase(const bf16* __restrict__ X1B, const float* __restrict__ rowss, const float* __restrict__ gain, const float* __restrict__ mod, signed char* __restrict__ Q, float* __restrict__ SA, float* __restrict__ SACT, const float* __restrict__ wnmax) {
    const int tid = threadIdx.x, lane = tid & 63, wave = tid >> 6;
    const int gw = blockIdx.x * NWAVES + wave, NGW = gridDim.x * NWAVES, wpb = NGW / NB;
    if (wpb * NB != NGW || gw >= wpb * NB) return;
    const int b = gw / wpb, wi = gw % wpb;
    float mg[2][8], sh[2][8];
#pragma unroll
    for (int j = 0; j < 2; ++j) { const int k = 8 * lane + 512 * j;
#pragma unroll
        for (int h = 0; h < 2; ++h) { const f32x4 g = *(const f32x4*)(gain + k + 4 * h), sc = *(const f32x4*)(mod + b * NADA + 4 * DM + k + 4 * h), s2 = *(const f32x4*)(mod + b * NADA + 3 * DM + k + 4 * h);
            mg[j][4 * h] = g.x * (1.f + sc.x); mg[j][4 * h + 1] = g.y * (1.f + sc.y); mg[j][4 * h + 2] = g.z * (1.f + sc.z); mg[j][4 * h + 3] = g.w * (1.f + sc.w);
            sh[j][4 * h] = s2.x; sh[j][4 * h + 1] = s2.y; sh[j][4 * h + 2] = s2.z; sh[j][4 * h + 3] = s2.w; } }
    const float wprod = wnmax[0] * wnmax[1] * (1.f / 440.f);
    u32x4 qn[2]; float rsn;
    { const size_t m0 = (size_t)b * SEQ + wi; const u32x4* xr = (const u32x4*)(X1B + m0 * DM) + lane; qn[0] = xr[0]; qn[1] = xr[64]; rsn = rowss[m0]; }
    for (int t = wi; t < SEQ; t += wpb) {
        const size_t m = (size_t)b * SEQ + t;
        const u32x4 q0 = qn[0], q1 = qn[1]; const float rstd = rsqrtf(rsn * (1.f / DM) + RMS_EPS);
        if (t + wpb < SEQ) { const u32x4* xr = (const u32x4*)(X1B + (m + wpb) * DM) + lane; qn[0] = xr[0]; qn[1] = xr[64]; rsn = rowss[m + wpb]; }
        float v[2][8]; float amax = 0.f, vss = 0.f;
#pragma unroll
        for (int j = 0; j < 2; ++j) { const u32x4 q = j ? q1 : q0; const unsigned w[4] = {q.x, q.y, q.z, q.w};
#pragma unroll
            for (int e = 0; e < 8; ++e) { const float x = __uint_as_float((e & 1) ? (w[e >> 1] & 0xffff0000u) : (w[e >> 1] << 16));
                v[j][e] = x * rstd * mg[j][e] + sh[j][e]; amax = fmaxf(amax, fabsf(v[j][e])); vss += v[j][e] * v[j][e]; } }
        amax = wave_max_dpp(amax); vss = wave_sum_dpp(vss);
        const float inv = (amax > 0.f) ? 127.f / amax : 0.f;
        u32x2* q8 = (u32x2*)(Q + m * DM) + lane;
#pragma unroll
        for (int j = 0; j < 2; ++j) { unsigned pk[2];
#pragma unroll
            for (int d = 0; d < 2; ++d) { unsigned p = 0u;
#pragma unroll
                for (int e = 0; e < 4; ++e) p |= ((unsigned)(int)rintf(v[j][4 * d + e] * inv) & 0xffu) << (8 * e);
                pk[d] = p; }
            q8[64 * j] = u32x2{pk[0], pk[1]}; }
        if (lane == 0) { const float sa = (amax > 0.f) ? amax * (1.f / 127.f) : 1.f; SA[m] = sa;
            const float hn = sqrtf(vss) * 1.0001f + 16.f * sa;
            const float bd = hn * hn * wprod; SACT[m] = (bd > 0.f) ? bd : 1.f; }
    }
}

__device__ __forceinline__ void norm_dual_phase(const float* __restrict__ X, const float* __restrict__ gain, const float* __restrict__ mod, int shift_off, int scale_off, bf16* __restrict__ O, signed char* __restrict__ Q, float* __restrict__ SA) {
    const int tid = threadIdx.x, lane = tid & 63, wave = tid >> 6;
    const int gw = blockIdx.x * NWAVES + wave, NGW = gridDim.x * NWAVES, wpb = NGW / NB;
    if (wpb * NB != NGW || gw >= wpb * NB) return;
    const int b = gw / wpb, wi = gw % wpb;
    f32x4 mg[4], sh[4];
#pragma unroll
    for (int q = 0; q < 4; ++q) { const int k = 8 * lane + 512 * (q >> 1) + 4 * (q & 1);
        const f32x4 g = *(const f32x4*)(gain + k), sc = *(const f32x4*)(mod + b * NADA + scale_off + k); sh[q] = *(const f32x4*)(mod + b * NADA + shift_off + k);
        mg[q] = f32x4{g.x * (1.f + sc.x), g.y * (1.f + sc.y), g.z * (1.f + sc.z), g.w * (1.f + sc.w)}; }
    f32x4 vn[4];
    { const f32x4* xr = (const f32x4*)(X + ((size_t)b * SEQ + wi) * DM) + 2 * lane;
#pragma unroll
      for (int j = 0; j < 2; ++j) { vn[2 * j] = xr[128 * j]; vn[2 * j + 1] = xr[128 * j + 1]; } }
    for (int t = wi; t < SEQ; t += wpb) {
        const size_t m = (size_t)b * SEQ + t;
        f32x4 v[4]; float s = 0.f;
#pragma unroll
        for (int j = 0; j < 4; ++j) { v[j] = vn[j]; s += (v[j].x * v[j].x + v[j].y * v[j].y) + (v[j].z * v[j].z + v[j].w * v[j].w); }
        if (t + wpb < SEQ) { const f32x4* xr = (const f32x4*)(X + (m + wpb) * DM) + 2 * lane;
#pragma unroll
            for (int j = 0; j < 2; ++j) { vn[2 * j] = xr[128 * j]; vn[2 * j + 1] = xr[128 * j + 1]; } }
        const float rstd = rsqrtf(wave_sum_dpp(s) * (1.f / DM) + RMS_EPS);
        float amax = 0.f;
#pragma unroll
        for (int q = 0; q < 4; ++q) {
            v[q].x = v[q].x * rstd * mg[q].x + sh[q].x; v[q].y = v[q].y * rstd * mg[q].y + sh[q].y; v[q].z = v[q].z * rstd * mg[q].z + sh[q].z; v[q].w = v[q].w * rstd * mg[q].w + sh[q].w;
            amax = fmaxf(fmaxf(amax, fmaxf(fabsf(v[q].x), fabsf(v[q].y))), fmaxf(fabsf(v[q].z), fabsf(v[q].w)));
        }
        u32x4* o16 = (u32x4*)(O + m * DM) + lane;
#pragma unroll
        for (int j = 0; j < 2; ++j) o16[64 * j] = u32x4{cvt_pk(v[2 * j].x, v[2 * j].y), cvt_pk(v[2 * j].z, v[2 * j].w), cvt_pk(v[2 * j + 1].x, v[2 * j + 1].y), cvt_pk(v[2 * j + 1].z, v[2 * j + 1].w)};
        amax = wave_max_dpp(amax);
        const float inv = (amax > 0.f) ? 127.f / amax : 0.f;
        u32x2* q8 = (u32x2*)(Q + m * DM) + lane;
#pragma unroll
        for (int j = 0; j < 2; ++j) { unsigned pk[2];
#pragma unroll
            for (int d = 0; d < 2; ++d) { const f32x4 tt = v[2 * j + d]; const int q0 = (int)rintf(tt.x * inv), q1 = (int)rintf(tt.y * inv), q2 = (int)rintf(tt.z * inv), q3 = (int)rintf(tt.w * inv);
                pk[d] = ((unsigned)q0 & 0xffu) | (((unsigned)q1 & 0xffu) << 8) | (((unsigned)q2 & 0xffu) << 16) | (((unsigned)q3 & 0xffu) << 24); }
            q8[64 * j] = u32x2{pk[0], pk[1]}; }
        if (lane == 0) SA[m] = (amax > 0.f) ? amax * (1.f / 127.f) : 1.f;
    }
}

typedef const pg8::f32x4 (&AccRef)[2][2][4][2];

template <bool I8> struct EpiProj {
    static constexpr bool PERM = true, AFTER_DRAIN = false;
    unsigned char* ws; const float *g_q_a, *g_ks_a, *g_kw_a, *g_q_b, *g_k_b;
    __device__ __forceinline__ void operator()(AccRef acc_c, const pg8::Unit& u, int wr, int wc, int fr, int fq) const {
        const int T = I8 ? tmap_i8(u.pn) : tmap_bf(u.pn), row0 = u.pm * 256 + wr * 64 + fr, b = (u.pm * 256) >> 11;
        pg8::f32x4 (&acc)[2][2][4][2] = const_cast<pg8::f32x4 (&)[2][2][4][2]>(acc_c);
        if (I8) {
            const float* SA = (const float*)(ws + WS_SA1); const float* SB = (const float*)(ws + WS_SBWIN) + u.pn * 256 + wc * 32 + 8 * fq;
            f32x4 sb[2][2];
#pragma unroll
            for (int bj = 0; bj < 2; ++bj)
#pragma unroll
                for (int n = 0; n < 2; ++n) sb[bj][n] = *(const f32x4*)(SB + bj * 128 + 4 * n);
#pragma unroll
            for (int ai = 0; ai < 2; ++ai)
#pragma unroll
                for (int m = 0; m < 4; ++m) { const float sa = SA[row0 + ai * 128 + m * 16];
#pragma unroll
                    for (int bj = 0; bj < 2; ++bj)
#pragma unroll
                        for (int n = 0; n < 2; ++n) { acc[ai][bj][m][n][0] *= sa * sb[bj][n].x; acc[ai][bj][m][n][1] *= sa * sb[bj][n].y; acc[ai][bj][m][n][2] *= sa * sb[bj][n].z; acc[ai][bj][m][n][3] *= sa * sb[bj][n].w; } }
        }
        if (T >= 10) {
            unsigned char* G = ws + (T >= 14 ? WS_GB : WS_GA); const int cbase = ((T - 10) & 3) * 256 + wc * 32 + 8 * fq;
#pragma unroll
            for (int ai = 0; ai < 2; ++ai)
#pragma unroll
                for (int m = 0; m < 4; ++m) { const size_t row = row0 + ai * 128 + m * 16;
#pragma unroll
                    for (int bj = 0; bj < 2; ++bj) { const pg8::f32x4 v0 = acc[ai][bj][m][0], v1 = acc[ai][bj][m][1];
                        int w0 = __builtin_amdgcn_cvt_pk_fp8_f32(256.f * sigmoidf_(v0[0]), 256.f * sigmoidf_(v0[1]), 0, false); w0 = __builtin_amdgcn_cvt_pk_fp8_f32(256.f * sigmoidf_(v0[2]), 256.f * sigmoidf_(v0[3]), w0, true);
                        int w1 = __builtin_amdgcn_cvt_pk_fp8_f32(256.f * sigmoidf_(v1[0]), 256.f * sigmoidf_(v1[1]), 0, false); w1 = __builtin_amdgcn_cvt_pk_fp8_f32(256.f * sigmoidf_(v1[2]), 256.f * sigmoidf_(v1[3]), w1, true);
                        *(u32x2*)(G + row * 1024 + cbase + bj * 128) = u32x2{(unsigned)w0, (unsigned)w1}; } }
            return;
        }
        const int slot = wc;
        if (T == 7 && slot == 3) {
            float* GN = (float*)(ws + WS_GN); float* IW = (float*)(ws + WS_IW);
#pragma unroll
            for (int ai = 0; ai < 2; ++ai)
#pragma unroll
                for (int m = 0; m < 4; ++m) { const size_t row = row0 + ai * 128 + m * 16; const pg8::f32x4 v0 = acc[ai][0][m][0], v1 = acc[ai][0][m][1];
                    if (fq < 3) { f32x4 a0 = {sigmoidf_(v0[0]), sigmoidf_(v0[1]), sigmoidf_(v0[2]), sigmoidf_(v0[3])}, a1 = {sigmoidf_(v1[0]), sigmoidf_(v1[1]), sigmoidf_(v1[2]), sigmoidf_(v1[3])};
                        *(f32x4*)(GN + row * 24 + 8 * fq) = a0; *(f32x4*)(GN + row * 24 + 8 * fq + 4) = a1; }
                    else { const float s = 0.35355339059327373f; f32x4 a0 = {v0[0] * s, v0[1] * s, v0[2] * s, v0[3] * s}, a1 = {v1[0] * s, v1[1] * s, v1[2] * s, v1[3] * s};
                        *(f32x4*)(IW + row * 8) = a0; *(f32x4*)(IW + row * 8 + 4) = a1; } }
            return;
        }
        const float* gain = nullptr; float scale = 1.f; bf16* dst; size_t pitch, extra;
        switch (T) {
            case 0: case 1: gain = g_q_a; scale = QSCALE; dst = (bf16*)(ws + WS_QA); pitch = 512; extra = (size_t)(T * 4 + slot) * 64; break;
            case 5: case 6: gain = g_q_b; scale = QSCALE; dst = (bf16*)(ws + WS_QB); pitch = 512; extra = (size_t)((T - 5) * 4 + slot) * 64; break;
            case 8: case 9: scale = 0.125f; dst = (bf16*)(ws + WS_IQ); pitch = 512; extra = (size_t)((T - 8) * 4 + slot) * 64; break;
            case 2: dst = (bf16*)(ws + (slot < 2 ? WS_KC : WS_VC)); pitch = 64; extra = (size_t)(b + (slot & 1)) * SEQ * 64; break;
            case 3: if (slot < 2) gain = g_ks_a; dst = (bf16*)(ws + (slot < 2 ? WS_KS : WS_VS)); pitch = 64; extra = (size_t)(b + (slot & 1)) * SEQ * 64; break;
            case 4: if (slot < 2) gain = g_kw_a; dst = (bf16*)(ws + (slot < 2 ? WS_KW : WS_VW)); pitch = 64; extra = (size_t)(b + (slot & 1)) * SEQ * 64; break;
            default: if (slot == 0) gain = g_k_b; dst = (bf16*)(ws + (slot == 0 ? WS_KB : (slot == 1 ? WS_VB : WS_IK))); pitch = 64; extra = 0; break;
        }
        const int vidx = ((T == 3 || T == 4) && slot >= 2) ? (T - 2) : ((T == 7 && slot == 1) ? 3 : -1);
        float vmx = 0.f;
        float gv[2][8];
#pragma unroll
        for (int bj = 0; bj < 2; ++bj)
#pragma unroll
            for (int e = 0; e < 8; ++e) gv[bj][e] = gain ? gain[32 * bj + 8 * fq + e] * scale : scale;
#pragma unroll
        for (int ai = 0; ai < 2; ++ai)
#pragma unroll
            for (int m = 0; m < 4; ++m) { const size_t row = row0 + ai * 128 + m * 16;
                float rstd = 1.f;
                if (gain) { float ss = 0.f;
#pragma unroll
                    for (int bj = 0; bj < 2; ++bj)
#pragma unroll
                        for (int n = 0; n < 2; ++n) { const pg8::f32x4 v = acc[ai][bj][m][n]; ss += (v[0] * v[0] + v[1] * v[1]) + (v[2] * v[2] + v[3] * v[3]); }
                    ss += __shfl_xor(ss, 16); ss += __shfl_xor(ss, 32);
                    rstd = rsqrtf(ss * (1.f / 64.f) + RMS_EPS); }
#pragma unroll
                for (int bj = 0; bj < 2; ++bj) { const pg8::f32x4 v0 = acc[ai][bj][m][0], v1 = acc[ai][bj][m][1]; u32x4 w;
                    w.x = cvt_pk(v0[0] * rstd * gv[bj][0], v0[1] * rstd * gv[bj][1]); w.y = cvt_pk(v0[2] * rstd * gv[bj][2], v0[3] * rstd * gv[bj][3]);
                    w.z = cvt_pk(v1[0] * rstd * gv[bj][4], v1[1] * rstd * gv[bj][5]); w.w = cvt_pk(v1[2] * rstd * gv[bj][6], v1[3] * rstd * gv[bj][7]);
                    if (vidx >= 0) vmx = fmaxf(fmaxf(fmaxf(vmx, fmaxf(fabsf(v0[0]), fabsf(v0[1]))), fmaxf(fabsf(v0[2]), fabsf(v0[3]))), fmaxf(fmaxf(fabsf(v1[0]), fabsf(v1[1])), fmaxf(fabsf(v1[2]), fabsf(v1[3]))));
                    *(u32x4*)(dst + row * pitch + extra + 32 * bj + 8 * fq) = w; } }
        if (vidx >= 0) { vmx = wave_max_dpp(vmx) * 1.004f; if ((threadIdx.x & 63) == 0) atomicMax((unsigned*)(ws + WS_VMAX) + vidx, __float_as_uint(vmx)); }
    }
};

template <bool SECOND> struct EpiY {
    static constexpr bool PERM = true, AFTER_DRAIN = false;
    const unsigned char* G; bf16* Y; unsigned char* Y8; const float* rna; const float* rnb; const float* wn; float so; const float* sbw;
    __device__ __forceinline__ void operator()(AccRef acc, const pg8::Unit& u, int wr, int wc, int fr, int fq) const {
        const int row0 = u.pm * 256 + wr * 64 + fr, col0 = u.pn * 256 + wc * 32 + 8 * fq;
        float cs[2][8];
#pragma unroll
        for (int bj = 0; bj < 2; ++bj) { const f32x4 c0 = *(const f32x4*)(sbw + col0 + bj * 128), c1 = *(const f32x4*)(sbw + col0 + bj * 128 + 4);
            const float so_ = so * (1.f / 256.f);
            cs[bj][0] = c0.x * so_; cs[bj][1] = c0.y * so_; cs[bj][2] = c0.z * so_; cs[bj][3] = c0.w * so_; cs[bj][4] = c1.x * so_; cs[bj][5] = c1.y * so_; cs[bj][6] = c1.z * so_; cs[bj][7] = c1.w * so_; }
        float wa = 0.f, wb = 0.f; if (SECOND) { wa = wn[2]; wb = wn[3]; }
        const unsigned gb0 = (unsigned)row0 * 2048u + (unsigned)col0 * 2u;
        u32x2 gq[2][2][2]; u32x4 yq[2][2]; float ra[2], rb[2]; u32x4 o16[2][2]; u32x2 o8[2][2];
#define EPIY_ROW(qd, mm) ((unsigned)(((qd) >> 1) * 128 + (((qd) & 1) * 2 + (mm)) * 16))
#define EPIY_LOAD(qd, B) { _Pragma("unroll") for (int mm = 0; mm < 2; ++mm) { const unsigned rr = EPIY_ROW(qd, mm); \
            _Pragma("unroll") for (int bj = 0; bj < 2; ++bj) gq[B][mm][bj] = *(const u32x2*)(G + ((gb0 + rr * 2048u + (unsigned)bj * 256u) >> 1)); } }
#define EPIY_LOADY(qd) { if (SECOND) { _Pragma("unroll") for (int mm = 0; mm < 2; ++mm) { const unsigned rr = EPIY_ROW(qd, mm); \
            ra[mm] = *(const float*)((const char*)rna + ((unsigned)row0 + rr) * 4u); rb[mm] = *(const float*)((const char*)rnb + ((unsigned)row0 + rr) * 4u); \
            _Pragma("unroll") for (int bj = 0; bj < 2; ++bj) yq[mm][bj] = *(const u32x4*)((const char*)Y + (gb0 + rr * 2048u + (unsigned)bj * 256u)); } } }
#define EPIY_COMPUTE(qd, B) { _Pragma("unroll") for (int mm = 0; mm < 2; ++mm) { float is_ = 0.f; if (SECOND) is_ = __builtin_amdgcn_rcpf(sy_scale(ra[mm], rb[mm], wa, wb)); \
            _Pragma("unroll") for (int bj = 0; bj < 2; ++bj) { \
            const u32x2 g2 = gq[B][mm][bj]; u32x4 y4 = {0u, 0u, 0u, 0u}; if (SECOND) y4 = yq[mm][bj]; \
            typedef float f32x2g __attribute__((ext_vector_type(2))); \
            const f32x2g ga_ = __builtin_amdgcn_cvt_pk_f32_fp8((int)g2.x, false), gb_ = __builtin_amdgcn_cvt_pk_f32_fp8((int)g2.x, true), gc_ = __builtin_amdgcn_cvt_pk_f32_fp8((int)g2.y, false), gd_ = __builtin_amdgcn_cvt_pk_f32_fp8((int)g2.y, true); \
            const float gf[8] = {ga_.x, ga_.y, gb_.x, gb_.y, gc_.x, gc_.y, gd_.x, gd_.y}; \
            const pg8::f32x4 v0 = acc[(qd) >> 1][bj][((qd) & 1) * 2 + mm][0], v1 = acc[(qd) >> 1][bj][((qd) & 1) * 2 + mm][1]; float r[8]; \
            const unsigned yw[4] = {y4.x, y4.y, y4.z, y4.w}; \
            _Pragma("unroll") for (int e = 0; e < 8; ++e) { const float a_ = ((e < 4) ? v0[e] : v1[e - 4]) * cs[bj][e]; \
                const float gg = gf[e]; \
                const float yy = __uint_as_float((e & 1) ? (yw[e >> 1] & 0xffff0000u) : (yw[e >> 1] << 16)); \
                r[e] = gg * a_ + (SECOND ? yy : 0.f); } \
            if (SECOND) { \
                int w0 = __builtin_amdgcn_cvt_pk_fp8_f32(r[0] * is_, r[1] * is_, 0, false); w0 = __builtin_amdgcn_cvt_pk_fp8_f32(r[2] * is_, r[3] * is_, w0, true); \
                int w1 = __builtin_amdgcn_cvt_pk_fp8_f32(r[4] * is_, r[5] * is_, 0, false); w1 = __builtin_amdgcn_cvt_pk_fp8_f32(r[6] * is_, r[7] * is_, w1, true); \
                o8[mm][bj] = u32x2{(unsigned)w0, (unsigned)w1}; } \
            else { o16[mm][bj].x = cvt_pk(r[0], r[1]); o16[mm][bj].y = cvt_pk(r[2], r[3]); o16[mm][bj].z = cvt_pk(r[4], r[5]); o16[mm][bj].w = cvt_pk(r[6], r[7]); } } } \
        if (SECOND) asm volatile("" :: "v"(o8[0][0]), "v"(o8[0][1]), "v"(o8[1][0]), "v"(o8[1][1]) : "memory"); \
        else asm volatile("" :: "v"(o16[0][0]), "v"(o16[0][1]), "v"(o16[1][0]), "v"(o16[1][1]) : "memory"); }
#define EPIY_STORE(qd) { _Pragma("unroll") for (int mm = 0; mm < 2; ++mm) _Pragma("unroll") for (int bj = 0; bj < 2; ++bj) { const unsigned ob = gb0 + EPIY_ROW(qd, mm) * 2048u + (unsigned)bj * 256u; \
            if (SECOND) *(u32x2*)(Y8 + (ob >> 1)) = o8[mm][bj]; else *(u32x4*)((char*)Y + ob) = o16[mm][bj]; } }
        EPIY_LOAD(0, 0) EPIY_LOAD(1, 1) EPIY_LOADY(0)
        EPIY_COMPUTE(0, 0) EPIY_LOAD(2, 0) EPIY_LOADY(1) EPIY_STORE(0)
        EPIY_COMPUTE(1, 1) EPIY_LOAD(3, 1) EPIY_LOADY(2) EPIY_STORE(1)
        EPIY_COMPUTE(2, 0) EPIY_LOADY(3) EPIY_STORE(2)
        EPIY_COMPUTE(3, 1) EPIY_STORE(3)
#undef EPIY_ROW
#undef EPIY_LOAD
#undef EPIY_LOADY
#undef EPIY_COMPUTE
#undef EPIY_STORE
    }
};

struct EpiX1 {
    static constexpr bool PERM = true, AFTER_DRAIN = false;
    const float* X; bf16* X1B; float* rowss; const float* mod; const float* rna; const float* rnb; const float* wn; const float* SBO;
    __device__ __forceinline__ void operator()(AccRef acc, const pg8::Unit& u, int wr, int wc, int fr, int fq) const {
        const int row0 = u.pm * 256 + wr * 64 + fr, col0 = u.pn * 256 + wc * 32 + 8 * fq, b = (u.pm * 256) >> 11;
        f32x4 gt[2][2];
#pragma unroll
        for (int bj = 0; bj < 2; ++bj)
#pragma unroll
            for (int n = 0; n < 2; ++n) { const f32x4 g = *(const f32x4*)(mod + b * NADA + 2 * DM + col0 + bj * 128 + 4 * n), sb = *(const f32x4*)(SBO + col0 + bj * 128 + 4 * n);
                gt[bj][n] = f32x4{g.x * sb.x, g.y * sb.y, g.z * sb.z, g.w * sb.w}; }
        const float wa = wn[2], wb = wn[3];
#pragma unroll
        for (int ai = 0; ai < 2; ++ai)
#pragma unroll
            for (int m = 0; m < 4; ++m) { const size_t row = row0 + ai * 128 + m * 16; float ss = 0.f; const float sy = sy_scale(rna[row], rnb[row], wa, wb);
#pragma unroll
                for (int bj = 0; bj < 2; ++bj) { const size_t off = row * 1024 + col0 + bj * 128; float x1[8];
#pragma unroll
                    for (int n = 0; n < 2; ++n) { const f32x4 xv = *(const f32x4*)(X + off + 4 * n); pg8::f32x4 v = acc[ai][bj][m][n]; v[0] *= sy; v[1] *= sy; v[2] *= sy; v[3] *= sy;
                        x1[4 * n] = xv.x + gt[bj][n].x * v[0]; x1[4 * n + 1] = xv.y + gt[bj][n].y * v[1]; x1[4 * n + 2] = xv.z + gt[bj][n].z * v[2]; x1[4 * n + 3] = xv.w + gt[bj][n].w * v[3]; }
#pragma unroll
                    for (int e2 = 0; e2 < 8; ++e2) ss += x1[e2] * x1[e2];
                    u32x4 w1; w1.x = cvt_pk(x1[0], x1[1]); w1.y = cvt_pk(x1[2], x1[3]); w1.z = cvt_pk(x1[4], x1[5]); w1.w = cvt_pk(x1[6], x1[7]);
                    *(u32x4*)(X1B + off) = w1; }
                ss += __shfl_xor(ss, 16); ss += __shfl_xor(ss, 32);
                if (fq == 0) unsafeAtomicAdd(rowss + row, ss); }
    }
};

struct EpiOut {
    static constexpr bool PERM = true, AFTER_DRAIN = false;
    const bf16* X1B; float* OUT; const float* mod; const float* SACT; const float* SBD;
    __device__ __forceinline__ void operator()(AccRef acc, const pg8::Unit& u, int wr, int wc, int fr, int fq) const {
        const int row0 = u.pm * 256 + wr * 64 + fr, col0 = u.pn * 256 + wc * 32 + 8 * fq, b = (u.pm * 256) >> 11;
        f32x4 gt[2][2];
#pragma unroll
        for (int bj = 0; bj < 2; ++bj)
#pragma unroll
            for (int n = 0; n < 2; ++n) { const f32x4 g = *(const f32x4*)(mod + b * NADA + 5 * DM + col0 + bj * 128 + 4 * n), sb = *(const f32x4*)(SBD + col0 + bj * 128 + 4 * n);
                gt[bj][n] = f32x4{g.x * sb.x, g.y * sb.y, g.z * sb.z, g.w * sb.w}; }
#pragma unroll
        for (int ai = 0; ai < 2; ++ai)
#pragma unroll
            for (int m = 0; m < 4; ++m) { const size_t row = row0 + ai * 128 + m * 16; const float sa = SACT[row];
#pragma unroll
                for (int bj = 0; bj < 2; ++bj) { const size_t off = row * 1024 + col0 + bj * 128;
                    const u32x4 xq = *(const u32x4*)(X1B + off); const unsigned xw[4] = {xq.x, xq.y, xq.z, xq.w};
#pragma unroll
                    for (int n = 0; n < 2; ++n) { pg8::f32x4 v = acc[ai][bj][m][n]; v[0] *= sa; v[1] *= sa; v[2] *= sa; v[3] *= sa;
                        const float x0 = __uint_as_float(xw[2 * n] << 16), x1 = __uint_as_float(xw[2 * n] & 0xffff0000u), x2 = __uint_as_float(xw[2 * n + 1] << 16), x3 = __uint_as_float(xw[2 * n + 1] & 0xffff0000u);
                        f32x4 o = {x0 + gt[bj][n].x * v[0], x1 + gt[bj][n].y * v[1], x2 + gt[bj][n].z * v[2], x3 + gt[bj][n].w * v[3]};
                        *(f32x4*)(OUT + off + 4 * n) = o; } } }
    }
};

struct PairOrder {
    pg8::StaticOrder base;
    __device__ __forceinline__ void init(int G, int c) { base.init(MROWS, DM, G, c); }
    __device__ __forceinline__ bool next(int i, pg8::Unit& u) const { if (!base.next(i >> 1, u)) return false; if (i & 1) { u.pm += 256; u.pn += 4; } return true; }
    __device__ __forceinline__ void a_ready(const pg8::Unit&) const {}
    __device__ __forceinline__ void done(const pg8::Unit&) const {}
};
struct EpiYPair {
    static constexpr bool PERM = true, AFTER_DRAIN = false;
    const unsigned char* GA; const unsigned char* GB; bf16* Y; unsigned char* Y8; const float* rna; const float* rnb; const float* wn; const float* vm; const float* sbwo;
    __device__ __forceinline__ void operator()(AccRef acc, const pg8::Unit& u, int wr, int wc, int fr, int fq) const {
        if (u.pm < 256) { EpiY<false> E{GA, Y, Y8, rna, rnb, wn, so_scale_a(vm), sbwo}; E(acc, u, wr, wc, fr, fq); }
        else { pg8::Unit v; v.pm = u.pm - 256; v.pn = u.pn - 4; EpiY<true> E{GB, Y, Y8, rna, rnb, wn, so_scale_b(vm), sbwo + 1024}; E(acc, v, wr, wc, fr, fq); }
    }
};

struct EpiAct3 {
    static constexpr bool PERM = true, AFTER_DRAIN = false, KEEPS = false;
    unsigned char* ACT; const float* SA; const float* SB; const float* SACT;
    __device__ __forceinline__ void operator()(AccRef acc, const pg8::Unit& u, int wr, int wc, int fr, int fq) const {
        const int row0 = u.pm * 256 + wr * 64 + fr, col0 = u.pn * 128 + wc * 32 + 8 * fq;
        const float* sb = SB + u.pn * 256 + wc * 32 + 8 * fq;
        const f32x4 g0 = *(const f32x4*)(sb), g1 = *(const f32x4*)(sb + 4), u0 = *(const f32x4*)(sb + 128), u1 = *(const f32x4*)(sb + 132);
        const float sg[8] = {g0.x, g0.y, g0.z, g0.w, g1.x, g1.y, g1.z, g1.w}, su[8] = {u0.x, u0.y, u0.z, u0.w, u1.x, u1.y, u1.z, u1.w};
#pragma unroll
        for (int ai = 0; ai < 2; ++ai)
#pragma unroll
            for (int m = 0; m < 4; ++m) { const size_t row = row0 + ai * 128 + m * 16; float r[8]; const float sa = SA[row], ia = __builtin_amdgcn_rcpf(SACT[row]);
#pragma unroll
                for (int n = 0; n < 2; ++n)
#pragma unroll
                    for (int e = 0; e < 4; ++e) { const float g = acc[ai][0][m][n][e] * (sa * sg[4 * n + e]), up = acc[ai][1][m][n][e] * (sa * su[4 * n + e]); r[4 * n + e] = siluf_(g) * (up * ia); }
                int w0 = __builtin_amdgcn_cvt_pk_fp8_f32(r[0], r[1], 0, false); w0 = __builtin_amdgcn_cvt_pk_fp8_f32(r[2], r[3], w0, true);
                int w1 = __builtin_amdgcn_cvt_pk_fp8_f32(r[4], r[5], 0, false); w1 = __builtin_amdgcn_cvt_pk_fp8_f32(r[6], r[7], w1, true);
                *(u32x2*)(ACT + row * DFF + col0) = u32x2{(unsigned)w0, (unsigned)w1}; }
    }
};


#define MFMA32(a, b, c) __builtin_amdgcn_mfma_f32_32x32x16_bf16(a, b, c, 0, 0, 0)
#define LDS_BARRIER() asm volatile("s_waitcnt lgkmcnt(0)\n\ts_barrier" ::: "memory")
__device__ __forceinline__ int crow(int r, int hi) { return (r & 3) + 8 * (r >> 2) + 4 * hi; }

__device__ __forceinline__ void compress_phase(const Args& a, LAS unsigned char* lds) {
    const int tid = threadIdx.x, lane = tid & 63, wave = __builtin_amdgcn_readfirstlane(tid >> 6), r32 = lane & 31, hi = lane >> 5;
    unsigned char* ws = a.ws;
    constexpr int PITCH = 528, A_OFF = 0, B_OFF = 64 * PITCH;
    LAS float* hid = (LAS float*)lds;
    for (int u = blockIdx.x; u < 256; u += gridDim.x) {
        const int which = u >> 7, bg = (u >> 1) & 63, n0 = (u & 1) * 64;
        const bf16* A = (const bf16*)(ws + (which ? WS_VC : WS_KC)) + ((size_t)bg * SEQ + (size_t)n0 * 16) * 64;
        const bf16* W1 = (const bf16*)(ws + (which ? WS_WCV1 : WS_WCK1));
        const int rb = wave & 1, cb = wave >> 1;
        f32x16 acc = {};
        u32x4 ra[4], rw[8];
#pragma unroll
        for (int i = 0; i < 4; ++i) { const int p = tid + 512 * i, row = p >> 5, c = p & 31; ra[i] = *(const u32x4*)(A + (size_t)row * 1024 + c * 8); }
#pragma unroll
        for (int i = 0; i < 8; ++i) { const int p = tid + 512 * i, row = p >> 5, c = p & 31; rw[i] = *(const u32x4*)(W1 + (size_t)row * 2048 + c * 8); }
        for (int kc = 0; kc < 8; ++kc) {
            __syncthreads();
#pragma unroll
            for (int i = 0; i < 4; ++i) { const int p = tid + 512 * i, row = p >> 5, c = p & 31; *(LAS u32x4*)(lds + A_OFF + row * PITCH + c * 16) = ra[i]; }
#pragma unroll
            for (int i = 0; i < 8; ++i) { const int p = tid + 512 * i, row = p >> 5, c = p & 31; *(LAS u32x4*)(lds + B_OFF + row * PITCH + c * 16) = rw[i]; }
            if (kc < 7) {
#pragma unroll
                for (int i = 0; i < 4; ++i) { const int p = tid + 512 * i, row = p >> 5, c = p & 31; ra[i] = *(const u32x4*)(A + (size_t)row * 1024 + (kc + 1) * 256 + c * 8); }
#pragma unroll
                for (int i = 0; i < 8; ++i) { const int p = tid + 512 * i, row = p >> 5, c = p & 31; rw[i] = *(const u32x4*)(W1 + (size_t)row * 2048 + (kc + 1) * 256 + c * 8); }
            }
            LDS_BARRIER();
            const LAS unsigned char* ap = lds + A_OFF + (rb * 32 + r32) * PITCH + hi * 16;
            const LAS unsigned char* bp = lds + B_OFF + (cb * 32 + r32) * PITCH + hi * 16;
#pragma unroll
            for (int ks = 0; ks < 16; ++ks) acc = MFMA32(*(const LAS bf16x8*)(ap + ks * 32), *(const LAS bf16x8*)(bp + ks * 32), acc);
        }
        __syncthreads();
        { float bias = 0.f;
#pragma unroll
          for (int q = 0; q < 8; ++q) bias += ((const float*)(ws + WS_BIAS))[(which * 8 + q) * 128 + cb * 32 + r32];
#pragma unroll
          for (int r = 0; r < 16; ++r) hid[(rb * 32 + crow(r, hi)) * 132 + cb * 32 + r32] = siluf_(acc[r] + bias); }
        __syncthreads();
        { const int row = tid >> 3, dc = (tid & 7) * 8; const float* w2 = a.in[which ? I_WCV2 : I_WCK2];
          float o[8];
#pragma unroll
          for (int j = 0; j < 8; ++j) o[j] = 0.f;
#pragma unroll 8
          for (int k = 0; k < 128; ++k) { const float h = hid[row * 132 + k]; const f32x4 wa = *(const f32x4*)(w2 + k * 64 + dc), wb = *(const f32x4*)(w2 + k * 64 + dc + 4);
              o[0] += h * wa.x; o[1] += h * wa.y; o[2] += h * wa.z; o[3] += h * wa.w; o[4] += h * wb.x; o[5] += h * wb.y; o[6] += h * wb.z; o[7] += h * wb.w; }
          if (!which) { float ss = 0.f;
#pragma unroll
              for (int j = 0; j < 8; ++j) ss += o[j] * o[j];
              ss += __shfl_xor(ss, 1); ss += __shfl_xor(ss, 2); ss += __shfl_xor(ss, 4);
              const float rstd = rsqrtf(ss * (1.f / 64.f) + RMS_EPS); const float* gk = a.in[I_GKC];
#pragma unroll
              for (int j = 0; j < 8; ++j) o[j] = o[j] * rstd * gk[dc + j]; }
          const int n = n0 + row;
          if (n >= 127) {
#pragma unroll
              for (int j = 0; j < 8; ++j) o[j] = 0.f; }
          u32x4 w; w.x = cvt_pk(o[0], o[1]); w.y = cvt_pk(o[2], o[3]); w.z = cvt_pk(o[4], o[5]); w.w = cvt_pk(o[6], o[7]);
          if (which) { float vmx = 0.f;
#pragma unroll
              for (int j = 0; j < 8; ++j) vmx = fmaxf(vmx, fabsf(o[j]));
              vmx = wave_max_dpp(vmx) * 1.004f; if (lane == 0) atomicMax((unsigned*)(ws + WS_VMAX), __float_as_uint(vmx)); }
          *(u32x4*)((bf16*)(ws + (which ? WS_VCO : WS_KCO)) + ((size_t)bg * 128 + n) * 64 + dc) = w; }
    }
    __syncthreads();
}

typedef LAS const char* lds_cptr;
__device__ __forceinline__ s16x4 vtr(lds_cptr p) { return __builtin_bit_cast(s16x4, __builtin_amdgcn_ds_read_tr16_b64_v4i16((LAS v4i16_t*)p)); }

struct FlashSt { f32x16 o0, o1; float m, l; };

__device__ __forceinline__ void flash_init(FlashSt& st) { st.o0 = f32x16{}; st.o1 = f32x16{}; st.m = -INFINITY; st.l = 0.f; }

__device__ __forceinline__ void tile_gload(const bf16* __restrict__ Kb, const bf16* __restrict__ Vb, int key0, int tid, u32x4& kr, u32x4& vr) {
    const size_t off = (size_t)(key0 + (tid >> 3)) * 64 + (tid & 7) * 8;
    kr = *(const u32x4*)(Kb + off); vr = *(const u32x4*)(Vb + off);
}
__device__ __forceinline__ void tile_lstore(LAS unsigned char* Kt, LAS unsigned char* Vt, int tid, const u32x4& kr, const u32x4& vr) {
    const int row = tid >> 3, c = tid & 7;
    *(LAS u32x4*)(Kt + c * 1024 + row * 16) = kr;
    *(LAS u32x4*)(Vt + (c >> 2) * 4096 + row * 64 + (c & 3) * 16) = vr;
}

typedef f32x16 CInit;
__device__ __forceinline__ CInit make_cinit(float sl, int hi) { CInit c;
#pragma unroll
    for (int r = 0; r < 16; ++r) c[r] = sl * (float)crow(r, hi);
    return c; }
__device__ __forceinline__ void qk_tile(lds_cptr Kt, const bf16x8 (&qr)[4], const CInit& cinit, f32x16& s0, f32x16& s1, int r32, int hi) {
    const lds_cptr kp = Kt + hi * 1024 + r32 * 16;
    { const bf16x8 k0 = *(const LAS bf16x8*)(kp), k1 = *(const LAS bf16x8*)(kp + 512); s0 = MFMA32(k0, qr[0], cinit); s1 = MFMA32(k1, qr[0], cinit); }
#pragma unroll
    for (int d0 = 1; d0 < 4; ++d0) {
        const bf16x8 k0 = *(const LAS bf16x8*)(kp + d0 * 2048), k1 = *(const LAS bf16x8*)(kp + d0 * 2048 + 512);
        s0 = MFMA32(k0, qr[d0], s0); s1 = MFMA32(k1, qr[d0], s1);
    }
}
__device__ __forceinline__ void pv_tile(lds_cptr Vt, const f32x16& p0, const f32x16& p1, f32x16& o0, f32x16& o1, int lane, int hi) {
    const lds_cptr vp = Vt + ((lane >> 4) & 1) * 32 + (lane & 3) * 8 + (4 * hi + ((lane & 15) >> 2)) * 64;
#pragma unroll
    for (int i = 0; i < 4; ++i) {
        const f32x16& P = (i < 2) ? p0 : p1; const int rb = (i & 1) * 8;
        u32x4 pw; pw.x = cvt_pk(P[rb + 0], P[rb + 1]); pw.y = cvt_pk(P[rb + 2], P[rb + 3]); pw.z = cvt_pk(P[rb + 4], P[rb + 5]); pw.w = cvt_pk(P[rb + 6], P[rb + 7]);
        const bf16x8 pf = __builtin_bit_cast(bf16x8, pw);
        const s16x4 a0 = vtr(vp + i * 1024), a1 = vtr(vp + i * 1024 + 512), b0 = vtr(vp + 4096 + i * 1024), b1 = vtr(vp + 4096 + i * 1024 + 512);
        const bf16x8 v0 = {a0[0], a0[1], a0[2], a0[3], a1[0], a1[1], a1[2], a1[3]}, v1 = {b0[0], b0[1], b0[2], b0[3], b1[0], b1[1], b1[2], b1[3]};
        o0 = MFMA32(v0, pf, o0); o1 = MFMA32(v1, pf, o1);
    }
}
template <bool MASKED, class VF>
__device__ __forceinline__ float flash_probs(lds_cptr Kt, const bf16x8 (&qr)[4], const CInit& cinit, float c32, float off, FlashSt& st, const VF& vf, int lane, f32x16& s0, f32x16& s1) {
    const int r32 = lane & 31, hi = lane >> 5;
    qk_tile(Kt, qr, cinit, s0, s1, r32, hi);
    if (MASKED) {
#pragma unroll
        for (int r = 0; r < 16; ++r) {
            const unsigned m0 = (unsigned)vf(r, 0), m1 = (unsigned)vf(r, 1);
            s0[r] = __uint_as_float((__float_as_uint(s0[r]) & m0) | (0xFF800000u & ~m0)); s1[r] = __uint_as_float((__float_as_uint(s1[r]) & m1) | (0xFF800000u & ~m1)); }
    }
    float m0 = fmaxf(s0[0], s0[1]), m1 = fmaxf(s1[0], s1[1]);
#pragma unroll
    for (int r = 2; r < 16; r += 2) { m0 = fmaxf(fmaxf(m0, s0[r]), s0[r + 1]); m1 = fmaxf(fmaxf(m1, s1[r]), s1[r + 1]); }
    float mx = fmaxf(m0, m1 + c32) + off;
    mx = fmaxf(mx, __shfl_xor(mx, 32));
    const float mnew = fmaxf(st.m, mx), msafe = (mnew == -INFINITY) ? 0.f : mnew;
    const float alpha = __builtin_amdgcn_exp2f(st.m - msafe);
    const float b0 = msafe - off, b1 = b0 - c32;
    { typedef float f32x2 __attribute__((ext_vector_type(2))); const f32x2 nb0 = {-b0, -b0}, nb1 = {-b1, -b1};
#pragma unroll
      for (int r = 0; r < 16; r += 2) { f32x2 a = {s0[r], s0[r + 1]}, c = {s1[r], s1[r + 1]}; a = a + nb0; c = c + nb1;
          s0[r] = __builtin_amdgcn_exp2f(a.x); s0[r + 1] = __builtin_amdgcn_exp2f(a.y); s1[r] = __builtin_amdgcn_exp2f(c.x); s1[r + 1] = __builtin_amdgcn_exp2f(c.y); } }
    float ps;
    { typedef float f32x8 __attribute__((ext_vector_type(8))); typedef float f32x2 __attribute__((ext_vector_type(2)));
      const f32x16 t16 = s0 + s1; const f32x8 t8 = t16.lo + t16.hi; const f32x4 t4 = t8.lo + t8.hi; const f32x2 t2 = t4.lo + t4.hi; ps = t2.x + t2.y; }
    st.l = st.l * alpha + ps; st.m = mnew;
    if (__any(alpha != 1.f)) {
#pragma unroll
        for (int r = 0; r < 16; ++r) { st.o0[r] *= alpha; st.o1[r] *= alpha; }
    }
    return msafe;
}
template <class TI>
__device__ __forceinline__ void flash_loop(const bf16* __restrict__ Kb, const bf16* __restrict__ Vb, int kt_lo, int kt_hi, unsigned long long tmask,
                                           const bf16x8 (&qr)[4], const CInit& cinit, float c32, FlashSt& st, const TI& ti, LAS unsigned char* lds, int tid) {
    const int lane = tid & 63;
    unsigned long long rem = tmask & ((kt_hi >= 63 ? ~0ull : ((1ull << (kt_hi + 1)) - 1ull)) & ~((1ull << kt_lo) - 1ull));
    rem = (unsigned long long)(unsigned)__builtin_amdgcn_readfirstlane((int)(unsigned)rem) | ((unsigned long long)(unsigned)__builtin_amdgcn_readfirstlane((int)(unsigned)(rem >> 32)) << 32);
    int left = __popcll(rem);
    auto pop = [&]() { const int k = (int)__builtin_ctzll(rem); rem &= rem - 1ull; return k; };
    auto compute = [&](int buf, int kt) {
        const lds_cptr Kt = (lds_cptr)(lds + buf * 8192), Vt = (lds_cptr)(lds + 16384 + buf * 8192);
        f32x16 s0, s1; const float off = ti.off(kt);
        if (ti.masked(kt)) { const auto pd = ti.prep(kt); (void)flash_probs<true>(Kt, qr, cinit, c32, off, st, [&](int r, int half) { return ti.valid(pd, r, half); }, lane, s0, s1); }
        else (void)flash_probs<false>(Kt, qr, cinit, c32, off, st, [](int, int) { return -1; }, lane, s0, s1);
        pv_tile(Vt, s0, s1, st.o0, st.o1, lane, lane >> 5);
    };
    if (left == 0) return;
    u32x4 krA, vrA, krB, vrB;
    int k0 = pop(), k1 = k0;
    tile_gload(Kb, Vb, k0 * 64, tid, krA, vrA);
    if (left >= 2) { k1 = pop(); tile_gload(Kb, Vb, k1 * 64, tid, krB, vrB); }
#pragma unroll 1
    while (left >= 4) {
        tile_lstore(lds, lds + 16384, tid, krA, vrA);
        LDS_BARRIER();
        const int k2 = pop(); tile_gload(Kb, Vb, k2 * 64, tid, krA, vrA);
        compute(0, k0);
        tile_lstore(lds + 8192, lds + 16384 + 8192, tid, krB, vrB);
        LDS_BARRIER();
        const int k3 = pop(); tile_gload(Kb, Vb, k3 * 64, tid, krB, vrB);
        compute(1, k1);
        k0 = k2; k1 = k3; left -= 2;
    }
    {
        int k2 = k0;
        tile_lstore(lds, lds + 16384, tid, krA, vrA);
        LDS_BARRIER();
        if (left == 3) { k2 = pop(); tile_gload(Kb, Vb, k2 * 64, tid, krA, vrA); }
        compute(0, k0);
        if (left >= 2) {
            tile_lstore(lds + 8192, lds + 16384 + 8192, tid, krB, vrB);
            LDS_BARRIER();
            compute(1, k1);
        }
        if (left == 3) {
            tile_lstore(lds, lds + 16384, tid, krA, vrA);
            LDS_BARRIER();
            compute(0, k2);
        }
    }
    LDS_BARRIER();
}
__device__ __forceinline__ void flash_finish(const FlashSt& st, float gate, f32x16& t0, f32x16& t1) {
    const float l = st.l + __shfl_xor(st.l, 32);
    const float f = (l > 0.f) ? gate / l : 0.f;
#pragma unroll
    for (int r = 0; r < 16; ++r) { t0[r] += f * st.o0[r]; t1[r] += f * st.o1[r]; }
}
__device__ __forceinline__ void store_o(unsigned char* __restrict__ O, size_t elem_off, const f32x16& t0, const f32x16& t1, int hi, float* __restrict__ rown, float so) {
    const float inv = __builtin_amdgcn_rcpf(so);
    { float ss = 0.f;
#pragma unroll
      for (int r = 0; r < 16; ++r) ss += t0[r] * t0[r] + t1[r] * t1[r];
      ss += __shfl_xor(ss, 32);
      if (hi == 0) unsafeAtomicAdd(rown, ss * 2.26f + 1.3e-4f * so * so); }
#pragma unroll
    for (int q = 0; q < 4; ++q) {
        int w0 = __builtin_amdgcn_cvt_pk_fp8_f32(t0[4 * q] * inv, t0[4 * q + 1] * inv, 0, false); w0 = __builtin_amdgcn_cvt_pk_fp8_f32(t0[4 * q + 2] * inv, t0[4 * q + 3] * inv, w0, true);
        int w1 = __builtin_amdgcn_cvt_pk_fp8_f32(t1[4 * q] * inv, t1[4 * q + 1] * inv, 0, false); w1 = __builtin_amdgcn_cvt_pk_fp8_f32(t1[4 * q + 2] * inv, t1[4 * q + 3] * inv, w1, true);
        *(unsigned*)(O + elem_off + 8 * q + 4 * hi) = (unsigned)w0; *(unsigned*)(O + elem_off + 32 + 8 * q + 4 * hi) = (unsigned)w1;
    }
}

constexpr int L_IMPA = 32768, L_IMPC = 65536, L_IMPF = 98304, L_FAC = 106496, L_SELM = 108544, L_UNION = 108544 + 256, L_IQL = 32768, L_MSK = 65536, L_IWL = 73728;

__device__ __forceinline__ void nsa_unit(const Args& a, LAS unsigned char* lds, int b, int g, int qt) {
    int tid_ = threadIdx.x; asm volatile("" : "+v"(tid_));
    const int tid = tid_, lane = tid & 63, wave = __builtin_amdgcn_readfirstlane(tid >> 6), r32 = lane & 31, hi = lane >> 5;
    unsigned char* ws = a.ws;
    const int rh = wave & 3, th = wave >> 2, head = g * 4 + rh, t0 = qt * 64, tl = th * 32 + r32, token = t0 + tl;
    const size_t row = (size_t)b * SEQ + token;
    bf16x8 qr[4];
#pragma unroll
    for (int d0 = 0; d0 < 4; ++d0) qr[d0] = *(const bf16x8*)((const bf16*)(ws + WS_QA) + row * 512 + head * 64 + 16 * d0 + 8 * hi);
    const float slope2 = __builtin_amdgcn_exp2f(-(float)(head + 1)) * LOG2E;
    const int tokl = tl + 0;
    const float* gn = (const float*)(ws + WS_GN) + row * 24 + head * 3;
    const float g_cmp = gn[0], g_slc = gn[1], g_win = gn[2];
    f32x16 tot0 = {}, tot1 = {};
    const size_t bgoff = ((size_t)(b * 2 + g)) * SEQ * 64;
    LAS float* impa = (LAS float*)(lds + L_IMPA); LAS float* impc = (LAS float*)(lds + L_IMPC); LAS float* impf = (LAS float*)(lds + L_IMPF); LAS float* facl = (LAS float*)(lds + L_FAC);
    LAS unsigned* selm = (LAS unsigned*)(lds + L_SELM); LAS unsigned* uni = (LAS unsigned*)(lds + L_UNION);

    REP(16) {
        tot0 = f32x16{}; tot1 = f32x16{};
        const bf16* Kc = (const bf16*)(ws + WS_KCO) + (size_t)(b * 2 + g) * 128 * 64; const bf16* Vc = (const bf16*)(ws + WS_VCO) + (size_t)(b * 2 + g) * 128 * 64;
        const bool two = (t0 + 63 - 31) / 16 >= 64;
        { u32x4 kr, vr; tile_gload(Kc, Vc, 0, tid, kr, vr); tile_lstore(lds, lds + 16384, tid, kr, vr);
          tile_gload(Kc, Vc, 64, tid, kr, vr); tile_lstore(lds + 8192, lds + 16384 + 8192, tid, kr, vr); }
        if (tid < 64) selm[tid] = 0u; if (tid == 64) *uni = 0u;
        __syncthreads();
        const int nv = (token >= 31) ? (token - 31) / 16 : -1;
        FlashSt st; flash_init(st);
        float ms0 = 0.f;
        const CInit cinitc = make_cinit(16.f * slope2, hi);
#pragma unroll
        for (int tile = 0; tile < 2; ++tile) {
            if (tile == 0 || two) {
                f32x16 s0, s1;
                const int lim = nv - 64 * tile - 4 * hi;
                auto vf = [=](int r, int half) { return ~((lim - ((r & 3) + 8 * (r >> 2) + 32 * half)) >> 31); };
                const float ms = flash_probs<true>((lds_cptr)(lds + tile * 8192), qr, cinitc, 512.f * slope2, 1024.f * slope2 * (float)tile, st, vf, lane, s0, s1);
                if (tile == 0) ms0 = ms;
#pragma unroll
                for (int blk = 0; blk < 2; ++blk) { const f32x16& P = blk ? s1 : s0;
#pragma unroll
                    for (int q = 0; q < 4; ++q) { const int uq = 16 * tile + 8 * blk + 2 * q + hi;
                        impa[(rh * 32 + uq) * 64 + tl] = (P[4 * q] + P[4 * q + 1]) + (P[4 * q + 2] + P[4 * q + 3]); impc[(rh * 32 + uq) * 64 + tl] = P[4 * q + 3]; } }
                pv_tile((lds_cptr)(lds + 16384 + tile * 8192), s0, s1, st.o0, st.o1, lane, hi);
            } else {
#pragma unroll
                for (int k = 0; k < 8; ++k) { const int uq = 16 + 2 * k + hi; impa[(rh * 32 + uq) * 64 + tl] = 0.f; impc[(rh * 32 + uq) * 64 + tl] = 0.f; }
            }
        }
        { const float l = st.l + __shfl_xor(st.l, 32), inv = (l > 0.f) ? 1.f / l : 0.f, mf = (st.m == -INFINITY) ? 0.f : st.m;
          if (hi == 0) { facl[(rh * 2 + 0) * 64 + tl] = __builtin_amdgcn_exp2f(ms0 - mf) * inv; facl[(rh * 2 + 1) * 64 + tl] = inv; } }
        flash_finish(st, g_cmp, tot0, tot1);
        __syncthreads();
        { const int tk = tid & 63, jg = tid >> 6;
#pragma unroll
          for (int jj = 0; jj < 4; ++jj) { const int j = jg * 4 + jj; float v = 0.f;
#pragma unroll
              for (int h4 = 0; h4 < 4; ++h4) { v += impa[(h4 * 32 + j) * 64 + tk] * facl[(h4 * 2 + (j >> 4)) * 64 + tk];
                  if (j > 0) v += impc[(h4 * 32 + j - 1) * 64 + tk] * facl[(h4 * 2 + ((j - 1) >> 4)) * 64 + tk]; }
              const bool forced = (j == 0) || (j == qt) || (j == qt - 1);
              v = forced ? 1e9f : ((j <= qt) ? v : -1e9f);
              impf[j * 64 + tk] = v; } }
        __syncthreads();
        { const int tk = tid & 63, jg = tid >> 6; unsigned bits = 0u;
#pragma unroll
          for (int jj = 0; jj < 4; ++jj) { const int j = jg * 4 + jj; const float v = impf[j * 64 + tk]; int rank = 0;
              for (int j2 = 0; j2 < 32; ++j2) { const float w = impf[j2 * 64 + tk]; rank += (w > v || (w == v && j2 < j)) ? 1 : 0; }
              if (rank < 16) bits |= 1u << j; }
          atomicOr((unsigned*)&selm[tk], bits); atomicOr((unsigned*)uni, bits); }
        __syncthreads();
    }
    const unsigned mysel = selm[tl]; const unsigned long long um = (unsigned long long)(*uni);
    LAS float* stash = (LAS float*)(lds + L_IMPA) + tid;
#pragma unroll
    for (int r = 0; r < 16; ++r) { stash[r * 512] = tot0[r]; stash[(16 + r) * 512] = tot1[r]; }
    const CInit cinit = make_cinit(slope2, hi);

    REP(17) {
        FlashSt st; flash_init(st);
        struct TI { int qt, lim; unsigned mysel; float sl64;
            __device__ __forceinline__ bool masked(int kt) const { return kt == qt; }
            __device__ __forceinline__ float off(int kt) const { return ((mysel >> kt) & 1u) ? sl64 * (float)kt : -INFINITY; }
            __device__ __forceinline__ int prep(int kt) const { return kt; }
            __device__ __forceinline__ int valid(int, int r, int half) const { return ~((lim - ((r & 3) + 8 * (r >> 2) + 32 * half)) >> 31); } };
        const TI ti{qt, tokl - 4 * hi, mysel, 64.f * slope2};
        flash_loop((const bf16*)(ws + WS_KS) + bgoff, (const bf16*)(ws + WS_VS) + bgoff, 0, qt, um, qr, cinit, 32.f * slope2, st, ti, lds, tid);
        f32x16 a0 = {}, a1 = {}; flash_finish(st, g_slc, a0, a1);
        if (rp_ == 0) {
#pragma unroll
        for (int r = 0; r < 16; ++r) { stash[r * 512] += a0[r]; stash[(16 + r) * 512] += a1[r]; } }
    }
    REP(18) {
        FlashSt st; flash_init(st);
        struct TI { int qt, lim; float sl64;
            __device__ __forceinline__ bool masked(int kt) const { return kt == qt || kt == qt - 8; }
            __device__ __forceinline__ float off(int kt) const { return sl64 * (float)kt; }
            __device__ __forceinline__ int prep(int kt) const { return kt; }
            __device__ __forceinline__ int valid(int kt, int r, int half) const { const int gt = (lim - ((r & 3) + 8 * (r >> 2) + 32 * half)) >> 31; return (kt == qt) ? ~gt : gt; } };
        const TI ti{qt, tokl - 4 * hi, 64.f * slope2};
        flash_loop((const bf16*)(ws + WS_KW) + bgoff, (const bf16*)(ws + WS_VW) + bgoff, (qt >= 8) ? qt - 8 : 0, qt, ~0ull, qr, cinit, 32.f * slope2, st, ti, lds, tid);
        f32x16 a0 = {}, a1 = {}; flash_finish(st, g_win, a0, a1);
#pragma unroll
        for (int r = 0; r < 16; ++r) { a0[r] += stash[r * 512]; a1[r] += stash[(16 + r) * 512]; }
        store_o(ws + WS_OA, row * 512 + head * 64, a0, a1, hi, (float*)(ws + WS_ROWNA) + row, so_scale_a((const float*)(ws + WS_VMAX)));
    }
}

__device__ __forceinline__ unsigned ordkey(float f) { f = f + 0.f; const unsigned u = __float_as_uint(f); return u ^ ((unsigned)((int)u >> 31) | 0x80000000u); }

__device__ __forceinline__ int wave_sum_i32(int x) {
    x += __builtin_amdgcn_update_dpp(0, x, 0x111, 0xf, 0xf, true);
    x += __builtin_amdgcn_update_dpp(0, x, 0x112, 0xf, 0xf, true);
    x += __builtin_amdgcn_update_dpp(0, x, 0x114, 0xf, 0xf, true);
    x += __builtin_amdgcn_update_dpp(0, x, 0x118, 0xf, 0xf, true);
    x += __builtin_amdgcn_update_dpp(0, x, 0x142, 0xa, 0xf, false);
    x += __builtin_amdgcn_update_dpp(0, x, 0x143, 0xc, 0xf, false);
    return __builtin_amdgcn_readlane(x, 63);
}
__device__ __forceinline__ unsigned wave_max_u32(unsigned x) {
    unsigned y;
    y = (unsigned)__builtin_amdgcn_update_dpp(0, (int)x, 0x111, 0xf, 0xf, true); x = x > y ? x : y;
    y = (unsigned)__builtin_amdgcn_update_dpp(0, (int)x, 0x112, 0xf, 0xf, true); x = x > y ? x : y;
    y = (unsigned)__builtin_amdgcn_update_dpp(0, (int)x, 0x114, 0xf, 0xf, true); x = x > y ? x : y;
    y = (unsigned)__builtin_amdgcn_update_dpp(0, (int)x, 0x118, 0xf, 0xf, true); x = x > y ? x : y;
    y = (unsigned)__builtin_amdgcn_update_dpp(0, (int)x, 0x142, 0xa, 0xf, false); x = x > y ? x : y;
    y = (unsigned)__builtin_amdgcn_update_dpp(0, (int)x, 0x143, 0xc, 0xf, false); x = x > y ? x : y;
    return (unsigned)__builtin_amdgcn_readlane((int)x, 63);
}
template <int NI>
__device__ __forceinline__ void dsa_select(const float* __restrict__ scr, LAS unsigned long long* msk, int wave, int lane, int t0, int nkt) {
    unsigned u[NI], un[NI];
    auto loadrow = [&](int tk, unsigned (&dst)[NI]) {
#pragma unroll
        for (int i = 0; i < NI; ++i) { const int ii = (i < nkt) ? i : 0; const float f = scr[(size_t)tk * 2048 + ii * 64 + lane]; dst[i] = (i < nkt) ? ordkey(f) : 0u; } };
    loadrow(wave * 4, un);
#pragma unroll 1
    for (int tq = 0; tq < 4; ++tq) {
        const int tk = wave * 4 + tq, tpos = t0 + tk;
#pragma unroll
        for (int i = 0; i < NI; ++i) u[i] = un[i];
        if (tq < 3) loadrow(tk + 1, un);
        if (tpos + 1 <= 256) {
#pragma unroll
            for (int i = 0; i < NI; ++i) { const unsigned long long m = __ballot(i * 64 + lane <= tpos); if (lane == 0) msk[tk * 32 + i] = m; }
        } else {
            int h[NI];
#pragma unroll
            for (int i = 0; i < NI; ++i) h[i] = (int)(u[i] >> 1);
            auto count_ge = [&](int c) { int lt = 0;
#pragma unroll
                for (int i = 0; i < NI; i += 4) { int d0 = h[i] - c, d1 = h[i + 1] - c, d2 = h[i + 2] - c, d3 = h[i + 3] - c;
                    asm volatile("" : "+v"(d0), "+v"(d1), "+v"(d2), "+v"(d3));
                    lt += ((int)((unsigned)d0 >> 31) + (int)((unsigned)d1 >> 31)) + ((int)((unsigned)d2 >> 31) + (int)((unsigned)d3 >> 31)); }
                return NI * 64 - wave_sum_i32(lt); };
            int T31 = 0, bit0 = 30; bool exact = false;
            { int mx = 0;
#pragma unroll
              for (int i = 0; i < NI; ++i) mx = (h[i] > mx) ? h[i] : mx;
              mx = (int)wave_max_u32((unsigned)mx);
              int P = mx >> 22;
#pragma unroll 1
              for (int tr = 0; tr < 4 && P > 0; ++tr, --P) {
                  const int cand = P << 22; const int cnt = count_ge(cand);
                  if (cnt >= 256) { T31 = cand; bit0 = 21; exact = (cnt == 256); break; }
              } }
            if (!exact) {
#pragma unroll 1
                for (int bit = bit0; bit >= 0; --bit) {
                    const int cand = T31 | (1 << bit); const int cnt = count_ge(cand);
                    if (cnt >= 256) { T31 = cand; if (cnt == 256) { exact = true; break; } }
                }
            }
            unsigned T = (unsigned)T31 << 1; int cge = 256;
            if (!exact) { const unsigned Thi = T | 1u; int lc = 0;
#pragma unroll
                for (int i = 0; i < NI; ++i) lc += (u[i] >= Thi) ? 1 : 0;
                const int chi = wave_sum_i32(lc);
                if (chi >= 256) { T = Thi; cge = chi; } else cge = count_ge(T31); }
            if (cge == 256) {
                int mlo = 0, mhi = 0;
#pragma unroll
                for (int i = 0; i < NI; ++i) { const unsigned long long bm = __ballot(u[i] >= T);
                    const bool me = (lane == i); mlo = me ? (int)(unsigned)bm : mlo; mhi = me ? (int)(unsigned)(bm >> 32) : mhi; }
                if (lane < NI) msk[tk * 32 + lane] = ((unsigned long long)(unsigned)mhi << 32) | (unsigned long long)(unsigned)mlo;
                continue;
            }
            int cgt = 0;
#pragma unroll
            for (int i = 0; i < NI; ++i) cgt += __popcll(__ballot(u[i] > T));
            const int need = 256 - cgt;
            int run = 0; const unsigned long long lt = (1ull << lane) - 1ull;
#pragma unroll
            for (int i = 0; i < NI; ++i) {
                const bool eq = (u[i] == T); const unsigned long long eqm = __ballot(eq);
                const int myrank = run + __popcll(eqm & lt); const bool sel = (u[i] > T) || (eq && myrank < need);
                run += __popcll(eqm); const unsigned long long m = __ballot(sel); if (lane == 0) msk[tk * 32 + i] = m; }
        }
    }
}

__device__ __forceinline__ void dsa_unit(const Args& a, LAS unsigned char* lds, int b, int qt) {
    int tid_ = threadIdx.x; asm volatile("" : "+v"(tid_));
    __syncthreads();
    const int tid = tid_, lane = tid & 63, wave = __builtin_amdgcn_readfirstlane(tid >> 6), r32 = lane & 31, hi = lane >> 5;
    unsigned char* ws = a.ws;
    const int t0 = qt * 32, token = t0 + r32, nkt = (t0 + 31) / 64 + 1;
    const size_t row = (size_t)b * SEQ + token;
    float* scr = (float*)(ws + WS_SCR) + (size_t)blockIdx.x * 32 * 2048;
    LAS unsigned char* iql = lds + L_IQL; LAS unsigned long long* msk = (LAS unsigned long long*)(lds + L_MSK);
    REP(13) {
        const bf16* IQ = (const bf16*)(ws + WS_IQ);
#pragma unroll
        for (int c4 = 0; c4 < 4; ++c4) { const int id = tid + 512 * c4, tok = id >> 6, c = id & 63, h = c >> 3, d0 = (c >> 1) & 3, hh = c & 1;
            const u32x4 v = *(const u32x4*)(IQ + ((size_t)b * SEQ + t0 + tok) * 512 + c * 8);
            *(LAS u32x4*)(iql + (((h * 4 + d0) * 2 + hh) * 32 + tok) * 16) = v; }
        if (tid < 256) { const int tok = tid >> 3, h = tid & 7; ((LAS float*)(lds + L_IWL))[h * 32 + tok] = ((const float*)(ws + WS_IW))[((size_t)b * SEQ + t0 + tok) * 8 + h]; }
        __syncthreads();
        const bf16* IK = (const bf16*)(ws + WS_IK) + (size_t)b * SEQ * 64;
        bf16x8 kf[8], kn[8];
        auto kload = [&](int kt, bf16x8 (&d)[8]) {
#pragma unroll
            for (int d0 = 0; d0 < 4; ++d0) { d[2 * d0] = *(const bf16x8*)(IK + (size_t)(kt * 64 + r32) * 64 + 16 * d0 + 8 * hi); d[2 * d0 + 1] = *(const bf16x8*)(IK + (size_t)(kt * 64 + 32 + r32) * 64 + 16 * d0 + 8 * hi); } };
        if (wave < nkt) kload(wave, kn);
#pragma unroll 1
        for (int kt = wave; kt < nkt; kt += NWAVES) {
#pragma unroll
            for (int i = 0; i < 8; ++i) kf[i] = kn[i];
            if (kt + NWAVES < nkt) kload(kt + NWAVES, kn);
            f32x16 acc0 = {}, acc1 = {};
#pragma unroll 1
            for (int h = 0; h < 8; ++h) {
                const float wh = ((const LAS float*)(lds + L_IWL))[h * 32 + r32];
                f32x16 s0 = {}, s1 = {};
#pragma unroll
                for (int d0 = 0; d0 < 4; ++d0) { const bf16x8 q = *(const LAS bf16x8*)(iql + (((h * 4 + d0) * 2 + hi) * 32 + r32) * 16);
                    s0 = MFMA32(kf[2 * d0], q, s0); s1 = MFMA32(kf[2 * d0 + 1], q, s1); }
#pragma unroll
                for (int r = 0; r < 16; ++r) {
                    const int i0 = __float_as_int(s0[r]), i1 = __float_as_int(s1[r]);
                    acc0[r] += wh * __int_as_float(i0 > 0 ? i0 : 0); acc1[r] += wh * __int_as_float(i1 > 0 ? i1 : 0); }
            }
#pragma unroll
            for (int q = 0; q < 4; ++q) { const int k0 = kt * 64 + 8 * q + 4 * hi; f32x4 v0, v1;
#pragma unroll
                for (int e = 0; e < 4; ++e) { v0[e] = (k0 + e <= token) ? acc0[4 * q + e] : -INFINITY; v1[e] = (k0 + 32 + e <= token) ? acc1[4 * q + e] : -INFINITY; }
                *(f32x4*)(scr + (size_t)r32 * 2048 + k0) = v0; *(f32x4*)(scr + (size_t)r32 * 2048 + k0 + 32) = v1; }
        }
        __syncthreads();
    }
    REP(14) {
        if (nkt <= 8) dsa_select<8>(scr, msk, wave, lane, t0, nkt);
        else if (nkt <= 12) dsa_select<12>(scr, msk, wave, lane, t0, nkt);
        else if (nkt <= 16) dsa_select<16>(scr, msk, wave, lane, t0, nkt);
        else if (nkt <= 20) dsa_select<20>(scr, msk, wave, lane, t0, nkt);
        else if (nkt <= 24) dsa_select<24>(scr, msk, wave, lane, t0, nkt);
        else if (nkt <= 28) dsa_select<28>(scr, msk, wave, lane, t0, nkt);
        else dsa_select<32>(scr, msk, wave, lane, t0, nkt);
    }
    __syncthreads();
    REP(15) {
        const int head = wave;
        bf16x8 qr[4];
#pragma unroll
        for (int d0 = 0; d0 < 4; ++d0) qr[d0] = *(const bf16x8*)((const bf16*)(ws + WS_QB) + row * 512 + head * 64 + 16 * d0 + 8 * hi);
        const float slope2 = __builtin_amdgcn_exp2f(-(float)(head + 1)) * LOG2E;
        const CInit cinit = make_cinit(slope2, hi);
        FlashSt st; flash_init(st);
        struct TI { const LAS unsigned long long* mrow; int sh; float sl64;
            __device__ __forceinline__ bool masked(int) const { return true; }
            __device__ __forceinline__ float off(int kt) const { return sl64 * (float)kt; }
            __device__ __forceinline__ u32x2 prep(int kt) const { const unsigned long long mm = mrow[kt] >> sh; u32x2 w; w.x = (unsigned)mm; w.y = (unsigned)(mm >> 32); return w; }
            __device__ __forceinline__ int valid(const u32x2& w, int r, int half) const { return __builtin_amdgcn_sbfe((int)(half ? w.y : w.x), (r & 3) + 8 * (r >> 2), 1); } };
        const TI ti{msk + r32 * 32, 4 * hi, 64.f * slope2};
        flash_loop((const bf16*)(ws + WS_KB) + (size_t)b * SEQ * 64, (const bf16*)(ws + WS_VB) + (size_t)b * SEQ * 64, 0, nkt - 1, ~0ull, qr, cinit, 32.f * slope2, st, ti, lds, tid);
        f32x16 t0v = {}, t1v = {};
        flash_finish(st, 1.f, t0v, t1v);
        store_o(ws + WS_OB8, row * 512 + head * 64, t0v, t1v, hi, (float*)(ws + WS_ROWNB) + row, so_scale_b((const float*)(ws + WS_VMAX)));
    }
    __syncthreads();
}

__device__ __forceinline__ void attn_phase(const Args& a, LAS unsigned char* lds) {
    const int c = blockIdx.x, G = gridDim.x;
    REP(11) for (int i = c; i < 2048; i += G) { const int k = i / 256, cc = i % 256, j = cc / 64, bg = cc % 64, jj = (k & 1) ? 3 - j : j, qt = 31 - (4 * k + jj);
        nsa_unit(a, lds, bg >> 1, bg & 1, qt); }
    REP(12) for (int i = c; i < 2048; i += G) { const int k = i / 256, cc = i % 256, j = cc / 32, b = cc % 32, jj = (k & 1) ? 7 - j : j, qt = 63 - (8 * k + jj);
        dsa_unit(a, lds, b, qt); }
}

#define RLX_AGENT __ATOMIC_RELAXED, __HIP_MEMORY_SCOPE_AGENT
#define XB_TMO      128
#define XB_XCNT(j)  (256  + 64 * (j))
#define XB_XSUB(j)  (1280 + 64 * (j))
#define XB_XGEN(j)  (2304 + 64 * (j))
#define XB_TOP      3328
#define XB_TOPGEN   3392
#define XCD_BAR_WORDS 3456
#define XB_SPIN_CAP (1u << 18)

__device__ __forceinline__ unsigned xb_ld(unsigned* p)              { return __hip_atomic_load(p, __ATOMIC_RELAXED, __HIP_MEMORY_SCOPE_AGENT); }
__device__ __forceinline__ unsigned xb_add(unsigned* p, unsigned v) { return __hip_atomic_fetch_add(p, v, __ATOMIC_RELAXED, __HIP_MEMORY_SCOPE_AGENT); }
__device__ __forceinline__ unsigned xb_xcc_id() { return (unsigned)__builtin_amdgcn_s_getreg((3 << 11) | 20) & 0xFu; }
#define XB_SPIN(cond, bar) do { unsigned _sp = 0; while (cond) { __builtin_amdgcn_s_sleep(1); \
    if ((++_sp & 255u) == 0u) { if (xb_ld(&(bar)[XB_TMO])) break; if (_sp > XB_SPIN_CAP) { atomicAdd(&(bar)[XB_TMO], 1u); break; } } } } while (0)

struct XcdBarrier {
    unsigned* bar; unsigned x;
    volatile LAS unsigned* st;
};

__device__ __forceinline__ XcdBarrier xcd_barrier_post(unsigned* bar, volatile LAS unsigned* st) {
    XcdBarrier b; b.bar = bar; b.x = xb_xcc_id(); b.st = st;
    if (threadIdx.x == 0) (void)xb_add(&bar[XB_XCNT(b.x)], 1u);
    return b;
}
__device__ __forceinline__ void xcd_barrier_complete(unsigned* bar, unsigned x, unsigned& nloc, unsigned& nx) {
    const unsigned G = gridDim.x * gridDim.y * gridDim.z;
    unsigned sum, cnt, mine, sp = 0u;
    for (;;) {
        sum = 0u; cnt = 0u; mine = 0u;
#pragma unroll
        for (unsigned j = 0; j < 16; ++j) { const unsigned c = xb_ld(&bar[XB_XCNT(j)]); sum += c; cnt += (c > 0u) ? 1u : 0u; mine = (j == x) ? c : mine; }
        if (sum == G) break;
        __builtin_amdgcn_s_sleep(1);
        if ((++sp & 255u) == 0u) { if (xb_ld(&bar[XB_TMO])) break; if (sp > XB_SPIN_CAP) { atomicAdd(&bar[XB_TMO], 1u); break; } }
    }
    nloc = mine > 0u ? mine : 1u; nx = cnt > 0u ? cnt : 1u;
}

__device__ __forceinline__ void xcd_barrier(const XcdBarrier& b) {
    asm volatile("s_waitcnt vmcnt(0)" ::: "memory");
    __syncthreads();
    if (threadIdx.x == 0) {
        unsigned* bar = b.bar;
        __builtin_amdgcn_s_waitcnt(0);
        unsigned nloc = b.st[0], nx = b.st[1];
        if (nloc == 0u) { xcd_barrier_complete(bar, b.x, nloc, nx); b.st[0] = nloc; b.st[1] = nx; }
        const unsigned old = xb_add(&bar[XB_XSUB(b.x)], 1u);
        const unsigned gen = old / nloc;
        if (old + 1u == (gen + 1u) * nloc) {
            __builtin_amdgcn_fence(__ATOMIC_RELEASE, "agent");
            asm volatile("s_waitcnt vmcnt(0)" ::: "memory");
            const unsigned og = xb_add(&bar[XB_TOP], 1u);
            const unsigned tg = og / nx;
            if (og + 1u == (tg + 1u) * nx) xb_add(&bar[XB_TOPGEN], 1u);
            else XB_SPIN(xb_ld(&bar[XB_TOPGEN]) == tg, bar);
            __builtin_amdgcn_fence(__ATOMIC_ACQUIRE, "agent");
            xb_add(&bar[XB_XGEN(b.x)], 1u);
            asm volatile("s_waitcnt vmcnt(0)" ::: "memory");
        } else {
            XB_SPIN(xb_ld(&bar[XB_XGEN(b.x)]) == gen, bar);
            __builtin_amdgcn_fence(__ATOMIC_ACQUIRE, "agent");
            asm volatile("s_waitcnt vmcnt(0)" ::: "memory");
        }
    }
    __syncthreads();
}

#ifndef WGM_P2A
#define WGM_P2A 4
#endif
#ifndef WGM_P2B
#define WGM_P2B 4
#endif
#ifndef WGM_P9
#define WGM_P9 4
#endif
#ifndef RUNG
#define RUNG 99
#endif
__global__ void __launch_bounds__(NTHREADS, 2) hybrid_fwd(Args a) {
    extern __shared__ __attribute__((aligned(16))) unsigned char lds_raw[];
    LAS unsigned char* lds = (LAS unsigned char*)lds_raw;
    cg::grid_group grid = cg::this_grid();
    unsigned char* ws = a.ws;
    volatile LAS unsigned* bst = (volatile LAS unsigned*)(lds + LDS_BYTES - 64);
    if (threadIdx.x < 2) bst[threadIdx.x] = 0u;
    __syncthreads();
    XcdBarrier xbar; xbar.bar = (unsigned*)ws; xbar.x = 0u; xbar.st = bst;
    const float* mod = (const float*)(ws + WS_MOD);
    const int lo = a.ph_lo, hi = a.ph_hi;
#define IN(k) (lo <= (k) && (k) < hi)
#define SEAM(k) do { if (IN(k) && IN((k) + 1)) { if ((k) == 0) grid.sync(); else xcd_barrier(xbar); } } while (0)

    if (IN(0)) REP(0) { phase0(a, lds); }
    SEAM(0);
    if (IN(0) && IN(1)) xbar = xcd_barrier_post((unsigned*)ws, bst);
    if (IN(1)) REP(1) { if (blockIdx.x == 0 && threadIdx.x < 64) wnmax_item(ws); wgu_quant_items(a, lds); wing_quant_items(a, lds); wd_quant_items(a, lds); wout_quant_items(a, lds); woab_quant_items(a, lds); norm_dual_phase(a.in[I_X], a.in[I_GN1], mod, 0, DM, (bf16*)(ws + WS_H), (signed char*)(ws + WS_HQ), (float*)(ws + WS_SA1)); }
    SEAM(1);
#if RUNG >= 2
    if (IN(2)) {
        if constexpr (NBFT > 0) { pg8::Gemm g{(const bf16*)(ws + WS_H), (const bf16*)(ws + WS_WIN), MROWS, NBFROWS, DM}; pg8::StaticOrder S; S.init(MROWS, NBFROWS, gridDim.x, blockIdx.x, WGM_P2A);
          EpiProj<false> E{ws, a.in[I_GQA], a.in[I_GKS], a.in[I_GKW], a.in[I_GQB], a.in[I_GKB]};
          pg8::gemm_phase<EpiProj<false>, pg8::StaticOrder, true, true>(lds, g, S, E); }
        { pg8::Gemm g{(const bf16*)(ws + WS_HQ), (const bf16*)(ws + WS_WINGQ), MROWS, NI8ROWS, DM / 2}; pg8::StaticOrder S; S.init(MROWS, NI8ROWS, gridDim.x, blockIdx.x, WGM_P2B);
          EpiProj<true> E{ws, a.in[I_GQA], a.in[I_GKS], a.in[I_GKW], a.in[I_GQB], a.in[I_GKB]};
          pg8::gemm_phase<EpiProj<true>, pg8::StaticOrder, true, true, true>(lds, g, S, E); }
    }
    SEAM(2);
    if (IN(3)) REP(3) { compress_phase(a, lds); }
    SEAM(3);
    if (IN(4)) { attn_phase(a, lds); }
    SEAM(4);
    if (IN(5)) {
        pg8::Gemm g{(const bf16*)(ws + WS_OA), (const bf16*)(ws + WS_WOA), 2 * MROWS, 2 * DM, 256}; PairOrder S; S.init(gridDim.x, blockIdx.x);
        EpiYPair E{ws + WS_GA, ws + WS_GB, (bf16*)(ws + WS_Y), ws + WS_Y8, (const float*)(ws + WS_ROWNA), (const float*)(ws + WS_ROWNB), (const float*)(ws + WS_WNMAX),
                   (const float*)(ws + WS_VMAX), (const float*)(ws + WS_SBWO)};
        pg8::gemm_phase<EpiYPair, PairOrder, true, true, false, true>(lds, g, S, E);
    }
    SEAM(6);
    if (IN(7)) {
        pg8::Gemm g{(const bf16*)(ws + WS_Y8), (const bf16*)(ws + WS_WOUT), MROWS, DM, DM / 2}; pg8::StaticOrder S; S.init(MROWS, DM, gridDim.x, blockIdx.x);
        EpiX1 E{a.in[I_X], (bf16*)(ws + WS_X1B), (float*)(ws + WS_ROWSS), mod, (const float*)(ws + WS_ROWNA), (const float*)(ws + WS_ROWNB), (const float*)(ws + WS_WNMAX), (const float*)(ws + WS_SBO)};
        pg8::gemm_phase<EpiX1, pg8::StaticOrder, true, true, false, true>(lds, g, S, E);
    }
    SEAM(7);
#endif
    if (IN(8)) { norm2_quant_phase((const bf16*)(ws + WS_X1B), (const float*)(ws + WS_ROWSS), a.in[I_GN2], mod, (signed char*)(ws + WS_H2), (float*)(ws + WS_SA2), (float*)(ws + WS_SACT), (const float*)(ws + WS_WNMAX)); }
    SEAM(8);
    if (IN(9)) {
        pg8::Gemm g{(const bf16*)(ws + WS_H2), (const bf16*)(ws + WS_WGU), MROWS, 2 * DFF, DM / 2}; pg8::StaticOrder S; S.init(MROWS, 2 * DFF, gridDim.x, blockIdx.x, WGM_P9);
        EpiAct3 E{ws + WS_ACT, (const float*)(ws + WS_SA2), (const float*)(ws + WS_SBWGU), (const float*)(ws + WS_SACT)};
        pg8::gemm_phase<EpiAct3, pg8::StaticOrder, true, true, true>(lds, g, S, E);
    }
    SEAM(9);
    if (IN(10)) {
        pg8::Gemm g{(const bf16*)(ws + WS_ACT), (const bf16*)(ws + WS_WD), MROWS, DM, DFF / 2}; pg8::StaticOrder S; S.init(MROWS, DM, gridDim.x, blockIdx.x);
        EpiOut E{(const bf16*)(ws + WS_X1B), a.out, mod, (const float*)(ws + WS_SACT), (const float*)(ws + WS_SBD)};
        pg8::gemm_phase<EpiOut, pg8::StaticOrder, true, true, false, true>(lds, g, S, E);
    }
#undef IN
#undef SEAM
}

#ifndef N_LAUNCH_MODE
#define N_LAUNCH_MODE 1
#endif
extern "C" void kernel_launch(void* const* d_in, const int* in_sizes, int n_in, void* d_out, int out_size, void* d_ws, size_t ws_size, hipStream_t stream) {
    static int grid = 0;
    if (grid == 0) {
        if (n_in != 25 || out_size != MROWS * DM || ws_size < WS_END) { fprintf(stderr, "kernel_launch: unexpected problem (n_in %d, out %d, ws %zu)\n", n_in, out_size, ws_size); grid = -1; return; }
        int dev = 0, cus = 0, per_cu = 0;
        hipGetDevice(&dev); hipDeviceGetAttribute(&cus, hipDeviceAttributeMultiprocessorCount, dev);
        if (hipFuncSetAttribute((const void*)hybrid_fwd, hipFuncAttributeMaxDynamicSharedMemorySize, LDS_BYTES) != hipSuccess) { fprintf(stderr, "kernel_launch: hipFuncSetAttribute failed\n"); grid = -1; return; }
        if (hipOccupancyMaxActiveBlocksPerMultiprocessor(&per_cu, (const void*)hybrid_fwd, NTHREADS, LDS_BYTES) != hipSuccess || per_cu < 1) { fprintf(stderr, "kernel_launch: occupancy query says %d\n", per_cu); per_cu = 1; }
        (void)hipGetLastError();
        grid = cus * (per_cu > 1 ? 1 : per_cu);
        if (grid > MAXGRID) grid = MAXGRID;
        if (grid < 1) grid = 1;
    }
    if (grid < 0) return;
    Args a{};
    for (int i = 0; i < 25; ++i) a.in[i] = (const float*)d_in[i];
    a.out = (float*)d_out; a.ws = (unsigned char*)d_ws;
#if N_LAUNCH_MODE == 1
    a.ph_lo = 0; a.ph_hi = 11;
    void* args[] = {&a};
    hipError_t e = hipLaunchCooperativeKernel((const void*)hybrid_fwd, dim3(grid), dim3(NTHREADS), args, LDS_BYTES, stream);
    if (e != hipSuccess) fprintf(stderr, "kernel_launch: cooperative launch failed: %s (grid %d)\n", hipGetErrorString(e), grid);
#else
    for (int p = 0; p < 11; ++p) { a.ph_lo = p; a.ph_hi = p + 1; hipLaunchKernelGGL(hybrid_fwd, dim3(grid), dim3(NTHREADS), LDS_BYTES, stream, a); }
#endif
}
```

```cpp
#include <hip/hip_runtime.h>
#include <hip/hip_cooperative_groups.h>
#include <cstdio>
#include <cstdint>
namespace cg = cooperative_groups;
#define RUNG 99
#define N_LAUNCH_MODE 1
#define REPMASK 0
#define REP(k) for (int rp_ = 0; rp_ < (((REPMASK) >> (k)) & 1) + 1; ++rp_)
namespace pg8 {
#define PG8_LAS __attribute__((address_space(3)))
typedef unsigned short bf16_t;
typedef short bf16x8 __attribute__((ext_vector_type(8)));
typedef float f32x4 __attribute__((ext_vector_type(4)));
typedef unsigned u32x4 __attribute__((ext_vector_type(4)));
typedef int i32x4 __attribute__((ext_vector_type(4)));
typedef int i32x8 __attribute__((ext_vector_type(8)));
constexpr int BM = 256, BK = 64, HALF = 128, HTB = HALF * BK * 2  , STAGE_BYTES = 8 * HTB, NXCD = 8, WGM = 4;

__host__ __device__ __forceinline__ int lds_byte(int r, int c) { const int st = (r >> 4) * 2 + (c >> 5), rr = r & 15, cc = c & 31, ob = rr * 64 + cc * 2; return st * 1024 + (ob ^ (((ob >> 9) & 1) << 5)); }
__host__ __device__ __forceinline__ void stage_rc(int b, int& R, int& C) { const int st = b / 1024, sb = b % 1024, swz = sb ^ (((sb >> 9) & 1) << 5); R = (st >> 1) * 16 + swz / 64; C = (st & 1) * 32 + (swz % 64) / 2; }
__host__ __device__ __forceinline__ int perm32(int rho) { const int n = rho >> 4, i = rho & 15; return 8 * (i >> 2) + 4 * n + (i & 3); }

struct Unit { int pm, pn; };
struct Gemm { const bf16_t* A; const bf16_t* Bt; int M, N, K; };

struct StaticOrder {
    int nM, nN, nwg, G, c, wgm;
    __host__ __device__ void init(int M, int N, int G_, int c_, int wgm_ = WGM) { nM = M / BM; nN = N / BM; nwg = nM * nN; G = G_; c = c_; wgm = wgm_; }
    __host__ __device__ bool next(int i, Unit& u) const {
        const long L = (long)i * G + c; if (L >= nwg) return false;
        int wgid = (int)L; { const int q = nwg / NXCD, r = nwg % NXCD, xcd = wgid % NXCD, off = wgid / NXCD; wgid = (xcd < r ? xcd * (q + 1) : r * (q + 1) + (xcd - r) * q) + off; }
        const int nig = wgm * nN, gid = wgid / nig, fm = gid * wgm, gsz = (nM - fm) < wgm ? (nM - fm) : wgm;
        u.pm = fm + ((wgid % nig) % gsz); u.pn = (wgid % nig) / gsz; return true;
    }
    __device__ __forceinline__ void a_ready(const Unit&) const {}
    __device__ __forceinline__ void done(const Unit&) const {}
};

template <class Epi, class Sched, bool ALIGN_EPI = false, bool SP2 = false, bool I8 = false, bool F8 = false>
__device__ __forceinline__ void gemm_phase(PG8_LAS unsigned char* lds, const Gemm g, const Sched& S, const Epi& E) {
    const int tid = threadIdx.x, wid = __builtin_amdgcn_readfirstlane(tid >> 6), lane = tid & 63, wr = wid >> 2, wc = wid & 3, fr = lane & 15, fq = lane >> 4;
    const int K = g.K, nt = K / BK;
    unsigned voffA[2], voffB[2];
#pragma unroll
    for (int i = 0; i < 2; ++i) { int R, C; stage_rc(tid * 16 + i * 8192, R, C); const int Rb = Epi::PERM ? ((R & ~31) + perm32(R & 31)) : R;
        voffA[i] = (unsigned)(R * K + C) * 2u; voffB[i] = (unsigned)(Rb * K + C) * 2u; }
    const size_t kstep = (size_t)(BK * 2);
    const size_t hstep = (size_t)HALF * K * 2;
    const size_t tstep = 2 * hstep;
    const unsigned ldsw = (unsigned)wid * 1024u;
    const int aoff = lds_byte(wr * 64 + fr, fq * 8), boff = lds_byte(wc * 32 + fr, fq * 8);
#define PG8_SA(b, h) (((b) * 2 + (h)) * HTB)
#define PG8_SB(b, h) ((4 + (b) * 2 + (h)) * HTB)
#define PG8_STAGE(bufoff, gbase, voff) do { _Pragma("unroll") for (int _i = 0; _i < 2; ++_i) \
        __builtin_amdgcn_global_load_lds((const unsigned*)((const char*)(gbase) + (voff)[_i]), (PG8_LAS unsigned*)(lds + (bufoff) + ldsw + _i * 8192), 16, 0, 0); } while (0)
#define PG8_LD8(p) PG8_CAT8(*(const PG8_LAS bf16x8*)(p), *(const PG8_LAS bf16x8*)((p) + 1024))
#define PG8_LDA8(dst, b, h) do { _Pragma("unroll") for (int m = 0; m < 4; ++m) dst##8[m] = PG8_LD8(lds + PG8_SA(b, h) + aoff + m * 2048); } while (0)
#define PG8_LDB8(dst, b, h) do { _Pragma("unroll") for (int n = 0; n < 2; ++n) dst##8[n] = PG8_LD8(lds + PG8_SB(b, h) + boff + n * 2048); } while (0)
#define PG8_LDA_(dst, b, h) do { _Pragma("unroll") for (int m = 0; m < 4; ++m) _Pragma("unroll") for (int k = 0; k < 2; ++k) dst[m][k] = *(const PG8_LAS bf16x8*)(lds + PG8_SA(b, h) + aoff + m * 2048 + k * 1024); } while (0)
#define PG8_LDB_(dst, b, h) do { _Pragma("unroll") for (int n = 0; n < 2; ++n) _Pragma("unroll") for (int k = 0; k < 2; ++k) dst[n][k] = *(const PG8_LAS bf16x8*)(lds + PG8_SB(b, h) + boff + n * 2048 + k * 1024); } while (0)
#define PG8_LDA(dst, b, h) do { if constexpr (F8) PG8_LDA8(dst, b, h); else PG8_LDA_(dst, b, h); } while (0)
#define PG8_LDB(dst, b, h) do { if constexpr (F8) PG8_LDB8(dst, b, h); else PG8_LDB_(dst, b, h); } while (0)
#define PG8_MMA(ai, bj, At, Bt) do { __builtin_amdgcn_s_setprio(1); _Pragma("unroll") for (int m = 0; m < 4; ++m) _Pragma("unroll") for (int n = 0; n < 2; ++n) _Pragma("unroll") for (int k = 0; k < 2; ++k) \
        { if constexpr (F8) { if (k == 0) asm volatile("v_mfma_scale_f32_16x16x128_f8f6f4 %0, %1, %2, %0, %3, %3 op_sel_hi:[0,0,0]" : "+v"(acc[ai][bj][m][n]) : "v"(Bt##8[n]), "v"(At##8[m]), "v"(f8scl)); } \
          else if constexpr (I8) acc[ai][bj][m][n] = __builtin_bit_cast(f32x4, __builtin_amdgcn_mfma_i32_16x16x64_i8(__builtin_bit_cast(i32x4, Bt[n][k]), __builtin_bit_cast(i32x4, At[m][k]), __builtin_bit_cast(i32x4, acc[ai][bj][m][n]), 0, 0, 0)); \
          else acc[ai][bj][m][n] = __builtin_amdgcn_mfma_f32_16x16x32_bf16(Bt[n][k], At[m][k], acc[ai][bj][m][n], 0, 0, 0); } __builtin_amdgcn_s_setprio(0); } while (0)
#define PG8_CAT8(x, y) __builtin_shufflevector(__builtin_bit_cast(i32x4, x), __builtin_bit_cast(i32x4, y), 0, 1, 2, 3, 4, 5, 6, 7)
#define PG8_WAIT_V(n) asm volatile("s_waitcnt vmcnt(" #n ")" ::: "memory")
#define PG8_WAIT_L(n) asm volatile("s_waitcnt lgkmcnt(" #n ")" ::: "memory")
#define PG8_BAR __builtin_amdgcn_s_barrier()
#define PG8_SCHED __builtin_amdgcn_sched_barrier(0)
    Unit cur, nxt; int ui = 0;
    if (!S.next(0, cur)) return;
    f32x4 acc[2][2][4][2];
#pragma unroll
    for (int a = 0; a < 2; ++a)
#pragma unroll
        for (int b = 0; b < 2; ++b)
#pragma unroll
            for (int m = 0; m < 4; ++m)
#pragma unroll
                for (int n = 0; n < 2; ++n) acc[a][b][m][n] = (f32x4){0.f, 0.f, 0.f, 0.f};
    bf16x8 At[4][2], B0[2][2], B1[2][2], Bn[2][2];
    const int f8scl = 0x7f7f7f7f;
    i32x8 At8[4], B08[2], B18[2], Bn8[2];
    const char* cA = (const char*)g.A + (size_t)cur.pm * tstep; const char* cB = (const char*)g.Bt + (size_t)cur.pn * tstep;
    S.a_ready(cur);
    if constexpr (SP2) {
        PG8_STAGE(PG8_SB(0, 0), cB, voffB); PG8_STAGE(PG8_SB(0, 1), cB + hstep, voffB); PG8_STAGE(PG8_SA(0, 0), cA, voffA); PG8_STAGE(PG8_SA(0, 1), cA + hstep, voffA);
        if (wr == 1) PG8_BAR;
        PG8_WAIT_V(2); PG8_BAR;
        PG8_STAGE(PG8_SB(1, 0), cB + kstep, voffB); PG8_STAGE(PG8_SA(1, 0), cA + kstep, voffA); PG8_STAGE(PG8_SB(1, 1), cB + hstep + kstep, voffB);
        PG8_WAIT_V(6); PG8_BAR;
    } else {
        PG8_STAGE(PG8_SB(0, 0), cB, voffB); PG8_STAGE(PG8_SA(0, 0), cA, voffA); PG8_STAGE(PG8_SB(0, 1), cB + hstep, voffB); PG8_STAGE(PG8_SA(0, 1), cA + hstep, voffA);
        if (wr == 1) PG8_BAR;
        PG8_WAIT_V(4); PG8_BAR;
        PG8_STAGE(PG8_SB(1, 0), cB + kstep, voffB); PG8_STAGE(PG8_SA(1, 0), cA + kstep, voffA); PG8_STAGE(PG8_SB(1, 1), cB + hstep + kstep, voffB);
        PG8_WAIT_V(6); PG8_BAR;
    }
    for (;;) {
        const bool has_next = S.next(ui + 1, nxt);
        const char* nA = has_next ? (const char*)g.A + (size_t)nxt.pm * tstep : cA; const char* nB = has_next ? (const char*)g.Bt + (size_t)nxt.pn * tstep : cB;
        if constexpr (SP2) PG8_LDB(B0, 0, 0);
        for (int t = 0; t < nt; t += 2) {
            const bool last = (t == nt - 2);
            const char* a1 = cA + (size_t)(t + 1) * kstep;
            const char* a2 = last ? nA : cA + (size_t)(t + 2) * kstep; const char* b2 = last ? nB : cB + (size_t)(t + 2) * kstep;
            const char* a3 = a2 + kstep; const char* b3 = b2 + kstep;
            if (last && has_next) S.a_ready(nxt);
            if constexpr (SP2) {
            PG8_LDB(B1, 0, 1); PG8_SCHED; PG8_LDA(At, 0, 0); PG8_STAGE(PG8_SA(1, 1), a1 + hstep, voffA);
            PG8_WAIT_V(6); PG8_WAIT_L(0); PG8_BAR; PG8_MMA(0, 0, At, B0); PG8_MMA(0, 1, At, B1); PG8_BAR; PG8_SCHED;
            PG8_LDA(At, 0, 1); PG8_LDB(Bn, 1, 0); PG8_STAGE(PG8_SB(0, 0), b2, voffB); PG8_STAGE(PG8_SB(0, 1), b2 + hstep, voffB); PG8_STAGE(PG8_SA(0, 0), a2, voffA);
            PG8_WAIT_V(8); PG8_WAIT_L(0); PG8_BAR; PG8_MMA(1, 0, At, B0); PG8_MMA(1, 1, At, B1); PG8_BAR; PG8_SCHED;
            PG8_LDB(B1, 1, 1); PG8_SCHED; PG8_LDA(At, 1, 0); PG8_STAGE(PG8_SA(0, 1), a2 + hstep, voffA);
            PG8_WAIT_V(6); PG8_WAIT_L(0); PG8_BAR; PG8_MMA(0, 0, At, Bn); PG8_MMA(0, 1, At, B1); PG8_BAR; PG8_SCHED;
            PG8_LDA(At, 1, 1); PG8_LDB(B0, 0, 0); PG8_STAGE(PG8_SB(1, 0), b3, voffB); PG8_STAGE(PG8_SB(1, 1), b3 + hstep, voffB); PG8_STAGE(PG8_SA(1, 0), a3, voffA);
            PG8_WAIT_V(8); PG8_WAIT_L(0); PG8_BAR; PG8_MMA(1, 0, At, Bn); PG8_MMA(1, 1, At, B1); PG8_BAR; PG8_SCHED;
            } else {
            PG8_LDB(B0, 0, 0); PG8_SCHED; PG8_LDA(At, 0, 0); PG8_STAGE(PG8_SA(1, 1), a1 + hstep, voffA);
            PG8_WAIT_L(8); PG8_BAR; PG8_WAIT_L(0); PG8_MMA(0, 0, At, B0); PG8_BAR; PG8_SCHED;
            PG8_LDB(B1, 0, 1); PG8_STAGE(PG8_SB(0, 0), b2, voffB);
            PG8_BAR; PG8_WAIT_L(0); PG8_MMA(0, 1, At, B1); PG8_BAR;
            PG8_LDA(At, 0, 1); PG8_STAGE(PG8_SA(0, 0), a2, voffA);
            PG8_BAR; PG8_WAIT_L(0); PG8_MMA(1, 0, At, B0); PG8_BAR; PG8_SCHED;
            PG8_STAGE(PG8_SB(0, 1), b2 + hstep, voffB);
            PG8_WAIT_V(6); PG8_BAR; PG8_MMA(1, 1, At, B1); PG8_BAR;
            PG8_LDB(B0, 1, 0); PG8_SCHED; PG8_LDA(At, 1, 0); PG8_STAGE(PG8_SA(0, 1), a2 + hstep, voffA);
            PG8_WAIT_L(8); PG8_BAR; PG8_WAIT_L(0); PG8_MMA(0, 0, At, B0); PG8_BAR; PG8_SCHED;
            PG8_LDB(B1, 1, 1); PG8_STAGE(PG8_SB(1, 0), b3, voffB);
            PG8_BAR; PG8_WAIT_L(0); PG8_MMA(0, 1, At, B1); PG8_BAR;
            PG8_LDA(At, 1, 1); PG8_STAGE(PG8_SA(1, 0), a3, voffA);
            PG8_BAR; PG8_WAIT_L(0); PG8_MMA(1, 0, At, B0); PG8_BAR; PG8_SCHED;
            PG8_STAGE(PG8_SB(1, 1), b3 + hstep, voffB);
            PG8_WAIT_V(6); PG8_BAR; PG8_MMA(1, 1, At, B1); PG8_BAR;
            }
        }
        if constexpr (F8) asm volatile("s_nop 15\n\ts_nop 15" ::: "memory");
        if constexpr (ALIGN_EPI) { if (wr == 0) PG8_BAR; }
        if constexpr (I8) {
#pragma unroll
            for (int a = 0; a < 2; ++a)
#pragma unroll
                for (int b2 = 0; b2 < 2; ++b2)
#pragma unroll
                    for (int m = 0; m < 4; ++m)
#pragma unroll
                        for (int n = 0; n < 2; ++n) acc[a][b2][m][n] = __builtin_convertvector(__builtin_bit_cast(i32x4, acc[a][b2][m][n]), f32x4);
        }
        if constexpr (!Epi::AFTER_DRAIN) { E(acc, cur, wr, wc, fr, fq); S.done(cur); }
        if (!has_next) break;
#pragma unroll
        for (int a = 0; a < 2; ++a)
#pragma unroll
            for (int b = 0; b < 2; ++b)
#pragma unroll
                for (int m = 0; m < 4; ++m)
#pragma unroll
                    for (int n = 0; n < 2; ++n) acc[a][b][m][n] = (f32x4){0.f, 0.f, 0.f, 0.f};
        cur = nxt; cA = nA; cB = nB; ++ui;
        if constexpr (ALIGN_EPI) { if (wr == 1) PG8_BAR; }
    }
    PG8_WAIT_V(0);
    if constexpr (!ALIGN_EPI) { if (wr == 0) PG8_BAR; }
    PG8_BAR;
    if constexpr (Epi::AFTER_DRAIN) { E.fused(acc, cur, wr, wc, fr, fq, lds, wid, lane); S.done(cur); }
#undef PG8_SA
#undef PG8_SB
#undef PG8_STAGE
#undef PG8_LDA
#undef PG8_LDA_
#undef PG8_LDB_
#undef PG8_LDA8
#undef PG8_LDB8
#undef PG8_LD8
#undef PG8_LDB
#undef PG8_MMA
#undef PG8_CAT8
#undef PG8_WAIT_V
#undef PG8_WAIT_L
#undef PG8_BAR
#undef PG8_SCHED
}
}

#define LAS __attribute__((address_space(3)))
typedef unsigned short bf16;
typedef short bf16x8 __attribute__((ext_vector_type(8)));
typedef short s16x4 __attribute__((ext_vector_type(4)));
typedef short v4i16_t __attribute__((ext_vector_type(4)));
typedef float f32x4 __attribute__((ext_vector_type(4)));
typedef float f32x16 __attribute__((ext_vector_type(16)));
typedef unsigned u32x4 __attribute__((ext_vector_type(4)));
typedef unsigned u32x2 __attribute__((ext_vector_type(2)));

constexpr int NB = 32, SEQ = 2048, DM = 1024, MROWS = NB * SEQ;
constexpr int DIN = 4576, DINP = 4608, DFF = 2816, NADA = 6 * DM;
constexpr float LOG2E = 1.4426950408889634f;
constexpr float QSCALE = 0.125f * LOG2E;
constexpr float RMS_EPS = 1e-6f;
constexpr int NWAVES = 8, NTHREADS = 512;
constexpr int LDS_BYTES = 147456;
constexpr int MAXGRID = 256;

constexpr size_t MiB = 1ull << 20;
constexpr size_t WS_MOD = 1 * MiB, WS_BIAS = 2 * MiB,
    WS_WIN = 4 * MiB, WS_WOA = 13 * MiB, WS_WOB = 14 * MiB, WS_WOUT = 15 * MiB, WS_WGU = 17 * MiB, WS_WD = 28 * MiB,
    WS_WCK1 = 34 * MiB, WS_WCV1 = 34 * MiB + 512 * 1024, WS_KCO = 35 * MiB, WS_VCO = 36 * MiB,
    WS_H = 40 * MiB, WS_OA = 40 * MiB, WS_OB = 104 * MiB, WS_H2 = 40 * MiB,
    WS_QA = 168 * MiB, WS_QB = 232 * MiB, WS_IQ = 296 * MiB, WS_GA = 360 * MiB, WS_GB = 488 * MiB,
    WS_KC = 616 * MiB, WS_VC = 632 * MiB, WS_KS = 648 * MiB, WS_VS = 664 * MiB, WS_KW = 680 * MiB, WS_VW = 696 * MiB,
    WS_KB = 712 * MiB, WS_VB = 720 * MiB, WS_IK = 728 * MiB, WS_GN = 736 * MiB, WS_IW = 744 * MiB,
    WS_SCR = 748 * MiB, WS_Y = 812 * MiB, WS_ACT = 168 * MiB, WS_END = 940 * MiB,
    WS_ROWSS = 65536  , WS_CB = 3 * MiB  ,
    WS_X1B = 620 * MiB  ;
constexpr size_t ZERO_BYTES = 65536 + 3 * 4 * 65536;
constexpr size_t WS_HQ = 812 * MiB  , WS_WINGQ = WS_WIN + 4 * MiB  ;
constexpr size_t WS_SBWIN = 2 * MiB + 65536, WS_SBWGU = 2 * MiB + 131072, WS_SA1 = 2 * MiB + 262144, WS_SA2 = 2 * MiB + 524288;
constexpr size_t WS_SBO = 2 * MiB + 200704  , WS_ROWNA = 327680, WS_ROWNB = 589824  ;
constexpr size_t WS_Y8 = 168 * MiB  ;
constexpr size_t WS_VMAX = 32768  , WS_SBWO = 2 * MiB + 212992  ;
constexpr size_t WS_OB8 = WS_OA + 32 * MiB  , WS_WOB8 = WS_WOA + 512 * 1024;
__device__ __forceinline__ float so_scale_a(const float* vm) { const float bd = (vm[0] + vm[1] + vm[2]) * (1.01f / 440.f); return (bd > 0.f) ? bd : 1.f; }
__device__ __forceinline__ float so_scale_b(const float* vm) { const float bd = vm[3] * (1.01f / 440.f); return (bd > 0.f) ? bd : 1.f; }
constexpr size_t WS_SBD = 2 * MiB + 196608  , WS_SACT = 2 * MiB + 786432  , WS_WNMAX = 2 * MiB + 208896  , WS_WNI = 2 * MiB + 204800  ;

struct Args { const float* in[25]; float* out; unsigned char* ws; int ph_lo, ph_hi; };

enum { I_X = 0, I_C, I_WADA, I_BADA, I_GN1, I_GN2, I_WIN, I_GQA, I_GKC, I_GKS, I_GKW, I_PECK, I_PECV, I_WCK1, I_WCK2, I_WCV1, I_WCV2,
       I_GQB, I_GKB, I_WOA, I_WOB, I_WOUT, I_WFG, I_WFU, I_WFD };

typedef float f32x2_t __attribute__((ext_vector_type(2))); typedef __bf16 bf16x2_t __attribute__((ext_vector_type(2)));
__device__ __forceinline__ unsigned cvt_pk(float lo, float hi) { const f32x2_t v = {lo, hi}; const bf16x2_t b = __builtin_convertvector(v, bf16x2_t); return __builtin_bit_cast(unsigned, b); }
__device__ __forceinline__ float bf2f(unsigned short v) { return __uint_as_float((unsigned)v << 16); }
__device__ __forceinline__ float sigmoidf_(float x) { return __builtin_amdgcn_rcpf(1.f + __builtin_amdgcn_exp2f(x * -LOG2E)); }
__device__ __forceinline__ float siluf_(float x) { return x * __builtin_amdgcn_rcpf(1.f + __builtin_amdgcn_exp2f(x * -LOG2E)); }
__device__ __forceinline__ float sy_scale(float rna, float rnb, float wa, float wb) { const float bd = (sqrtf(rna) * wa + sqrtf(rnb) * wb) * (1.02f / 440.f); return (bd > 0.f) ? bd : 1.f; }
__device__ __forceinline__ float wave_sum(float v) {
#pragma unroll
    for (int o = 1; o < 64; o <<= 1) v += __shfl_xor(v, o);
    return v;
}
#define LDS_WAIT() asm volatile("s_waitcnt lgkmcnt(0)" ::: "memory")
#define DPP_STEP_F(x, op, ctrl, rmask, bc, ident) { const float y_ = __int_as_float(__builtin_amdgcn_update_dpp(__float_as_int(ident), __float_as_int(x), ctrl, rmask, 0xf, bc)); x = op(x, y_); }
__device__ __forceinline__ float fadd_(float a, float b) { return a + b; }
__device__ __forceinline__ float wave_sum_dpp(float x) {
    DPP_STEP_F(x, fadd_, 0x111, 0xf, true, 0.f) DPP_STEP_F(x, fadd_, 0x112, 0xf, true, 0.f) DPP_STEP_F(x, fadd_, 0x114, 0xf, true, 0.f) DPP_STEP_F(x, fadd_, 0x118, 0xf, true, 0.f)
    DPP_STEP_F(x, fadd_, 0x142, 0xa, false, 0.f) DPP_STEP_F(x, fadd_, 0x143, 0xc, false, 0.f)
    return __int_as_float(__builtin_amdgcn_readlane(__float_as_int(x), 63));
}
__device__ __forceinline__ float wave_max_dpp(float x) {
    DPP_STEP_F(x, fmaxf, 0x111, 0xf, true, 0.f) DPP_STEP_F(x, fmaxf, 0x112, 0xf, true, 0.f) DPP_STEP_F(x, fmaxf, 0x114, 0xf, true, 0.f) DPP_STEP_F(x, fmaxf, 0x118, 0xf, true, 0.f)
    DPP_STEP_F(x, fmaxf, 0x142, 0xa, false, 0.f) DPP_STEP_F(x, fmaxf, 0x143, 0xc, false, 0.f)
    return __int_as_float(__builtin_amdgcn_readlane(__float_as_int(x), 63));
}

__device__ __forceinline__ int win_src_col(int np) {
    const int T = np >> 8, r = np & 255;
    if (T >= 10) return 2528 + (T - 10) * 256 + r;
    const int slot = (r & 127) >> 5, d = ((r >> 7) << 5) + (r & 31);
    switch (T) {
        case 0: return slot * 64 + d;
        case 1: return 256 + slot * 64 + d;
        case 2: return 512 + slot * 64 + d;
        case 3: return 768 + slot * 64 + d;
        case 4: return 1024 + slot * 64 + d;
        case 5: return 1304 + slot * 64 + d;
        case 6: return 1560 + slot * 64 + d;
        case 7: if (slot == 0) return 1816 + d;
                if (slot == 1) return 1880 + d;
                if (slot == 2) return 2456 + d;
                if (d < 24) return 1280 + d;
                if (d < 32) return 2520 + (d - 24);
                return -1;
        case 8: return 1944 + slot * 64 + d;
        default: return 2200 + slot * 64 + d;
    }
}

constexpr int NBFT = 3, NI8T = 15;
__device__ __forceinline__ int tmap_bf(int t) { return t + 7; }
__device__ __forceinline__ int tmap_i8(int t) { return t < 7 ? t : t + 3; }
constexpr int NBFROWS = NBFT * 256, NI8ROWS = NI8T * 256, NBFG = NBFROWS / 32, NI8G = NI8ROWS / 32;
__device__ __forceinline__ int win_src_col_bf(int np) { return win_src_col(tmap_bf(np >> 8) * 256 + (np & 255)); }
__device__ __forceinline__ int win_src_col_i8(int np) { return win_src_col(tmap_i8(np >> 8) * 256 + (np & 255)); }
__device__ __forceinline__ void transpose_item(const float* __restrict__ W, int ldw, int K, bf16* __restrict__ WT, int n0p, int k0, int col, LAS float* scr, int lane) {
#pragma unroll 8
    for (int i = 0; i < 32; ++i) { const int kk = 2 * i + (lane >> 5); scr[kk * 33 + (lane & 31)] = (col >= 0) ? W[(size_t)(k0 + kk) * ldw + col] : 0.f; }
    LDS_WAIT(); asm volatile("" ::: "memory");
    const int c = lane & 7;
#pragma unroll
    for (int j = 0; j < 4; ++j) { const int n = (lane >> 3) + 8 * j; const LAS float* s = scr + (8 * c) * 33 + n;
        u32x4 o; o.x = cvt_pk(s[0 * 33], s[1 * 33]); o.y = cvt_pk(s[2 * 33], s[3 * 33]); o.z = cvt_pk(s[4 * 33], s[5 * 33]); o.w = cvt_pk(s[6 * 33], s[7 * 33]);
        *(u32x4*)(WT + (size_t)(n0p + n) * K + k0 + 8 * c) = o; }
    LDS_WAIT(); asm volatile("" ::: "memory");
}

__device__ __forceinline__ void phase0(const Args& a, LAS unsigned char* lds) {
    const int tid = threadIdx.x, lane = tid & 63, wave = __builtin_amdgcn_readfirstlane(tid >> 6);
    unsigned char* ws = a.ws;
    for (size_t i = (size_t)blockIdx.x * NTHREADS + tid; i < ZERO_BYTES / 16; i += (size_t)gridDim.x * NTHREADS) ((u32x4*)ws)[i] = u32x4{0u, 0u, 0u, 0u};
    {
        LAS float* scr = (LAS float*)(lds + wave * 16384);
        const int gw = blockIdx.x * NWAVES + wave, NGW = gridDim.x * NWAVES;
        constexpr int I0 = 16 * NBFG  , I1 = 0, I2 = 0  , I3 = 0  , I4 = 0  , I5 = 0  , I6 = 32 * 4, I7 = 32 * 4;
        constexpr int NIT = I0 + I1 + I2 + I3 + I4 + I5 + I6 + I7;
        for (int it = gw; it < NIT; it += NGW) {
            int r = it;
            if (r < I0) { const int kb = r / (NBFG > 0 ? NBFG : 1), nb = r % (NBFG > 0 ? NBFG : 1), np = nb * 32 + (lane & 31);
                transpose_item(a.in[I_WIN], DIN, DM, (bf16*)(ws + WS_WIN), nb * 32, kb * 64, win_src_col_bf(np), scr, lane); continue; } r -= I0;
            if (r < I1) { const int kb = r / 32, nb = r % 32;
                transpose_item(a.in[I_WOA], DM, 512, (bf16*)(ws + WS_WOA), nb * 32, kb * 64, nb * 32 + (lane & 31), scr, lane); continue; } r -= I1;
            if (r < I2) { const int kb = r / 32, nb = r % 32;
                transpose_item(a.in[I_WOB], DM, 512, (bf16*)(ws + WS_WOB), nb * 32, kb * 64, nb * 32 + (lane & 31), scr, lane); continue; } r -= I2;
            if (r < I3) { const int kb = r / 32, nb = r % 32;
                transpose_item(a.in[I_WOUT], DM, DM, (bf16*)(ws + WS_WOUT), nb * 32, kb * 64, nb * 32 + (lane & 31), scr, lane); continue; } r -= I3;
            if (r < I4) { const int kb = r / 176, nb = r % 176, np0 = nb * 32, T = np0 >> 8, rr = np0 & 255;
                const float* src = (rr < 128) ? a.in[I_WFG] : a.in[I_WFU];
                transpose_item(src, DFF, DM, (bf16*)(ws + WS_WGU), np0, kb * 64, T * 128 + (rr & 127) + (lane & 31), scr, lane); continue; } r -= I4;
            if (r < I5) { const int kb = r / 32, nb = r % 32;
                transpose_item(a.in[I_WFD], DM, DFF, (bf16*)(ws + WS_WD), nb * 32, kb * 64, nb * 32 + (lane & 31), scr, lane); continue; } r -= I5;
            if (r < I6) { const int kb = r / 4, nb = r % 4;
                transpose_item(a.in[I_WCK1], 128, 2048, (bf16*)(ws + WS_WCK1), nb * 32, kb * 64, nb * 32 + (lane & 31), scr, lane); continue; } r -= I6;
            { const int kb = r / 4, nb = r % 4;
                transpose_item(a.in[I_WCV1], 128, 2048, (bf16*)(ws + WS_WCV1), nb * 32, kb * 64, nb * 32 + (lane & 31), scr, lane); }
        }
    }
    LAS float* sc = (LAS float*)lds;
    for (int it = blockIdx.x; it < 208 + 176 + NI8G + 32 + 96; it += gridDim.x) {
        __syncthreads();
        if (it >= 208 + 176 + NI8G + 32) {
            const int j = it - (208 + 176 + NI8G + 32), which = j >> 5, col = (j & 31) * 32 + (lane & 31);
            const float* W = a.in[which == 0 ? I_WOUT : (which == 1 ? I_WOA : I_WOB)]; const int kw = which == 0 ? 128 : 64;
            float m = 0.f, s2 = 0.f;
#pragma unroll 8
            for (int i = 0; i < kw / 2; ++i) { const int k = kw * wave + 2 * i + (lane >> 5); const float v = W[(size_t)k * DM + col]; m = fmaxf(m, fabsf(v)); s2 += v * v; }
            m = fmaxf(m, __shfl_xor(m, 32)); s2 += __shfl_xor(s2, 32);
            if (lane < 32) { sc[wave * 32 + lane] = m; sc[256 + wave * 32 + lane] = s2; }
            __syncthreads();
            if (tid < 32) { float mm = 0.f, ss = 0.f;
#pragma unroll
                for (int w = 0; w < 8; ++w) { mm = fmaxf(mm, sc[w * 32 + tid]); ss += sc[256 + w * 32 + tid]; }
                if (which == 0) ((float*)(ws + WS_SBO))[(j & 31) * 32 + tid] = (mm > 0.f) ? mm * (1.f / 448.f) : 1.f;
                else { ((float*)(ws + WS_SBWO))[(which - 1) * 1024 + (j & 31) * 32 + tid] = (mm > 0.f) ? mm * (1.f / 448.f) : 1.f;
                    float cn = sqrtf(ss) * 1.0635f;
#pragma unroll
                    for (int o = 1; o < 32; o <<= 1) cn = fmaxf(cn, __shfl_xor(cn, o));
                    if (tid == 0) ((float*)(ws + WS_WNI))[176 + (which - 1) * 32 + (j & 31)] = cn; } }
        } else if (it >= 208 + 176 + NI8G) {
            const int g32 = it - 208 - 176 - NI8G, col = g32 * 32 + (lane & 31); const float* W = a.in[I_WFD];
            float m = 0.f;
#pragma unroll 8
            for (int i = 0; i < 176; ++i) { const int k = 352 * wave + 2 * i + (lane >> 5); m = fmaxf(m, fabsf(W[(size_t)k * DM + col])); }
            m = fmaxf(m, __shfl_xor(m, 32));
            if (lane < 32) sc[wave * 32 + lane] = m;
            __syncthreads();
            if (tid < 32) { float mm = 0.f;
#pragma unroll
                for (int w = 0; w < 8; ++w) mm = fmaxf(mm, sc[w * 32 + tid]);
                ((float*)(ws + WS_SBD))[g32 * 32 + tid] = (mm > 0.f) ? mm * (1.f / 448.f) : 1.f; }
        } else if (it >= 208 + 176) {
            const int g32 = it - 208 - 176, col = win_src_col_i8(g32 * 32 + (lane & 31)); const float* W = a.in[I_WIN];
            float m = 0.f;
#pragma unroll 8
            for (int i = 0; i < 64; ++i) { const int k = 128 * wave + 2 * i + (lane >> 5); const float v = (col >= 0) ? W[(size_t)k * DIN + col] : 0.f; m = fmaxf(m, fabsf(v)); }
            m = fmaxf(m, __shfl_xor(m, 32));
            if (lane < 32) sc[wave * 32 + lane] = m;
            __syncthreads();
            if (tid < 32) { float mm = 0.f;
#pragma unroll
                for (int w = 0; w < 8; ++w) mm = fmaxf(mm, sc[w * 32 + tid]);
                ((float*)(ws + WS_SBWIN))[g32 * 32 + tid] = (mm > 0.f) ? mm * (1.f / 127.f) : 1.f; }
        } else if (it >= 208) {
            const int g32 = it - 208, np0 = g32 * 32, T = np0 >> 8, rr = np0 & 255; const float* W = (rr < 128) ? a.in[I_WFG] : a.in[I_WFU];
            const int col = T * 128 + (rr & 127) + (lane & 31);
            float m = 0.f, s2 = 0.f;
#pragma unroll 8
            for (int i = 0; i < 64; ++i) { const int k = 128 * wave + 2 * i + (lane >> 5); const float v = W[(size_t)k * DFF + col]; m = fmaxf(m, fabsf(v)); s2 += v * v; }
            m = fmaxf(m, __shfl_xor(m, 32)); s2 += __shfl_xor(s2, 32);
            if (lane < 32) { sc[wave * 32 + lane] = m; sc[256 + wave * 32 + lane] = s2; }
            __syncthreads();
            if (tid < 32) { float mm = 0.f, ss = 0.f;
#pragma unroll
                for (int w = 0; w < 8; ++w) { mm = fmaxf(mm, sc[w * 32 + tid]); ss += sc[256 + w * 32 + tid]; }
                const float sb = (mm > 0.f) ? mm * (1.f / 127.f) : 1.f;
                ((float*)(ws + WS_SBWGU))[g32 * 32 + tid] = sb;
                float cn = sqrtf(ss) * 1.0001f + 16.f * sb;
#pragma unroll
                for (int o = 1; o < 32; o <<= 1) cn = fmaxf(cn, __shfl_xor(cn, o));
                if (tid == 0) ((float*)(ws + WS_WNI))[g32] = cn; }
        } else if (it < 192) {
            const float* c = a.in[I_C];
            for (int i = tid; i < NB * DM; i += NTHREADS) { const int bb = i >> 10, kk = i & 1023; sc[kk * 32 + bb] = siluf_(c[i]); }
            __syncthreads();
            const int cl = tid & 31, ks = tid >> 5, col = it * 32 + cl;
            float acc[32];
#pragma unroll
            for (int j = 0; j < 32; ++j) acc[j] = 0.f;
            const float* W = a.in[I_WADA] + (size_t)(ks * 64) * NADA + col;
#pragma unroll 1
            for (int k0 = 0; k0 < 64; k0 += 8) {
                float w[8];
#pragma unroll
                for (int u = 0; u < 8; ++u) w[u] = W[(size_t)(k0 + u) * NADA];
#pragma unroll
                for (int u = 0; u < 8; ++u) { const LAS f32x4* sp = (const LAS f32x4*)(sc + (ks * 64 + k0 + u) * 32);
#pragma unroll
                    for (int q = 0; q < 8; ++q) { const f32x4 v = sp[q]; acc[4 * q] += v.x * w[u]; acc[4 * q + 1] += v.y * w[u]; acc[4 * q + 2] += v.z * w[u]; acc[4 * q + 3] += v.w * w[u]; } }
            }
            __syncthreads();
#pragma unroll
            for (int j = 0; j < 32; ++j) sc[(ks * 32 + j) * 32 + cl] = acc[j];
            __syncthreads();
            float* mod = (float*)(ws + WS_MOD);
            for (int o = tid; o < 1024; o += NTHREADS) { const int b = o >> 5, c2 = o & 31;
                float s2 = 0.f;
#pragma unroll
                for (int q = 0; q < 16; ++q) s2 += sc[(q * 32 + b) * 32 + c2];
                mod[b * NADA + it * 32 + c2] = s2 + a.in[I_BADA][it * 32 + c2]; }
        } else {
            const int which = (it - 192) >> 3, kq = (it - 192) & 7;
            const float* pe = a.in[which ? I_PECV : I_PECK]; const float* w1 = a.in[which ? I_WCV1 : I_WCK1];
            const int col = tid & 127, ks = tid >> 7; float s = 0.f;
#pragma unroll 8
            for (int k = kq * 256 + ks * 64; k < kq * 256 + ks * 64 + 64; ++k) s += pe[k] * w1[(size_t)k * 128 + col];
            sc[ks * 128 + col] = s;
            __syncthreads();
            if (tid < 128) ((float*)(ws + WS_BIAS))[(which * 8 + kq) * 128 + tid] = sc[tid] + sc[128 + tid] + sc[256 + tid] + sc[384 + tid];
        }
    }
    __syncthreads();
}

__device__ __forceinline__ void transpose_item_i8(const float* __restrict__ W, int ldw, int K, signed char* __restrict__ WQ, const float* __restrict__ SB, int n0p, int k0, int col, LAS float* scr, int lane) {
#pragma unroll 8
    for (int i = 0; i < 32; ++i) { const int kk = 2 * i + (lane >> 5); scr[kk * 33 + (lane & 31)] = (col >= 0) ? W[(size_t)(k0 + kk) * ldw + col] : 0.f; }
    LDS_WAIT(); asm volatile("" ::: "memory");
    const int n = lane >> 1, kh = (lane & 1) * 32; const float inv = 1.f / SB[n0p + n];
#pragma unroll
    for (int c = 0; c < 2; ++c) { unsigned w[4];
#pragma unroll
        for (int d = 0; d < 4; ++d) { unsigned pk = 0u;
#pragma unroll
            for (int j = 0; j < 4; ++j) { const float v = scr[(kh + 16 * c + 4 * d + j) * 33 + n] * inv; int q = (int)rintf(v); q = q > 127 ? 127 : (q < -127 ? -127 : q); pk |= ((unsigned)q & 0xffu) << (8 * j); }
            w[d] = pk; }
        *(u32x4*)(WQ + (size_t)(n0p + n) * K + k0 + kh + 16 * c) = u32x4{w[0], w[1], w[2], w[3]}; }
    LDS_WAIT(); asm volatile("" ::: "memory");
}
__device__ __forceinline__ void wing_quant_items(const Args& a, LAS unsigned char* lds) {
    const int tid = threadIdx.x, lane = tid & 63, wave = __builtin_amdgcn_readfirstlane(tid >> 6); unsigned char* ws = a.ws;
    LAS float* scr = (LAS float*)(lds + wave * 16384);
    const int gw = blockIdx.x * NWAVES + wave, NGW = gridDim.x * NWAVES;
    for (int it = gw; it < 16 * NI8G; it += NGW) { const int kb = it / NI8G, nb = it % NI8G;
        transpose_item_i8(a.in[I_WIN], DIN, DM, (signed char*)(ws + WS_WINGQ), (const float*)(ws + WS_SBWIN), nb * 32, kb * 64, win_src_col_i8(nb * 32 + (lane & 31)), scr, lane); }
}
__device__ __forceinline__ void wgu_quant_items(const Args& a, LAS unsigned char* lds) {
    const int tid = threadIdx.x, lane = tid & 63, wave = __builtin_amdgcn_readfirstlane(tid >> 6); unsigned char* ws = a.ws;
    LAS float* scr = (LAS float*)(lds + wave * 16384);
    const int gw = blockIdx.x * NWAVES + wave, NGW = gridDim.x * NWAVES;
    for (int it = gw; it < 16 * 176; it += NGW) { const int kb = it / 176, nb = it % 176, np0 = nb * 32, T = np0 >> 8, rr = np0 & 255;
        const float* src = (rr < 128) ? a.in[I_WFG] : a.in[I_WFU];
        transpose_item_i8(src, DFF, DM, (signed char*)(ws + WS_WGU), (const float*)(ws + WS_SBWGU), np0, kb * 64, T * 128 + (rr & 127) + (lane & 31), scr, lane); }
}
__device__ __forceinline__ void transpose_item_f8(const float* __restrict__ W, int ldw, int K, unsigned char* __restrict__ WQ, const float* __restrict__ SB, int n0p, int k0, int col, LAS float* scr, int lane) {
#pragma unroll 8
    for (int i = 0; i < 32; ++i) { const int kk = 2 * i + (lane >> 5); scr[kk * 33 + (lane & 31)] = W[(size_t)(k0 + kk) * ldw + col]; }
    LDS_WAIT(); asm volatile("" ::: "memory");
    const int n = lane >> 1, kh = (lane & 1) * 32; const float inv = 1.f / SB[n0p + n];
#pragma unroll
    for (int c = 0; c < 2; ++c) { unsigned w[4];
#pragma unroll
        for (int d = 0; d < 4; ++d) { const LAS float* sp = scr + (kh + 16 * c + 4 * d) * 33 + n;
            int pk = __builtin_amdgcn_cvt_pk_fp8_f32(sp[0] * inv, sp[33] * inv, 0, false); pk = __builtin_amdgcn_cvt_pk_fp8_f32(sp[66] * inv, sp[99] * inv, pk, true);
            w[d] = (unsigned)pk; }
        *(u32x4*)(WQ + (size_t)(n0p + n) * K + k0 + kh + 16 * c) = u32x4{w[0], w[1], w[2], w[3]}; }
    LDS_WAIT(); asm volatile("" ::: "memory");
}
__device__ __forceinline__ void wd_quant_items(const Args& a, LAS unsigned char* lds) {
    const int tid = threadIdx.x, lane = tid & 63, wave = __builtin_amdgcn_readfirstlane(tid >> 6); unsigned char* ws = a.ws;
    LAS float* scr = (LAS float*)(lds + wave * 16384);
    const int gw = blockIdx.x * NWAVES + wave, NGW = gridDim.x * NWAVES;
    for (int it = gw; it < 44 * 32; it += NGW) { const int kb = it / 32, nb = it % 32;
        transpose_item_f8(a.in[I_WFD], DM, DFF, ws + WS_WD, (const float*)(ws + WS_SBD), nb * 32, kb * 64, nb * 32 + (lane & 31), scr, lane); }
}
__device__ __forceinline__ void woab_quant_items(const Args& a, LAS unsigned char* lds) {
    const int tid = threadIdx.x, lane = tid & 63, wave = __builtin_amdgcn_readfirstlane(tid >> 6); unsigned char* ws = a.ws;
    LAS float* scr = (LAS float*)(lds + wave * 16384);
    const int gw = blockIdx.x * NWAVES + wave, NGW = gridDim.x * NWAVES;
    for (int it = gw; it < 2 * 8 * 32; it += NGW) { const int which = it >> 8, r = it & 255, kb = r / 32, nb = r % 32;
        transpose_item_f8(a.in[which ? I_WOB : I_WOA], DM, 512, ws + WS_WOA, (const float*)(ws + WS_SBWO), which * 1024 + nb * 32, kb * 64, nb * 32 + (lane & 31), scr, lane); }
}
__device__ __forceinline__ void wout_quant_items(const Args& a, LAS unsigned char* lds) {
    const int tid = threadIdx.x, lane = tid & 63, wave = __builtin_amdgcn_readfirstlane(tid >> 6); unsigned char* ws = a.ws;
    LAS float* scr = (LAS float*)(lds + wave * 16384);
    const int gw = blockIdx.x * NWAVES + wave, NGW = gridDim.x * NWAVES;
    for (int it = gw; it < 16 * 32; it += NGW) { const int kb = it / 32, nb = it % 32;
        transpose_item_f8(a.in[I_WOUT], DM, DM, ws + WS_WOUT, (const float*)(ws + WS_SBO), nb * 32, kb * 64, nb * 32 + (lane & 31), scr, lane); }
}
__device__ __forceinline__ void wnmax_item(unsigned char* ws) {
    const int lane = threadIdx.x & 63; const float* wni = (const float*)(ws + WS_WNI);
    float g = 0.f, u = 0.f;
    for (int i = lane; i < 176; i += 64) { const float v = wni[i]; if ((i & 7) < 4) g = fmaxf(g, v); else u = fmaxf(u, v); }
    float oa = (lane < 32) ? wni[176 + lane] : 0.f, ob = (lane < 32) ? wni[208 + lane] : 0.f;
    g = wave_max_dpp(g); u = wave_max_dpp(u); oa = wave_max_dpp(oa); ob = wave_max_dpp(ob);
    if (lane == 0) *(f32x4*)(ws + WS_WNMAX) = f32x4{g, u, oa, ob};
}
__device__ __forceinline__ void norm2_quant_phase(const bf16* __restrict__ X1B, const float* __restrict__ rowss, const float* __restrict__ gain, const float* __restrict__ mod, signed char* __restrict__ Q, float* __restrict__ SA, float* __restrict__ SACT, const float* __restrict__ wnmax) {
    const int tid = threadIdx.x, lane = tid & 63, wave = tid >> 6;
    const int gw = blockIdx.x * NWAVES + wave, NGW = gridDim.x * NWAVES, wpb = NGW / NB;
    if (wpb * NB != NGW || gw >= wpb * NB) return;
    const int b = gw / wpb, wi = gw % wpb;
    float mg[2][8], sh[2][8];
#pragma unroll
    for (int j = 0; j < 2; ++j) { const int k = 8 * lane + 512 * j;
#pragma unroll
        for (int h = 0; h < 2; ++h) { const f32x4 g = *(const f32x4*)(gain + k + 4 * h), sc = *(const f32x4*)(mod + b * NADA + 4 * DM + k + 4 * h), s2 = *(const f32x4*)(mod + b * NADA + 3 * DM + k + 4 * h);
            mg[j][4 * h] = g.x * (1.f + sc.x); mg[j][4 * h + 1] = g.y * (1.f + sc.y); mg[j][4 * h + 2] = g.z * (1.f + sc.z); mg[j][4 * h + 3] = g.w * (1.f + sc.w);
            sh[j][4 * h] = s2.x; sh[j][4 * h + 1] = s2.y; sh[j][4 * h + 2] = s2.z; sh[j][4 * h + 3] = s2.w; } }
    const float wprod = wnmax[0] * wnmax[1] * (1.f / 440.f);
    u32x4 qn[2]; float rsn;
    { const size_t m0 = (size_t)b * SEQ + wi; const u32x4* xr = (const u32x4*)(X1B + m0 * DM) + lane; qn[0] = xr[0]; qn[1] = xr[64]; rsn = rowss[m0]; }
    for (int t = wi; t < SEQ; t += wpb) {
        const size_t m = (size_t)b * SEQ + t;
        const u32x4 q0 = qn[0], q1 = qn[1]; const float rstd = rsqrtf(rsn * (1.f / DM) + RMS_EPS);
        if (t + wpb < SEQ) { const u32x4* xr = (const u32x4*)(X1B + (m + wpb) * DM) + lane; qn[0] = xr[0]; qn[1] = xr[64]; rsn = rowss[m + wpb]; }
        float v[2][8]; float amax = 0.f, vss = 0.f;
#pragma unroll
        for (int j = 0; j < 2; ++j) { const u32x4 q = j ? q1 : q0; const unsigned w[4] = {q.x, q.y, q.z, q.w};
#pragma unroll
            for (int e = 0; e < 8; ++e) { const float x = __uint_as_float((e & 1) ? (w[e >> 1] & 0xffff0000u) : (w[e >> 1] << 16));
                v[j][e] = x * rstd * mg[j][e] + sh[j][e]; amax = fmaxf(amax, fabsf(v[j][e])); vss += v[j][e] * v[j][e]; } }
        amax = wave_max_dpp(amax); vss = wave_sum_dpp(vss);
        const float inv = (amax > 0.f) ? 127.f / amax : 0.f;
        u32x2* q8 = (u32x2*)(Q + m * DM) + lane;
#pragma unroll
        for (int j = 0; j < 2; ++j) { unsigned pk[2];
#pragma unroll
            for (int d = 0; d < 2; ++d) { unsigned p = 0u;
#pragma unroll
                for (int e = 0; e < 4; ++e) p |= ((unsigned)(int)rintf(v[j][4 * d + e] * inv) & 0xffu) << (8 * e);
                pk[d] = p; }
            q8[64 * j] = u32x2{pk[0], pk[1]}; }
        if (lane == 0) { const float sa = (amax > 0.f) ? amax * (1.f / 127.f) : 1.f; SA[m] = sa;
            const float hn = sqrtf(vss) * 1.0001f + 16.f * sa;
            const float bd = hn * hn * wprod; SACT[m] = (bd > 0.f) ? bd : 1.f; }
    }
}

__device__ __forceinline__ void norm_dual_phase(const float* __restrict__ X, const float* __restrict__ gain, const float* __restrict__ mod, int shift_off, int scale_off, bf16* __restrict__ O, signed char* __restrict__ Q, float* __restrict__ SA) {
    const int tid = threadIdx.x, lane = tid & 63, wave = tid >> 6;
    const int gw = blockIdx.x * NWAVES + wave, NGW = gridDim.x * NWAVES, wpb = NGW / NB;
    if (wpb * NB != NGW || gw >= wpb * NB) return;
    const int b = gw / wpb, wi = gw % wpb;
    f32x4 mg[4], sh[4];
#pragma unroll
    for (int q = 0; q < 4; ++q) { const int k = 8 * lane + 512 * (q >> 1) + 4 * (q & 1);
        const f32x4 g = *(const f32x4*)(gain + k), sc = *(const f32x4*)(mod + b * NADA + scale_off + k); sh[q] = *(const f32x4*)(mod + b * NADA + shift_off + k);
        mg[q] = f32x4{g.x * (1.f + sc.x), g.y * (1.f + sc.y), g.z * (1.f + sc.z), g.w * (1.f + sc.w)}; }
    f32x4 vn[4];
    { const f32x4* xr = (const f32x4*)(X + ((size_t)b * SEQ + wi) * DM) + 2 * lane;
#pragma unroll
      for (int j = 0; j < 2; ++j) { vn[2 * j] = xr[128 * j]; vn[2 * j + 1] = xr[128 * j + 1]; } }
    for (int t = wi; t < SEQ; t += wpb) {
        const size_t m = (size_t)b * SEQ + t;
        f32x4 v[4]; float s = 0.f;
#pragma unroll
        for (int j = 0; j < 4; ++j) { v[j] = vn[j]; s += (v[j].x * v[j].x + v[j].y * v[j].y) + (v[j].z * v[j].z + v[j].w * v[j].w); }
        if (t + wpb < SEQ) { const f32x4* xr = (const f32x4*)(X + (m + wpb) * DM) + 2 * lane;
#pragma unroll
            for (int j = 0; j < 2; ++j) { vn[2 * j] = xr[128 * j]; vn[2 * j + 1] = xr[128 * j + 1]; } }
        const float rstd = rsqrtf(wave_sum_dpp(s) * (1.f / DM) + RMS_EPS);
        float amax = 0.f;
#pragma unroll
        for (int q = 0; q < 4; ++q) {
            v[q].x = v[q].x * rstd * mg[q].x + sh[q].x; v[q].y = v[q].y * rstd * mg[q].y + sh[q].y; v[q].z = v[q].z * rstd * mg[q].z + sh[q].z; v[q].w = v[q].w * rstd * mg[q].w + sh[q].w;
            amax = fmaxf(fmaxf(amax, fmaxf(fabsf(v[q].x), fabsf(v[q].y))), fmaxf(fabsf(v[q].z), fabsf(v[q].w)));
        }
        u32x4* o16 = (u32x4*)(O + m * DM) + lane;
#pragma unroll
        for (int j = 0; j < 2; ++j) o16[64 * j] = u32x4{cvt_pk(v[2 * j].x, v[2 * j].y), cvt_pk(v[2 * j].z, v[2 * j].w), cvt_pk(v[2 * j + 1].x, v[2 * j + 1].y), cvt_pk(v[2 * j + 1].z, v[2 * j + 1].w)};
        amax = wave_max_dpp(amax);
        const float inv = (amax > 0.f) ? 127.f / amax : 0.f;
        u32x2* q8 = (u32x2*)(Q + m * DM) + lane;
#pragma unroll
        for (int j = 0; j < 2; ++j) { unsigned pk[2];
#pragma unroll
            for (int d = 0; d < 2; ++d) { const f32x4 tt = v[2 * j + d]; const int q0 = (int)rintf(tt.x * inv), q1 = (int)rintf(tt.y * inv), q2 = (int)rintf(tt.z * inv), q3 = (int)rintf(tt.w * inv);
                pk[d] = ((unsigned)q0 & 0xffu) | (((unsigned)q1 & 0xffu) << 8) | (((unsigned)q2 & 0xffu) << 16) | (((unsigned)q3 & 0xffu) << 24); }
            q8[64 * j] = u32x2{pk[0], pk[1]}; }
        if (lane == 0) SA[m] = (amax > 0.f) ? amax * (1.f / 127.f) : 1.f;
    }
}

typedef const pg8::f32x4 (&AccRef)[2][2][4][2];

template <bool I8> struct EpiProj {
    static constexpr bool PERM = true, AFTER_DRAIN = false;
    unsigned char* ws; const float *g_q_a, *g_ks_a, *g_kw_a, *g_q_b, *g_k_b;
    __device__ __forceinline__ void operator()(AccRef acc_c, const pg8::Unit& u, int wr, int wc, int fr, int fq) const {
        const int T = I8 ? tmap_i8(u.pn) : tmap_bf(u.pn), row0 = u.pm * 256 + wr * 64 + fr, b = (u.pm * 256) >> 11;
        pg8::f32x4 (&acc)[2][2][4][2] = const_cast<pg8::f32x4 (&)[2][2][4][2]>(acc_c);
        if (I8) {
            const float* SA = (const float*)(ws + WS_SA1); const float* SB = (const float*)(ws + WS_SBWIN) + u.pn * 256 + wc * 32 + 8 * fq;
            f32x4 sb[2][2];
#pragma unroll
            for (int bj = 0; bj < 2; ++bj)
#pragma unroll
                for (int n = 0; n < 2; ++n) sb[bj][n] = *(const f32x4*)(SB + bj * 128 + 4 * n);
#pragma unroll
            for (int ai = 0; ai < 2; ++ai)
#pragma unroll
                for (int m = 0; m < 4; ++m) { const float sa = SA[row0 + ai * 128 + m * 16];
#pragma unroll
                    for (int bj = 0; bj < 2; ++bj)
#pragma unroll
                        for (int n = 0; n < 2; ++n) { acc[ai][bj][m][n][0] *= sa * sb[bj][n].x; acc[ai][bj][m][n][1] *= sa * sb[bj][n].y; acc[ai][bj][m][n][2] *= sa * sb[bj][n].z; acc[ai][bj][m][n][3] *= sa * sb[bj][n].w; } }
        }
        if (T >= 10) {
            unsigned char* G = ws + (T >= 14 ? WS_GB : WS_GA); const int cbase = ((T - 10) & 3) * 256 + wc * 32 + 8 * fq;
#pragma unroll
            for (int ai = 0; ai < 2; ++ai)
#pragma unroll
                for (int m = 0; m < 4; ++m) { const size_t row = row0 + ai * 128 + m * 16;
#pragma unroll
                    for (int bj = 0; bj < 2; ++bj) { const pg8::f32x4 v0 = acc[ai][bj][m][0], v1 = acc[ai][bj][m][1];
                        int w0 = __builtin_amdgcn_cvt_pk_fp8_f32(256.f * sigmoidf_(v0[0]), 256.f * sigmoidf_(v0[1]), 0, false); w0 = __builtin_amdgcn_cvt_pk_fp8_f32(256.f * sigmoidf_(v0[2]), 256.f * sigmoidf_(v0[3]), w0, true);
                        int w1 = __builtin_amdgcn_cvt_pk_fp8_f32(256.f * sigmoidf_(v1[0]), 256.f * sigmoidf_(v1[1]), 0, false); w1 = __builtin_amdgcn_cvt_pk_fp8_f32(256.f * sigmoidf_(v1[2]), 256.f * sigmoidf_(v1[3]), w1, true);
                        *(u32x2*)(G + row * 1024 + cbase + bj * 128) = u32x2{(unsigned)w0, (unsigned)w1}; } }
            return;
        }
        const int slot = wc;
        if (T == 7 && slot == 3) {
            float* GN = (float*)(ws + WS_GN); float* IW = (float*)(ws + WS_IW);
#pragma unroll
            for (int ai = 0; ai < 2; ++ai)
#pragma unroll
                for (int m = 0; m < 4; ++m) { const size_t row = row0 + ai * 128 + m * 16; const pg8::f32x4 v0 = acc[ai][0][m][0], v1 = acc[ai][0][m][1];
                    if (fq < 3) { f32x4 a0 = {sigmoidf_(v0[0]), sigmoidf_(v0[1]), sigmoidf_(v0[2]), sigmoidf_(v0[3])}, a1 = {sigmoidf_(v1[0]), sigmoidf_(v1[1]), sigmoidf_(v1[2]), sigmoidf_(v1[3])};
                        *(f32x4*)(GN + row * 24 + 8 * fq) = a0; *(f32x4*)(GN + row * 24 + 8 * fq + 4) = a1; }
                    else { const float s = 0.35355339059327373f; f32x4 a0 = {v0[0] * s, v0[1] * s, v0[2] * s, v0[3] * s}, a1 = {v1[0] * s, v1[1] * s, v1[2] * s, v1[3] * s};
                        *(f32x4*)(IW + row * 8) = a0; *(f32x4*)(IW + row * 8 + 4) = a1; } }
            return;
        }
        const float* gain = nullptr; float scale = 1.f; bf16* dst; size_t pitch, extra;
        switch (T) {
            case 0: case 1: gain = g_q_a; scale = QSCALE; dst = (bf16*)(ws + WS_QA); pitch = 512; extra = (size_t)(T * 4 + slot) * 64; break;
            case 5: case 6: gain = g_q_b; scale = QSCALE; dst = (bf16*)(ws + WS_QB); pitch = 512; extra = (size_t)((T - 5) * 4 + slot) * 64; break;
            case 8: case 9: scale = 0.125f; dst = (bf16*)(ws + WS_IQ); pitch = 512; extra = (size_t)((T - 8) * 4 + slot) * 64; break;
            case 2: dst = (bf16*)(ws + (slot < 2 ? WS_KC : WS_VC)); pitch = 64; extra = (size_t)(b + (slot & 1)) * SEQ * 64; break;
            case 3: if (slot < 2) gain = g_ks_a; dst = (bf16*)(ws + (slot < 2 ? WS_KS : WS_VS)); pitch = 64; extra = (size_t)(b + (slot & 1)) * SEQ * 64; break;
            case 4: if (slot < 2) gain = g_kw_a; dst = (bf16*)(ws + (slot < 2 ? WS_KW : WS_VW)); pitch = 64; extra = (size_t)(b + (slot & 1)) * SEQ * 64; break;
            default: if (slot == 0) gain = g_k_b; dst = (bf16*)(ws + (slot == 0 ? WS_KB : (slot == 1 ? WS_VB : WS_IK))); pitch = 64; extra = 0; break;
        }
        const int vidx = ((T == 3 || T == 4) && slot >= 2) ? (T - 2) : ((T == 7 && slot == 1) ? 3 : -1);
        float vmx = 0.f;
        float gv[2][8];
#pragma unroll
        for (int bj = 0; bj < 2; ++bj)
#pragma unroll
            for (int e = 0; e < 8; ++e) gv[bj][e] = gain ? gain[32 * bj + 8 * fq + e] * scale : scale;
#pragma unroll
        for (int ai = 0; ai < 2; ++ai)
#pragma unroll
            for (int m = 0; m < 4; ++m) { const size_t row = row0 + ai * 128 + m * 16;
                float rstd = 1.f;
                if (gain) { float ss = 0.f;
#pragma unroll
                    for (int bj = 0; bj < 2; ++bj)
#pragma unroll
                        for (int n = 0; n < 2; ++n) { const pg8::f32x4 v = acc[ai][bj][m][n]; ss += (v[0] * v[0] + v[1] * v[1]) + (v[2] * v[2] + v[3] * v[3]); }
                    ss += __shfl_xor(ss, 16); ss += __shfl_xor(ss, 32);
                    rstd = rsqrtf(ss * (1.f / 64.f) + RMS_EPS); }
#pragma unroll
                for (int bj = 0; bj < 2; ++bj) { const pg8::f32x4 v0 = acc[ai][bj][m][0], v1 = acc[ai][bj][m][1]; u32x4 w;
                    w.x = cvt_pk(v0[0] * rstd * gv[bj][0], v0[1] * rstd * gv[bj][1]); w.y = cvt_pk(v0[2] * rstd * gv[bj][2], v0[3] * rstd * gv[bj][3]);
                    w.z = cvt_pk(v1[0] * rstd * gv[bj][4], v1[1] * rstd * gv[bj][5]); w.w = cvt_pk(v1[2] * rstd * gv[bj][6], v1[3] * rstd * gv[bj][7]);
                    if (vidx >= 0) vmx = fmaxf(fmaxf(fmaxf(vmx, fmaxf(fabsf(v0[0]), fabsf(v0[1]))), fmaxf(fabsf(v0[2]), fabsf(v0[3]))), fmaxf(fmaxf(fabsf(v1[0]), fabsf(v1[1])), fmaxf(fabsf(v1[2]), fabsf(v1[3]))));
                    *(u32x4*)(dst + row * pitch + extra + 32 * bj + 8 * fq) = w; } }
        if (vidx >= 0) { vmx = wave_max_dpp(vmx) * 1.004f; if ((threadIdx.x & 63) == 0) atomicMax((unsigned*)(ws + WS_VMAX) + vidx, __float_as_uint(vmx)); }
    }
};

template <bool SECOND> struct EpiY {
    static constexpr bool PERM = true, AFTER_DRAIN = false;
    const unsigned char* G; bf16* Y; unsigned char* Y8; const float* rna; const float* rnb; const float* wn; float so; const float* sbw;
    __device__ __forceinline__ void operator()(AccRef acc, const pg8::Unit& u, int wr, int wc, int fr, int fq) const {
        const int row0 = u.pm * 256 + wr * 64 + fr, col0 = u.pn * 256 + wc * 32 + 8 * fq;
        float cs[2][8];
#pragma unroll
        for (int bj = 0; bj < 2; ++bj) { const f32x4 c0 = *(const f32x4*)(sbw + col0 + bj * 128), c1 = *(const f32x4*)(sbw + col0 + bj * 128 + 4);
            const float so_ = so * (1.f / 256.f);
            cs[bj][0] = c0.x * so_; cs[bj][1] = c0.y * so_; cs[bj][2] = c0.z * so_; cs[bj][3] = c0.w * so_; cs[bj][4] = c1.x * so_; cs[bj][5] = c1.y * so_; cs[bj][6] = c1.z * so_; cs[bj][7] = c1.w * so_; }
        const float wa = wn[2], wb = wn[3];
        const unsigned gb0 = (unsigned)row0 * 2048u + (unsigned)col0 * 2u;
        u32x2 gq[2][2][2], yq[2][2]; float ra[2], rb[2]; u32x2 o8[2][2];
        unsigned char* YA = (unsigned char*)Y;
#define EPIY_ROW(qd, mm) ((unsigned)(((qd) >> 1) * 128 + (((qd) & 1) * 2 + (mm)) * 16))
#define EPIY_LOAD(qd, B) { _Pragma("unroll") for (int mm = 0; mm < 2; ++mm) { const unsigned rr = EPIY_ROW(qd, mm); \
            _Pragma("unroll") for (int bj = 0; bj < 2; ++bj) gq[B][mm][bj] = *(const u32x2*)(G + ((gb0 + rr * 2048u + (unsigned)bj * 256u) >> 1)); } }
#define EPIY_LOADY(qd) { _Pragma("unroll") for (int mm = 0; mm < 2; ++mm) { const unsigned rr = EPIY_ROW(qd, mm); \
            ra[mm] = *(const float*)((const char*)rna + ((unsigned)row0 + rr) * 4u); rb[mm] = *(const float*)((const char*)rnb + ((unsigned)row0 + rr) * 4u); \
            if (SECOND) { _Pragma("unroll") for (int bj = 0; bj < 2; ++bj) yq[mm][bj] = *(const u32x2*)(YA + ((gb0 + rr * 2048u + (unsigned)bj * 256u) >> 1)); } } }
#define EPIY_COMPUTE(qd, B) { typedef float f32x2g __attribute__((ext_vector_type(2))); _Pragma("unroll") for (int mm = 0; mm < 2; ++mm) { const float is_ = __builtin_amdgcn_rcpf(sy_scale(ra[mm], rb[mm], wa, wb)); \
            _Pragma("unroll") for (int bj = 0; bj < 2; ++bj) { \
            const u32x2 g2 = gq[B][mm][bj]; u32x2 y2 = {0u, 0u}; if (SECOND) y2 = yq[mm][bj]; \
            const f32x2g ga_ = __builtin_amdgcn_cvt_pk_f32_fp8((int)g2.x, false), gb_ = __builtin_amdgcn_cvt_pk_f32_fp8((int)g2.x, true), gc_ = __builtin_amdgcn_cvt_pk_f32_fp8((int)g2.y, false), gd_ = __builtin_amdgcn_cvt_pk_f32_fp8((int)g2.y, true); \
            const f32x2g ya_ = __builtin_amdgcn_cvt_pk_f32_fp8((int)y2.x, false), yb_ = __builtin_amdgcn_cvt_pk_f32_fp8((int)y2.x, true), yc_ = __builtin_amdgcn_cvt_pk_f32_fp8((int)y2.y, false), yd_ = __builtin_amdgcn_cvt_pk_f32_fp8((int)y2.y, true); \
            const float gf[8] = {ga_.x, ga_.y, gb_.x, gb_.y, gc_.x, gc_.y, gd_.x, gd_.y}, yf[8] = {ya_.x, ya_.y, yb_.x, yb_.y, yc_.x, yc_.y, yd_.x, yd_.y}; \
            const pg8::f32x4 v0 = acc[(qd) >> 1][bj][((qd) & 1) * 2 + mm][0], v1 = acc[(qd) >> 1][bj][((qd) & 1) * 2 + mm][1]; float r[8]; \
            _Pragma("unroll") for (int e = 0; e < 8; ++e) { const float a_ = ((e < 4) ? v0[e] : v1[e - 4]) * cs[bj][e]; \
                r[e] = gf[e] * a_ * is_ + (SECOND ? yf[e] : 0.f); }       \
            int w0 = __builtin_amdgcn_cvt_pk_fp8_f32(r[0], r[1], 0, false); w0 = __builtin_amdgcn_cvt_pk_fp8_f32(r[2], r[3], w0, true); \
            int w1 = __builtin_amdgcn_cvt_pk_fp8_f32(r[4], r[5], 0, false); w1 = __builtin_amdgcn_cvt_pk_fp8_f32(r[6], r[7], w1, true); \
            o8[mm][bj] = u32x2{(unsigned)w0, (unsigned)w1}; } } \
        asm volatile("" :: "v"(o8[0][0]), "v"(o8[0][1]), "v"(o8[1][0]), "v"(o8[1][1]) : "memory"); }
#define EPIY_STORE(qd) { _Pragma("unroll") for (int mm = 0; mm < 2; ++mm) _Pragma("unroll") for (int bj = 0; bj < 2; ++bj) { const unsigned ob = (gb0 + EPIY_ROW(qd, mm) * 2048u + (unsigned)bj * 256u) >> 1; \
            *(u32x2*)((SECOND ? Y8 : YA) + ob) = o8[mm][bj]; } }
        EPIY_LOAD(0, 0) EPIY_LOAD(1, 1) EPIY_LOADY(0)
        EPIY_COMPUTE(0, 0) EPIY_LOAD(2, 0) EPIY_LOADY(1) EPIY_STORE(0)
        EPIY_COMPUTE(1, 1) EPIY_LOAD(3, 1) EPIY_LOADY(2) EPIY_STORE(1)
        EPIY_COMPUTE(2, 0) EPIY_LOADY(3) EPIY_STORE(2)
        EPIY_COMPUTE(3, 1) EPIY_STORE(3)
#undef EPIY_ROW
#undef EPIY_LOAD
#undef EPIY_LOADY
#undef EPIY_COMPUTE
#undef EPIY_STORE
    }
};

struct EpiX1 {
    static constexpr bool PERM = true, AFTER_DRAIN = false;
    const float* X; bf16* X1B; float* rowss; const float* mod; const float* rna; const float* rnb; const float* wn; const float* SBO;
    __device__ __forceinline__ void operator()(AccRef acc, const pg8::Unit& u, int wr, int wc, int fr, int fq) const {
        const int row0 = u.pm * 256 + wr * 64 + fr, col0 = u.pn * 256 + wc * 32 + 8 * fq, b = (u.pm * 256) >> 11;
        f32x4 gt[2][2];
#pragma unroll
        for (int bj = 0; bj < 2; ++bj)
#pragma unroll
            for (int n = 0; n < 2; ++n) { const f32x4 g = *(const f32x4*)(mod + b * NADA + 2 * DM + col0 + bj * 128 + 4 * n), sb = *(const f32x4*)(SBO + col0 + bj * 128 + 4 * n);
                gt[bj][n] = f32x4{g.x * sb.x, g.y * sb.y, g.z * sb.z, g.w * sb.w}; }
        const float wa = wn[2], wb = wn[3];
#pragma unroll
        for (int ai = 0; ai < 2; ++ai)
#pragma unroll
            for (int m = 0; m < 4; ++m) { const size_t row = row0 + ai * 128 + m * 16; float ss = 0.f; const float sy = sy_scale(rna[row], rnb[row], wa, wb);
#pragma unroll
                for (int bj = 0; bj < 2; ++bj) { const size_t off = row * 1024 + col0 + bj * 128; float x1[8];
#pragma unroll
                    for (int n = 0; n < 2; ++n) { const f32x4 xv = *(const f32x4*)(X + off + 4 * n); pg8::f32x4 v = acc[ai][bj][m][n]; v[0] *= sy; v[1] *= sy; v[2] *= sy; v[3] *= sy;
                        x1[4 * n] = xv.x + gt[bj][n].x * v[0]; x1[4 * n + 1] = xv.y + gt[bj][n].y * v[1]; x1[4 * n + 2] = xv.z + gt[bj][n].z * v[2]; x1[4 * n + 3] = xv.w + gt[bj][n].w * v[3]; }
#pragma unroll
                    for (int e2 = 0; e2 < 8; ++e2) ss += x1[e2] * x1[e2];
                    u32x4 w1; w1.x = cvt_pk(x1[0], x1[1]); w1.y = cvt_pk(x1[2], x1[3]); w1.z = cvt_pk(x1[4], x1[5]); w1.w = cvt_pk(x1[6], x1[7]);
                    *(u32x4*)(X1B + off) = w1; }
                ss += __shfl_xor(ss, 16); ss += __shfl_xor(ss, 32);
                if (fq == 0) unsafeAtomicAdd(rowss + row, ss); }
    }
};

struct EpiOut {
    static constexpr bool PERM = true, AFTER_DRAIN = false;
    const bf16* X1B; float* OUT; const float* mod; const float* SACT; const float* SBD;
    __device__ __forceinline__ void operator()(AccRef acc, const pg8::Unit& u, int wr, int wc, int fr, int fq) const {
        const int row0 = u.pm * 256 + wr * 64 + fr, col0 = u.pn * 256 + wc * 32 + 8 * fq, b = (u.pm * 256) >> 11;
        f32x4 gt[2][2];
#pragma unroll
        for (int bj = 0; bj < 2; ++bj)
#pragma unroll
            for (int n = 0; n < 2; ++n) { const f32x4 g = *(const f32x4*)(mod + b * NADA + 5 * DM + col0 + bj * 128 + 4 * n), sb = *(const f32x4*)(SBD + col0 + bj * 128 + 4 * n);
                gt[bj][n] = f32x4{g.x * sb.x, g.y * sb.y, g.z * sb.z, g.w * sb.w}; }
#pragma unroll
        for (int ai = 0; ai < 2; ++ai)
#pragma unroll
            for (int m = 0; m < 4; ++m) { const size_t row = row0 + ai * 128 + m * 16; const float sa = SACT[row];
#pragma unroll
                for (int bj = 0; bj < 2; ++bj) { const size_t off = row * 1024 + col0 + bj * 128;
                    const u32x4 xq = *(const u32x4*)(X1B + off); const unsigned xw[4] = {xq.x, xq.y, xq.z, xq.w};
#pragma unroll
                    for (int n = 0; n < 2; ++n) { pg8::f32x4 v = acc[ai][bj][m][n]; v[0] *= sa; v[1] *= sa; v[2] *= sa; v[3] *= sa;
                        const float x0 = __uint_as_float(xw[2 * n] << 16), x1 = __uint_as_float(xw[2 * n] & 0xffff0000u), x2 = __uint_as_float(xw[2 * n + 1] << 16), x3 = __uint_as_float(xw[2 * n + 1] & 0xffff0000u);
                        f32x4 o = {x0 + gt[bj][n].x * v[0], x1 + gt[bj][n].y * v[1], x2 + gt[bj][n].z * v[2], x3 + gt[bj][n].w * v[3]};
                        *(f32x4*)(OUT + off + 4 * n) = o; } } }
    }
};

struct PairOrder {
    pg8::StaticOrder base;
    __device__ __forceinline__ void init(int G, int c) { base.init(MROWS, DM, G, c); }
    __device__ __forceinline__ bool next(int i, pg8::Unit& u) const { if (!base.next(i >> 1, u)) return false; if (i & 1) { u.pm += 256; u.pn += 4; } return true; }
    __device__ __forceinline__ void a_ready(const pg8::Unit&) const {}
    __device__ __forceinline__ void done(const pg8::Unit&) const {}
};
struct EpiYPair {
    static constexpr bool PERM = true, AFTER_DRAIN = false;
    const unsigned char* GA; const unsigned char* GB; bf16* Y; unsigned char* Y8; const float* rna; const float* rnb; const float* wn; const float* vm; const float* sbwo;
    __device__ __forceinline__ void operator()(AccRef acc, const pg8::Unit& u, int wr, int wc, int fr, int fq) const {
        if (u.pm < 256) { EpiY<false> E{GA, Y, Y8, rna, rnb, wn, so_scale_a(vm), sbwo}; E(acc, u, wr, wc, fr, fq); }
        else { pg8::Unit v; v.pm = u.pm - 256; v.pn = u.pn - 4; EpiY<true> E{GB, Y, Y8, rna, rnb, wn, so_scale_b(vm), sbwo + 1024}; E(acc, v, wr, wc, fr, fq); }
    }
};

struct EpiAct3 {
    static constexpr bool PERM = true, AFTER_DRAIN = false, KEEPS = false;
    unsigned char* ACT; const float* SA; const float* SB; const float* SACT;
    __device__ __forceinline__ void operator()(AccRef acc, const pg8::Unit& u, int wr, int wc, int fr, int fq) const {
        const int row0 = u.pm * 256 + wr * 64 + fr, col0 = u.pn * 128 + wc * 32 + 8 * fq;
        const float* sb = SB + u.pn * 256 + wc * 32 + 8 * fq;
        const f32x4 g0 = *(const f32x4*)(sb), g1 = *(const f32x4*)(sb + 4), u0 = *(const f32x4*)(sb + 128), u1 = *(const f32x4*)(sb + 132);
        const float sg[8] = {g0.x, g0.y, g0.z, g0.w, g1.x, g1.y, g1.z, g1.w}, su[8] = {u0.x, u0.y, u0.z, u0.w, u1.x, u1.y, u1.z, u1.w};
#pragma unroll
        for (int ai = 0; ai < 2; ++ai)
#pragma unroll
            for (int m = 0; m < 4; ++m) { const size_t row = row0 + ai * 128 + m * 16; float r[8]; const float sa = SA[row], ia = __builtin_amdgcn_rcpf(SACT[row]);
#pragma unroll
                for (int n = 0; n < 2; ++n)
#pragma unroll
                    for (int e = 0; e < 4; ++e) { const float g = acc[ai][0][m][n][e] * (sa * sg[4 * n + e]), up = acc[ai][1][m][n][e] * (sa * su[4 * n + e]); r[4 * n + e] = siluf_(g) * (up * ia); }
                int w0 = __builtin_amdgcn_cvt_pk_fp8_f32(r[0], r[1], 0, false); w0 = __builtin_amdgcn_cvt_pk_fp8_f32(r[2], r[3], w0, true);
                int w1 = __builtin_amdgcn_cvt_pk_fp8_f32(r[4], r[5], 0, false); w1 = __builtin_amdgcn_cvt_pk_fp8_f32(r[6], r[7], w1, true);
                *(u32x2*)(ACT + row * DFF + col0) = u32x2{(unsigned)w0, (unsigned)w1}; }
    }
};


#define MFMA32(a, b, c) __builtin_amdgcn_mfma_f32_32x32x16_bf16(a, b, c, 0, 0, 0)
#define LDS_BARRIER() asm volatile("s_waitcnt lgkmcnt(0)\n\ts_barrier" ::: "memory")
__device__ __forceinline__ int crow(int r, int hi) { return (r & 3) + 8 * (r >> 2) + 4 * hi; }

__device__ __forceinline__ void compress_phase(const Args& a, LAS unsigned char* lds) {
    const int tid = threadIdx.x, lane = tid & 63, wave = __builtin_amdgcn_readfirstlane(tid >> 6), r32 = lane & 31, hi = lane >> 5;
    unsigned char* ws = a.ws;
    constexpr int PITCH = 528, A_OFF = 0, B_OFF = 64 * PITCH;
    LAS float* hid = (LAS float*)lds;
    for (int u = blockIdx.x; u < 256; u += gridDim.x) {
        const int which = u >> 7, bg = (u >> 1) & 63, n0 = (u & 1) * 64;
        const bf16* A = (const bf16*)(ws + (which ? WS_VC : WS_KC)) + ((size_t)bg * SEQ + (size_t)n0 * 16) * 64;
        const bf16* W1 = (const bf16*)(ws + (which ? WS_WCV1 : WS_WCK1));
        const int rb = wave & 1, cb = wave >> 1;
        f32x16 acc = {};
        u32x4 ra[4], rw[8];
#pragma unroll
        for (int i = 0; i < 4; ++i) { const int p = tid + 512 * i, row = p >> 5, c = p & 31; ra[i] = *(const u32x4*)(A + (size_t)row * 1024 + c * 8); }
#pragma unroll
        for (int i = 0; i < 8; ++i) { const int p = tid + 512 * i, row = p >> 5, c = p & 31; rw[i] = *(const u32x4*)(W1 + (size_t)row * 2048 + c * 8); }
        for (int kc = 0; kc < 8; ++kc) {
            __syncthreads();
#pragma unroll
            for (int i = 0; i < 4; ++i) { const int p = tid + 512 * i, row = p >> 5, c = p & 31; *(LAS u32x4*)(lds + A_OFF + row * PITCH + c * 16) = ra[i]; }
#pragma unroll
            for (int i = 0; i < 8; ++i) { const int p = tid + 512 * i, row = p >> 5, c = p & 31; *(LAS u32x4*)(lds + B_OFF + row * PITCH + c * 16) = rw[i]; }
            if (kc < 7) {
#pragma unroll
                for (int i = 0; i < 4; ++i) { const int p = tid + 512 * i, row = p >> 5, c = p & 31; ra[i] = *(const u32x4*)(A + (size_t)row * 1024 + (kc + 1) * 256 + c * 8); }
#pragma unroll
                for (int i = 0; i < 8; ++i) { const int p = tid + 512 * i, row = p >> 5, c = p & 31; rw[i] = *(const u32x4*)(W1 + (size_t)row * 2048 + (kc + 1) * 256 + c * 8); }
            }
            LDS_BARRIER();
            const LAS unsigned char* ap = lds + A_OFF + (rb * 32 + r32) * PITCH + hi * 16;
            const LAS unsigned char* bp = lds + B_OFF + (cb * 32 + r32) * PITCH + hi * 16;
#pragma unroll
            for (int ks = 0; ks < 16; ++ks) acc = MFMA32(*(const LAS bf16x8*)(ap + ks * 32), *(const LAS bf16x8*)(bp + ks * 32), acc);
        }
        __syncthreads();
        { float bias = 0.f;
#pragma unroll
          for (int q = 0; q < 8; ++q) bias += ((const float*)(ws + WS_BIAS))[(which * 8 + q) * 128 + cb * 32 + r32];
#pragma unroll
          for (int r = 0; r < 16; ++r) hid[(rb * 32 + crow(r, hi)) * 132 + cb * 32 + r32] = siluf_(acc[r] + bias); }
        __syncthreads();
        { const int row = tid >> 3, dc = (tid & 7) * 8; const float* w2 = a.in[which ? I_WCV2 : I_WCK2];
          float o[8];
#pragma unroll
          for (int j = 0; j < 8; ++j) o[j] = 0.f;
#pragma unroll 8
          for (int k = 0; k < 128; ++k) { const float h = hid[row * 132 + k]; const f32x4 wa = *(const f32x4*)(w2 + k * 64 + dc), wb = *(const f32x4*)(w2 + k * 64 + dc + 4);
              o[0] += h * wa.x; o[1] += h * wa.y; o[2] += h * wa.z; o[3] += h * wa.w; o[4] += h * wb.x; o[5] += h * wb.y; o[6] += h * wb.z; o[7] += h * wb.w; }
          if (!which) { float ss = 0.f;
#pragma unroll
              for (int j = 0; j < 8; ++j) ss += o[j] * o[j];
              ss += __shfl_xor(ss, 1); ss += __shfl_xor(ss, 2); ss += __shfl_xor(ss, 4);
              const float rstd = rsqrtf(ss * (1.f / 64.f) + RMS_EPS); const float* gk = a.in[I_GKC];
#pragma unroll
              for (int j = 0; j < 8; ++j) o[j] = o[j] * rstd * gk[dc + j]; }
          const int n = n0 + row;
          if (n >= 127) {
#pragma unroll
              for (int j = 0; j < 8; ++j) o[j] = 0.f; }
          u32x4 w; w.x = cvt_pk(o[0], o[1]); w.y = cvt_pk(o[2], o[3]); w.z = cvt_pk(o[4], o[5]); w.w = cvt_pk(o[6], o[7]);
          if (which) { float vmx = 0.f;
#pragma unroll
              for (int j = 0; j < 8; ++j) vmx = fmaxf(vmx, fabsf(o[j]));
              vmx = wave_max_dpp(vmx) * 1.004f; if (lane == 0) atomicMax((unsigned*)(ws + WS_VMAX), __float_as_uint(vmx)); }
          *(u32x4*)((bf16*)(ws + (which ? WS_VCO : WS_KCO)) + ((size_t)bg * 128 + n) * 64 + dc) = w; }
    }
    __syncthreads();
}

typedef LAS const char* lds_cptr;
__device__ __forceinline__ s16x4 vtr(lds_cptr p) { return __builtin_bit_cast(s16x4, __builtin_amdgcn_ds_read_tr16_b64_v4i16((LAS v4i16_t*)p)); }

struct FlashSt { f32x16 o0, o1; float m, l; };

__device__ __forceinline__ void flash_init(FlashSt& st) { st.o0 = f32x16{}; st.o1 = f32x16{}; st.m = -INFINITY; st.l = 0.f; }

__device__ __forceinline__ void tile_gload(const bf16* __restrict__ Kb, const bf16* __restrict__ Vb, int key0, int tid, u32x4& kr, u32x4& vr) {
    const size_t off = (size_t)(key0 + (tid >> 3)) * 64 + (tid & 7) * 8;
    kr = *(const u32x4*)(Kb + off); vr = *(const u32x4*)(Vb + off);
}
__device__ __forceinline__ void tile_lstore(LAS unsigned char* Kt, LAS unsigned char* Vt, int tid, const u32x4& kr, const u32x4& vr) {
    const int row = tid >> 3, c = tid & 7;
    *(LAS u32x4*)(Kt + c * 1024 + row * 16) = kr;
    *(LAS u32x4*)(Vt + (c >> 2) * 4096 + row * 64 + (c & 3) * 16) = vr;
}

typedef f32x16 CInit;
__device__ __forceinline__ CInit make_cinit(float sl, int hi) { CInit c;
#pragma unroll
    for (int r = 0; r < 16; ++r) c[r] = sl * (float)crow(r, hi);
    return c; }
__device__ __forceinline__ void qk_tile(lds_cptr Kt, const bf16x8 (&qr)[4], const CInit& cinit, f32x16& s0, f32x16& s1, int r32, int hi) {
    const lds_cptr kp = Kt + hi * 1024 + r32 * 16;
    { const bf16x8 k0 = *(const LAS bf16x8*)(kp), k1 = *(const LAS bf16x8*)(kp + 512); s0 = MFMA32(k0, qr[0], cinit); s1 = MFMA32(k1, qr[0], cinit); }
#pragma unroll
    for (int d0 = 1; d0 < 4; ++d0) {
        const bf16x8 k0 = *(const LAS bf16x8*)(kp + d0 * 2048), k1 = *(const LAS bf16x8*)(kp + d0 * 2048 + 512);
        s0 = MFMA32(k0, qr[d0], s0); s1 = MFMA32(k1, qr[d0], s1);
    }
}
__device__ __forceinline__ void pv_tile(lds_cptr Vt, const f32x16& p0, const f32x16& p1, f32x16& o0, f32x16& o1, int lane, int hi) {
    const lds_cptr vp = Vt + ((lane >> 4) & 1) * 32 + (lane & 3) * 8 + (4 * hi + ((lane & 15) >> 2)) * 64;
#pragma unroll
    for (int i = 0; i < 4; ++i) {
        const f32x16& P = (i < 2) ? p0 : p1; const int rb = (i & 1) * 8;
        u32x4 pw; pw.x = cvt_pk(P[rb + 0], P[rb + 1]); pw.y = cvt_pk(P[rb + 2], P[rb + 3]); pw.z = cvt_pk(P[rb + 4], P[rb + 5]); pw.w = cvt_pk(P[rb + 6], P[rb + 7]);
        const bf16x8 pf = __builtin_bit_cast(bf16x8, pw);
        const s16x4 a0 = vtr(vp + i * 1024), a1 = vtr(vp + i * 1024 + 512), b0 = vtr(vp + 4096 + i * 1024), b1 = vtr(vp + 4096 + i * 1024 + 512);
        const bf16x8 v0 = {a0[0], a0[1], a0[2], a0[3], a1[0], a1[1], a1[2], a1[3]}, v1 = {b0[0], b0[1], b0[2], b0[3], b1[0], b1[1], b1[2], b1[3]};
        o0 = MFMA32(v0, pf, o0); o1 = MFMA32(v1, pf, o1);
    }
}
template <bool MASKED, class VF>
__device__ __forceinline__ float flash_probs(lds_cptr Kt, const bf16x8 (&qr)[4], const CInit& cinit, float c32, float off, FlashSt& st, const VF& vf, int lane, f32x16& s0, f32x16& s1) {
    const int r32 = lane & 31, hi = lane >> 5;
    qk_tile(Kt, qr, cinit, s0, s1, r32, hi);
    if (MASKED) {
#pragma unroll
        for (int r = 0; r < 16; ++r) {
            const unsigned m0 = (unsigned)vf(r, 0), m1 = (unsigned)vf(r, 1);
            s0[r] = __uint_as_float((__float_as_uint(s0[r]) & m0) | (0xFF800000u & ~m0)); s1[r] = __uint_as_float((__float_as_uint(s1[r]) & m1) | (0xFF800000u & ~m1)); }
    }
    float m0 = fmaxf(s0[0], s0[1]), m1 = fmaxf(s1[0], s1[1]);
#pragma unroll
    for (int r = 2; r < 16; r += 2) { m0 = fmaxf(fmaxf(m0, s0[r]), s0[r + 1]); m1 = fmaxf(fmaxf(m1, s1[r]), s1[r + 1]); }
    float mx = fmaxf(m0, m1 + c32) + off;
    mx = fmaxf(mx, __shfl_xor(mx, 32));
    const float mnew = fmaxf(st.m, mx), msafe = (mnew == -INFINITY) ? 0.f : mnew;
    const float alpha = __builtin_amdgcn_exp2f(st.m - msafe);
    const float b0 = msafe - off, b1 = b0 - c32;
    { typedef float f32x2 __attribute__((ext_vector_type(2))); const f32x2 nb0 = {-b0, -b0}, nb1 = {-b1, -b1};
#pragma unroll
      for (int r = 0; r < 16; r += 2) { f32x2 a = {s0[r], s0[r + 1]}, c = {s1[r], s1[r + 1]}; a = a + nb0; c = c + nb1;
          s0[r] = __builtin_amdgcn_exp2f(a.x); s0[r + 1] = __builtin_amdgcn_exp2f(a.y); s1[r] = __builtin_amdgcn_exp2f(c.x); s1[r + 1] = __builtin_amdgcn_exp2f(c.y); } }
    float ps;
    { typedef float f32x8 __attribute__((ext_vector_type(8))); typedef float f32x2 __attribute__((ext_vector_type(2)));
      const f32x16 t16 = s0 + s1; const f32x8 t8 = t16.lo + t16.hi; const f32x4 t4 = t8.lo + t8.hi; const f32x2 t2 = t4.lo + t4.hi; ps = t2.x + t2.y; }
    st.l = st.l * alpha + ps; st.m = mnew;
    if (__any(alpha != 1.f)) {
#pragma unroll
        for (int r = 0; r < 16; ++r) { st.o0[r] *= alpha; st.o1[r] *= alpha; }
    }
    return msafe;
}
template <class TI>
__device__ __forceinline__ void flash_loop(const bf16* __restrict__ Kb, const bf16* __restrict__ Vb, int kt_lo, int kt_hi, unsigned long long tmask,
                                           const bf16x8 (&qr)[4], const CInit& cinit, float c32, FlashSt& st, const TI& ti, LAS unsigned char* lds, int tid) {
    const int lane = tid & 63;
    unsigned long long rem = tmask & ((kt_hi >= 63 ? ~0ull : ((1ull << (kt_hi + 1)) - 1ull)) & ~((1ull << kt_lo) - 1ull));
    rem = (unsigned long long)(unsigned)__builtin_amdgcn_readfirstlane((int)(unsigned)rem) | ((unsigned long long)(unsigned)__builtin_amdgcn_readfirstlane((int)(unsigned)(rem >> 32)) << 32);
    int left = __popcll(rem);
    auto pop = [&]() { const int k = (int)__builtin_ctzll(rem); rem &= rem - 1ull; return k; };
    auto compute = [&](int buf, int kt) {
        const lds_cptr Kt = (lds_cptr)(lds + buf * 8192), Vt = (lds_cptr)(lds + 16384 + buf * 8192);
        f32x16 s0, s1; const float off = ti.off(kt);
        if (ti.masked(kt)) { const auto pd = ti.prep(kt); (void)flash_probs<true>(Kt, qr, cinit, c32, off, st, [&](int r, int half) { return ti.valid(pd, r, half); }, lane, s0, s1); }
        else (void)flash_probs<false>(Kt, qr, cinit, c32, off, st, [](int, int) { return -1; }, lane, s0, s1);
        pv_tile(Vt, s0, s1, st.o0, st.o1, lane, lane >> 5);
    };
    if (left == 0) return;
    u32x4 krA, vrA, krB, vrB;
    int k0 = pop(), k1 = k0;
    tile_gload(Kb, Vb, k0 * 64, tid, krA, vrA);
    if (left >= 2) { k1 = pop(); tile_gload(Kb, Vb, k1 * 64, tid, krB, vrB); }
#pragma unroll 1
    while (left >= 4) {
        tile_lstore(lds, lds + 16384, tid, krA, vrA);
        LDS_BARRIER();
        const int k2 = pop(); tile_gload(Kb, Vb, k2 * 64, tid, krA, vrA);
        compute(0, k0);
        tile_lstore(lds + 8192, lds + 16384 + 8192, tid, krB, vrB);
        LDS_BARRIER();
        const int k3 = pop(); tile_gload(Kb, Vb, k3 * 64, tid, krB, vrB);
        compute(1, k1);
        k0 = k2; k1 = k3; left -= 2;
    }
    {
        int k2 = k0;
        tile_lstore(lds, lds + 16384, tid, krA, vrA);
        LDS_BARRIER();
        if (left == 3) { k2 = pop(); tile_gload(Kb, Vb, k2 * 64, tid, krA, vrA); }
        compute(0, k0);
        if (left >= 2) {
            tile_lstore(lds + 8192, lds + 16384 + 8192, tid, krB, vrB);
            LDS_BARRIER();
            compute(1, k1);
        }
        if (left == 3) {
            tile_lstore(lds, lds + 16384, tid, krA, vrA);
            LDS_BARRIER();
            compute(0, k2);
        }
    }
    LDS_BARRIER();
}
__device__ __forceinline__ void flash_finish(const FlashSt& st, float gate, f32x16& t0, f32x16& t1) {
    const float l = st.l + __shfl_xor(st.l, 32);
    const float f = (l > 0.f) ? gate / l : 0.f;
#pragma unroll
    for (int r = 0; r < 16; ++r) { t0[r] += f * st.o0[r]; t1[r] += f * st.o1[r]; }
}
__device__ __forceinline__ void store_o(unsigned char* __restrict__ O, size_t elem_off, const f32x16& t0, const f32x16& t1, int hi, float* __restrict__ rown, float so) {
    const float inv = __builtin_amdgcn_rcpf(so);
    { float ss = 0.f;
#pragma unroll
      for (int r = 0; r < 16; ++r) ss += t0[r] * t0[r] + t1[r] * t1[r];
      ss += __shfl_xor(ss, 32);
      if (hi == 0) unsafeAtomicAdd(rown, ss * 2.26f + 1.3e-4f * so * so); }
#pragma unroll
    for (int q = 0; q < 4; ++q) {
        int w0 = __builtin_amdgcn_cvt_pk_fp8_f32(t0[4 * q] * inv, t0[4 * q + 1] * inv, 0, false); w0 = __builtin_amdgcn_cvt_pk_fp8_f32(t0[4 * q + 2] * inv, t0[4 * q + 3] * inv, w0, true);
        int w1 = __builtin_amdgcn_cvt_pk_fp8_f32(t1[4 * q] * inv, t1[4 * q + 1] * inv, 0, false); w1 = __builtin_amdgcn_cvt_pk_fp8_f32(t1[4 * q + 2] * inv, t1[4 * q + 3] * inv, w1, true);
        *(unsigned*)(O + elem_off + 8 * q + 4 * hi) = (unsigned)w0; *(unsigned*)(O + elem_off + 32 + 8 * q + 4 * hi) = (unsigned)w1;
    }
}

constexpr int L_IMPA = 32768, L_IMPC = 65536, L_IMPF = 98304, L_FAC = 106496, L_SELM = 108544, L_UNION = 108544 + 256, L_IQL = 32768, L_MSK = 65536, L_IWL = 73728;

__device__ __forceinline__ void nsa_unit(const Args& a, LAS unsigned char* lds, int b, int g, int qt) {
    int tid_ = threadIdx.x; asm volatile("" : "+v"(tid_));
    const int tid = tid_, lane = tid & 63, wave = __builtin_amdgcn_readfirstlane(tid >> 6), r32 = lane & 31, hi = lane >> 5;
    unsigned char* ws = a.ws;
    const int rh = wave & 3, th = wave >> 2, head = g * 4 + rh, t0 = qt * 64, tl = th * 32 + r32, token = t0 + tl;
    const size_t row = (size_t)b * SEQ + token;
    bf16x8 qr[4];
#pragma unroll
    for (int d0 = 0; d0 < 4; ++d0) qr[d0] = *(const bf16x8*)((const bf16*)(ws + WS_QA) + row * 512 + head * 64 + 16 * d0 + 8 * hi);
    const float slope2 = __builtin_amdgcn_exp2f(-(float)(head + 1)) * LOG2E;
    const int tokl = tl + 0;
    const float* gn = (const float*)(ws + WS_GN) + row * 24 + head * 3;
    const float g_cmp = gn[0], g_slc = gn[1], g_win = gn[2];
    f32x16 tot0 = {}, tot1 = {};
    const size_t bgoff = ((size_t)(b * 2 + g)) * SEQ * 64;
    LAS float* impa = (LAS float*)(lds + L_IMPA); LAS float* impc = (LAS float*)(lds + L_IMPC); LAS float* impf = (LAS float*)(lds + L_IMPF); LAS float* facl = (LAS float*)(lds + L_FAC);
    LAS unsigned* selm = (LAS unsigned*)(lds + L_SELM); LAS unsigned* uni = (LAS unsigned*)(lds + L_UNION);

    REP(16) {
        tot0 = f32x16{}; tot1 = f32x16{};
        const bf16* Kc = (const bf16*)(ws + WS_KCO) + (size_t)(b * 2 + g) * 128 * 64; const bf16* Vc = (const bf16*)(ws + WS_VCO) + (size_t)(b * 2 + g) * 128 * 64;
        const bool two = (t0 + 63 - 31) / 16 >= 64;
        { u32x4 kr, vr; tile_gload(Kc, Vc, 0, tid, kr, vr); tile_lstore(lds, lds + 16384, tid, kr, vr);
          tile_gload(Kc, Vc, 64, tid, kr, vr); tile_lstore(lds + 8192, lds + 16384 + 8192, tid, kr, vr); }
        if (tid < 64) selm[tid] = 0u; if (tid == 64) *uni = 0u;
        __syncthreads();
        const int nv = (token >= 31) ? (token - 31) / 16 : -1;
        FlashSt st; flash_init(st);
        float ms0 = 0.f;
        const CInit cinitc = make_cinit(16.f * slope2, hi);
#pragma unroll
        for (int tile = 0; tile < 2; ++tile) {
            if (tile == 0 || two) {
                f32x16 s0, s1;
                const int lim = nv - 64 * tile - 4 * hi;
                auto vf = [=](int r, int half) { return ~((lim - ((r & 3) + 8 * (r >> 2) + 32 * half)) >> 31); };
                const float ms = flash_probs<true>((lds_cptr)(lds + tile * 8192), qr, cinitc, 512.f * slope2, 1024.f * slope2 * (float)tile, st, vf, lane, s0, s1);
                if (tile == 0) ms0 = ms;
#pragma unroll
                for (int blk = 0; blk < 2; ++blk) { const f32x16& P = blk ? s1 : s0;
#pragma unroll
                    for (int q = 0; q < 4; ++q) { const int uq = 16 * tile + 8 * blk + 2 * q + hi;
                        impa[(rh * 32 + uq) * 64 + tl] = (P[4 * q] + P[4 * q + 1]) + (P[4 * q + 2] + P[4 * q + 3]); impc[(rh * 32 + uq) * 64 + tl] = P[4 * q + 3]; } }
                pv_tile((lds_cptr)(lds + 16384 + tile * 8192), s0, s1, st.o0, st.o1, lane, hi);
            } else {
#pragma unroll
                for (int k = 0; k < 8; ++k) { const int uq = 16 + 2 * k + hi; impa[(rh * 32 + uq) * 64 + tl] = 0.f; impc[(rh * 32 + uq) * 64 + tl] = 0.f; }
            }
        }
        { const float l = st.l + __shfl_xor(st.l, 32), inv = (l > 0.f) ? 1.f / l : 0.f, mf = (st.m == -INFINITY) ? 0.f : st.m;
          if (hi == 0) { facl[(rh * 2 + 0) * 64 + tl] = __builtin_amdgcn_exp2f(ms0 - mf) * inv; facl[(rh * 2 + 1) * 64 + tl] = inv; } }
        flash_finish(st, g_cmp, tot0, tot1);
        __syncthreads();
        { const int tk = tid & 63, jg = tid >> 6;
#pragma unroll
          for (int jj = 0; jj < 4; ++jj) { const int j = jg * 4 + jj; float v = 0.f;
#pragma unroll
              for (int h4 = 0; h4 < 4; ++h4) { v += impa[(h4 * 32 + j) * 64 + tk] * facl[(h4 * 2 + (j >> 4)) * 64 + tk];
                  if (j > 0) v += impc[(h4 * 32 + j - 1) * 64 + tk] * facl[(h4 * 2 + ((j - 1) >> 4)) * 64 + tk]; }
              const bool forced = (j == 0) || (j == qt) || (j == qt - 1);
              v = forced ? 1e9f : ((j <= qt) ? v : -1e9f);
              impf[j * 64 + tk] = v; } }
        __syncthreads();
        { const int tk = tid & 63, jg = tid >> 6; unsigned bits = 0u;
#pragma unroll
          for (int jj = 0; jj < 4; ++jj) { const int j = jg * 4 + jj; const float v = impf[j * 64 + tk]; int rank = 0;
              for (int j2 = 0; j2 < 32; ++j2) { const float w = impf[j2 * 64 + tk]; rank += (w > v || (w == v && j2 < j)) ? 1 : 0; }
              if (rank < 16) bits |= 1u << j; }
          atomicOr((unsigned*)&selm[tk], bits); atomicOr((unsigned*)uni, bits); }
        __syncthreads();
    }
    const unsigned mysel = selm[tl]; const unsigned long long um = (unsigned long long)(*uni);
    LAS float* stash = (LAS float*)(lds + L_IMPA) + tid;
#pragma unroll
    for (int r = 0; r < 16; ++r) { stash[r * 512] = tot0[r]; stash[(16 + r) * 512] = tot1[r]; }
    const CInit cinit = make_cinit(slope2, hi);

    REP(17) {
        FlashSt st; flash_init(st);
        struct TI { int qt, lim; unsigned mysel; float sl64;
            __device__ __forceinline__ bool masked(int kt) const { return kt == qt; }
            __device__ __forceinline__ float off(int kt) const { return ((mysel >> kt) & 1u) ? sl64 * (float)kt : -INFINITY; }
            __device__ __forceinline__ int prep(int kt) const { return kt; }
            __device__ __forceinline__ int valid(int, int r, int half) const { return ~((lim - ((r & 3) + 8 * (r >> 2) + 32 * half)) >> 31); } };
        const TI ti{qt, tokl - 4 * hi, mysel, 64.f * slope2};
        flash_loop((const bf16*)(ws + WS_KS) + bgoff, (const bf16*)(ws + WS_VS) + bgoff, 0, qt, um, qr, cinit, 32.f * slope2, st, ti, lds, tid);
        f32x16 a0 = {}, a1 = {}; flash_finish(st, g_slc, a0, a1);
        if (rp_ == 0) {
#pragma unroll
        for (int r = 0; r < 16; ++r) { stash[r * 512] += a0[r]; stash[(16 + r) * 512] += a1[r]; } }
    }
    REP(18) {
        FlashSt st; flash_init(st);
        struct TI { int qt, lim; float sl64;
            __device__ __forceinline__ bool masked(int kt) const { return kt == qt || kt == qt - 8; }
            __device__ __forceinline__ float off(int kt) const { return sl64 * (float)kt; }
            __device__ __forceinline__ int prep(int kt) const { return kt; }
            __device__ __forceinline__ int valid(int kt, int r, int half) const { const int gt = (lim - ((r & 3) + 8 * (r >> 2) + 32 * half)) >> 31; return (kt == qt) ? ~gt : gt; } };
        const TI ti{qt, tokl - 4 * hi, 64.f * slope2};
        flash_loop((const bf16*)(ws + WS_KW) + bgoff, (const bf16*)(ws + WS_VW) + bgoff, (qt >= 8) ? qt - 8 : 0, qt, ~0ull, qr, cinit, 32.f * slope2, st, ti, lds, tid);
        f32x16 a0 = {}, a1 = {}; flash_finish(st, g_win, a0, a1);
#pragma unroll
        for (int r = 0; r < 16; ++r) { a0[r] += stash[r * 512]; a1[r] += stash[(16 + r) * 512]; }
        store_o(ws + WS_OA, row * 512 + head * 64, a0, a1, hi, (float*)(ws + WS_ROWNA) + row, so_scale_a((const float*)(ws + WS_VMAX)));
    }
}

__device__ __forceinline__ unsigned ordkey(float f) { f = f + 0.f; const unsigned u = __float_as_uint(f); return u ^ ((unsigned)((int)u >> 31) | 0x80000000u); }

__device__ __forceinline__ int wave_sum_i32(int x) {
    x += __builtin_amdgcn_update_dpp(0, x, 0x111, 0xf, 0xf, true);
    x += __builtin_amdgcn_update_dpp(0, x, 0x112, 0xf, 0xf, true);
    x += __builtin_amdgcn_update_dpp(0, x, 0x114, 0xf, 0xf, true);
    x += __builtin_amdgcn_update_dpp(0, x, 0x118, 0xf, 0xf, true);
    x += __builtin_amdgcn_update_dpp(0, x, 0x142, 0xa, 0xf, false);
    x += __builtin_amdgcn_update_dpp(0, x, 0x143, 0xc, 0xf, false);
    return __builtin_amdgcn_readlane(x, 63);
}
__device__ __forceinline__ unsigned wave_max_u32(unsigned x) {
    unsigned y;
    y = (unsigned)__builtin_amdgcn_update_dpp(0, (int)x, 0x111, 0xf, 0xf, true); x = x > y ? x : y;
    y = (unsigned)__builtin_amdgcn_update_dpp(0, (int)x, 0x112, 0xf, 0xf, true); x = x > y ? x : y;
    y = (unsigned)__builtin_amdgcn_update_dpp(0, (int)x, 0x114, 0xf, 0xf, true); x = x > y ? x : y;
    y = (unsigned)__builtin_amdgcn_update_dpp(0, (int)x, 0x118, 0xf, 0xf, true); x = x > y ? x : y;
    y = (unsigned)__builtin_amdgcn_update_dpp(0, (int)x, 0x142, 0xa, 0xf, false); x = x > y ? x : y;
    y = (unsigned)__builtin_amdgcn_update_dpp(0, (int)x, 0x143, 0xc, 0xf, false); x = x > y ? x : y;
    return (unsigned)__builtin_amdgcn_readlane((int)x, 63);
}
template <int NI>
__device__ __forceinline__ void dsa_select(const float* __restrict__ scr, LAS unsigned long long* msk, int wave, int lane, int t0, int nkt) {
    unsigned u[NI], un[NI];
    auto loadrow = [&](int tk, unsigned (&dst)[NI]) {
#pragma unroll
        for (int i = 0; i < NI; ++i) { const int ii = (i < nkt) ? i : 0; const float f = scr[(size_t)tk * 2048 + ii * 64 + lane]; dst[i] = (i < nkt) ? ordkey(f) : 0u; } };
    loadrow(wave * 4, un);
#pragma unroll 1
    for (int tq = 0; tq < 4; ++tq) {
        const int tk = wave * 4 + tq, tpos = t0 + tk;
#pragma unroll
        for (int i = 0; i < NI; ++i) u[i] = un[i];
        if (tq < 3) loadrow(tk + 1, un);
        if (tpos + 1 <= 256) {
#pragma unroll
            for (int i = 0; i < NI; ++i) { const unsigned long long m = __ballot(i * 64 + lane <= tpos); if (lane == 0) msk[tk * 32 + i] = m; }
        } else {
            int h[NI];
#pragma unroll
            for (int i = 0; i < NI; ++i) h[i] = (int)(u[i] >> 1);
            auto count_ge = [&](int c) { int lt = 0;
#pragma unroll
                for (int i = 0; i < NI; i += 4) { int d0 = h[i] - c, d1 = h[i + 1] - c, d2 = h[i + 2] - c, d3 = h[i + 3] - c;
                    asm volatile("" : "+v"(d0), "+v"(d1), "+v"(d2), "+v"(d3));
                    lt += ((int)((unsigned)d0 >> 31) + (int)((unsigned)d1 >> 31)) + ((int)((unsigned)d2 >> 31) + (int)((unsigned)d3 >> 31)); }
                return NI * 64 - wave_sum_i32(lt); };
            int T31 = 0, bit0 = 30; bool exact = false;
            { int mx = 0;
#pragma unroll
              for (int i = 0; i < NI; ++i) mx = (h[i] > mx) ? h[i] : mx;
              mx = (int)wave_max_u32((unsigned)mx);
              int P = mx >> 22;
#pragma unroll 1
              for (int tr = 0; tr < 4 && P > 0; ++tr, --P) {
                  const int cand = P << 22; const int cnt = count_ge(cand);
                  if (cnt >= 256) { T31 = cand; bit0 = 21; exact = (cnt == 256); break; }
              } }
            if (!exact) {
#pragma unroll 1
                for (int bit = bit0; bit >= 0; --bit) {
                    const int cand = T31 | (1 << bit); const int cnt = count_ge(cand);
                    if (cnt >= 256) { T31 = cand; if (cnt == 256) { exact = true; break; } }
                }
            }
            unsigned T = (unsigned)T31 << 1; int cge = 256;
            if (!exact) { const unsigned Thi = T | 1u; int lc = 0;
#pragma unroll
                for (int i = 0; i < NI; ++i) lc += (u[i] >= Thi) ? 1 : 0;
                const int chi = wave_sum_i32(lc);
                if (chi >= 256) { T = Thi; cge = chi; } else cge = count_ge(T31); }
            if (cge == 256) {
                int mlo = 0, mhi = 0;
#pragma unroll
                for (int i = 0; i < NI; ++i) { const unsigned long long bm = __ballot(u[i] >= T);
                    const bool me = (lane == i); mlo = me ? (int)(unsigned)bm : mlo; mhi = me ? (int)(unsigned)(bm >> 32) : mhi; }
                if (lane < NI) msk[tk * 32 + lane] = ((unsigned long long)(unsigned)mhi << 32) | (unsigned long long)(unsigned)mlo;
                continue;
            }
            int cgt = 0;
#pragma unroll
            for (int i = 0; i < NI; ++i) cgt += __popcll(__ballot(u[i] > T));
            const int need = 256 - cgt;
            int run = 0; const unsigned long long lt = (1ull << lane) - 1ull;
#pragma unroll
            for (int i = 0; i < NI; ++i) {
                const bool eq = (u[i] == T); const unsigned long long eqm = __ballot(eq);
                const int myrank = run + __popcll(eqm & lt); const bool sel = (u[i] > T) || (eq && myrank < need);
                run += __popcll(eqm); const unsigned long long m = __ballot(sel); if (lane == 0) msk[tk * 32 + i] = m; }
        }
    }
}

__device__ __forceinline__ void dsa_unit(const Args& a, LAS unsigned char* lds, int b, int qt) {
    int tid_ = threadIdx.x; asm volatile("" : "+v"(tid_));
    __syncthreads();
    const int tid = tid_, lane = tid & 63, wave = __builtin_amdgcn_readfirstlane(tid >> 6), r32 = lane & 31, hi = lane >> 5;
    unsigned char* ws = a.ws;
    const int t0 = qt * 32, token = t0 + r32, nkt = (t0 + 31) / 64 + 1;
    const size_t row = (size_t)b * SEQ + token;
    float* scr = (float*)(ws + WS_SCR) + (size_t)blockIdx.x * 32 * 2048;
    LAS unsigned char* iql = lds + L_IQL; LAS unsigned long long* msk = (LAS unsigned long long*)(lds + L_MSK);
    REP(13) {
        const bf16* IQ = (const bf16*)(ws + WS_IQ);
#pragma unroll
        for (int c4 = 0; c4 < 4; ++c4) { const int id = tid + 512 * c4, tok = id >> 6, c = id & 63, h = c >> 3, d0 = (c >> 1) & 3, hh = c & 1;
            const u32x4 v = *(const u32x4*)(IQ + ((size_t)b * SEQ + t0 + tok) * 512 + c * 8);
            *(LAS u32x4*)(iql + (((h * 4 + d0) * 2 + hh) * 32 + tok) * 16) = v; }
        if (tid < 256) { const int tok = tid >> 3, h = tid & 7; ((LAS float*)(lds + L_IWL))[h * 32 + tok] = ((const float*)(ws + WS_IW))[((size_t)b * SEQ + t0 + tok) * 8 + h]; }
        __syncthreads();
        const bf16* IK = (const bf16*)(ws + WS_IK) + (size_t)b * SEQ * 64;
        bf16x8 kf[8], kn[8];
        auto kload = [&](int kt, bf16x8 (&d)[8]) {
#pragma unroll
            for (int d0 = 0; d0 < 4; ++d0) { d[2 * d0] = *(const bf16x8*)(IK + (size_t)(kt * 64 + r32) * 64 + 16 * d0 + 8 * hi); d[2 * d0 + 1] = *(const bf16x8*)(IK + (size_t)(kt * 64 + 32 + r32) * 64 + 16 * d0 + 8 * hi); } };
        if (wave < nkt) kload(wave, kn);
#pragma unroll 1
        for (int kt = wave; kt < nkt; kt += NWAVES) {
#pragma unroll
            for (int i = 0; i < 8; ++i) kf[i] = kn[i];
            if (kt + NWAVES < nkt) kload(kt + NWAVES, kn);
            f32x16 acc0 = {}, acc1 = {};
#pragma unroll 1
            for (int h = 0; h < 8; ++h) {
                const float wh = ((const LAS float*)(lds + L_IWL))[h * 32 + r32];
                f32x16 s0 = {}, s1 = {};
#pragma unroll
                for (int d0 = 0; d0 < 4; ++d0) { const bf16x8 q = *(const LAS bf16x8*)(iql + (((h * 4 + d0) * 2 + hi) * 32 + r32) * 16);
                    s0 = MFMA32(kf[2 * d0], q, s0); s1 = MFMA32(kf[2 * d0 + 1], q, s1); }
#pragma unroll
                for (int r = 0; r < 16; ++r) {
                    const int i0 = __float_as_int(s0[r]), i1 = __float_as_int(s1[r]);
                    acc0[r] += wh * __int_as_float(i0 > 0 ? i0 : 0); acc1[r] += wh * __int_as_float(i1 > 0 ? i1 : 0); }
            }
#pragma unroll
            for (int q = 0; q < 4; ++q) { const int k0 = kt * 64 + 8 * q + 4 * hi; f32x4 v0, v1;
#pragma unroll
                for (int e = 0; e < 4; ++e) { v0[e] = (k0 + e <= token) ? acc0[4 * q + e] : -INFINITY; v1[e] = (k0 + 32 + e <= token) ? acc1[4 * q + e] : -INFINITY; }
                *(f32x4*)(scr + (size_t)r32 * 2048 + k0) = v0; *(f32x4*)(scr + (size_t)r32 * 2048 + k0 + 32) = v1; }
        }
        __syncthreads();
    }
    REP(14) {
        if (nkt <= 8) dsa_select<8>(scr, msk, wave, lane, t0, nkt);
        else if (nkt <= 12) dsa_select<12>(scr, msk, wave, lane, t0, nkt);
        else if (nkt <= 16) dsa_select<16>(scr, msk, wave, lane, t0, nkt);
        else if (nkt <= 20) dsa_select<20>(scr, msk, wave, lane, t0, nkt);
        else if (nkt <= 24) dsa_select<24>(scr, msk, wave, lane, t0, nkt);
        else if (nkt <= 28) dsa_select<28>(scr, msk, wave, lane, t0, nkt);
        else dsa_select<32>(scr, msk, wave, lane, t0, nkt);
    }
    __syncthreads();
    REP(15) {
        const int head = wave;
        bf16x8 qr[4];
#pragma unroll
        for (int d0 = 0; d0 < 4; ++d0) qr[d0] = *(const bf16x8*)((const bf16*)(ws + WS_QB) + row * 512 + head * 64 + 16 * d0 + 8 * hi);
        const float slope2 = __builtin_amdgcn_exp2f(-(float)(head + 1)) * LOG2E;
        const CInit cinit = make_cinit(slope2, hi);
        FlashSt st; flash_init(st);
        struct TI { const LAS unsigned long long* mrow; int sh; float sl64;
            __device__ __forceinline__ bool masked(int) const { return true; }
            __device__ __forceinline__ float off(int kt) const { return sl64 * (float)kt; }
            __device__ __forceinline__ u32x2 prep(int kt) const { const unsigned long long mm = mrow[kt] >> sh; u32x2 w; w.x = (unsigned)mm; w.y = (unsigned)(mm >> 32); return w; }
            __device__ __forceinline__ int valid(const u32x2& w, int r, int half) const { return __builtin_amdgcn_sbfe((int)(half ? w.y : w.x), (r & 3) + 8 * (r >> 2), 1); } };
        const TI ti{msk + r32 * 32, 4 * hi, 64.f * slope2};
        flash_loop((const bf16*)(ws + WS_KB) + (size_t)b * SEQ * 64, (const bf16*)(ws + WS_VB) + (size_t)b * SEQ * 64, 0, nkt - 1, ~0ull, qr, cinit, 32.f * slope2, st, ti, lds, tid);
        f32x16 t0v = {}, t1v = {};
        flash_finish(st, 1.f, t0v, t1v);
        store_o(ws + WS_OB8, row * 512 + head * 64, t0v, t1v, hi, (float*)(ws + WS_ROWNB) + row, so_scale_b((const float*)(ws + WS_VMAX)));
    }
    __syncthreads();
}

__device__ __forceinline__ void attn_phase(const Args& a, LAS unsigned char* lds) {
    const int c = blockIdx.x, G = gridDim.x;
    REP(11) for (int i = c; i < 2048; i += G) { const int k = i / 256, cc = i % 256, j = cc / 64, bg = cc % 64, jj = (k & 1) ? 3 - j : j, qt = 31 - (4 * k + jj);
        nsa_unit(a, lds, bg >> 1, bg & 1, qt); }
    REP(12) for (int i = c; i < 2048; i += G) { const int k = i / 256, cc = i % 256, j = cc / 32, b = cc % 32, jj = (k & 1) ? 7 - j : j, qt = 63 - (8 * k + jj);
        dsa_unit(a, lds, b, qt); }
}

#define RLX_AGENT __ATOMIC_RELAXED, __HIP_MEMORY_SCOPE_AGENT
#define XB_TMO      128
#define XB_XCNT(j)  (256  + 64 * (j))
#define XB_XSUB(j)  (1280 + 64 * (j))
#define XB_XGEN(j)  (2304 + 64 * (j))
#define XB_TOP      3328
#define XB_TOPGEN   3392
#define XCD_BAR_WORDS 3456
#define XB_SPIN_CAP (1u << 18)

__device__ __forceinline__ unsigned xb_ld(unsigned* p)              { return __hip_atomic_load(p, __ATOMIC_RELAXED, __HIP_MEMORY_SCOPE_AGENT); }
__device__ __forceinline__ unsigned xb_add(unsigned* p, unsigned v) { return __hip_atomic_fetch_add(p, v, __ATOMIC_RELAXED, __HIP_MEMORY_SCOPE_AGENT); }
__device__ __forceinline__ unsigned xb_xcc_id() { return (unsigned)__builtin_amdgcn_s_getreg((3 << 11) | 20) & 0xFu; }
#define XB_SPIN(cond, bar) do { unsigned _sp = 0; while (cond) { __builtin_amdgcn_s_sleep(1); \
    if ((++_sp & 255u) == 0u) { if (xb_ld(&(bar)[XB_TMO])) break; if (_sp > XB_SPIN_CAP) { atomicAdd(&(bar)[XB_TMO], 1u); break; } } } } while (0)

struct XcdBarrier {
    unsigned* bar; unsigned x;
    volatile LAS unsigned* st;
};

__device__ __forceinline__ XcdBarrier xcd_barrier_post(unsigned* bar, volatile LAS unsigned* st) {
    XcdBarrier b; b.bar = bar; b.x = xb_xcc_id(); b.st = st;
    if (threadIdx.x == 0) (void)xb_add(&bar[XB_XCNT(b.x)], 1u);
    return b;
}
__device__ __forceinline__ void xcd_barrier_complete(unsigned* bar, unsigned x, unsigned& nloc, unsigned& nx) {
    const unsigned G = gridDim.x * gridDim.y * gridDim.z;
    unsigned sum, cnt, mine, sp = 0u;
    for (;;) {
        sum = 0u; cnt = 0u; mine = 0u;
#pragma unroll
        for (unsigned j = 0; j < 16; ++j) { const unsigned c = xb_ld(&bar[XB_XCNT(j)]); sum += c; cnt += (c > 0u) ? 1u : 0u; mine = (j == x) ? c : mine; }
        if (sum == G) break;
        __builtin_amdgcn_s_sleep(1);
        if ((++sp & 255u) == 0u) { if (xb_ld(&bar[XB_TMO])) break; if (sp > XB_SPIN_CAP) { atomicAdd(&bar[XB_TMO], 1u); break; } }
    }
    nloc = mine > 0u ? mine : 1u; nx = cnt > 0u ? cnt : 1u;
}

__device__ __forceinline__ void xcd_barrier(const XcdBarrier& b) {
    asm volatile("s_waitcnt vmcnt(0)" ::: "memory");
    __syncthreads();
    if (threadIdx.x == 0) {
        unsigned* bar = b.bar;
        __builtin_amdgcn_s_waitcnt(0);
        unsigned nloc = b.st[0], nx = b.st[1];
        if (nloc == 0u) { xcd_barrier_complete(bar, b.x, nloc, nx); b.st[0] = nloc; b.st[1] = nx; }
        const unsigned old = xb_add(&bar[XB_XSUB(b.x)], 1u);
        const unsigned gen = old / nloc;
        if (old + 1u == (gen + 1u) * nloc) {
            __builtin_amdgcn_fence(__ATOMIC_RELEASE, "agent");
            asm volatile("s_waitcnt vmcnt(0)" ::: "memory");
            const unsigned og = xb_add(&bar[XB_TOP], 1u);
            const unsigned tg = og / nx;
            if (og + 1u == (tg + 1u) * nx) xb_add(&bar[XB_TOPGEN], 1u);
            else XB_SPIN(xb_ld(&bar[XB_TOPGEN]) == tg, bar);
            __builtin_amdgcn_fence(__ATOMIC_ACQUIRE, "agent");
            xb_add(&bar[XB_XGEN(b.x)], 1u);
            asm volatile("s_waitcnt vmcnt(0)" ::: "memory");
        } else {
            XB_SPIN(xb_ld(&bar[XB_XGEN(b.x)]) == gen, bar);
            __builtin_amdgcn_fence(__ATOMIC_ACQUIRE, "agent");
            asm volatile("s_waitcnt vmcnt(0)" ::: "memory");
        }
    }
    __syncthreads();
}

#ifndef WGM_P2A
#define WGM_P2A 4
#endif
#ifndef WGM_P2B
#define WGM_P2B 4
#endif
#ifndef WGM_P9
#define WGM_P9 4
#endif
#ifndef RUNG
#define RUNG 99
#endif
__global__ void __launch_bounds__(NTHREADS, 2) hybrid_fwd(Args a) {
    extern __shared__ __attribute__((aligned(16))) unsigned char lds_raw[];
    LAS unsigned char* lds = (LAS unsigned char*)lds_raw;
    cg::grid_group grid = cg::this_grid();
    unsigned char* ws = a.ws;
    volatile LAS unsigned* bst = (volatile LAS unsigned*)(lds + LDS_BYTES - 64);
    if (threadIdx.x < 2) bst[threadIdx.x] = 0u;
    __syncthreads();
    XcdBarrier xbar; xbar.bar = (unsigned*)ws; xbar.x = 0u; xbar.st = bst;
    const float* mod = (const float*)(ws + WS_MOD);
    const int lo = a.ph_lo, hi = a.ph_hi;
#define IN(k) (lo <= (k) && (k) < hi)
#define SEAM(k) do { if (IN(k) && IN((k) + 1)) { if ((k) == 0) grid.sync(); else xcd_barrier(xbar); } } while (0)

    if (IN(0)) REP(0) { phase0(a, lds); }
    SEAM(0);
    if (IN(0) && IN(1)) xbar = xcd_barrier_post((unsigned*)ws, bst);
    if (IN(1)) REP(1) { if (blockIdx.x == 0 && threadIdx.x < 64) wnmax_item(ws); wgu_quant_items(a, lds); wing_quant_items(a, lds); wd_quant_items(a, lds); wout_quant_items(a, lds); woab_quant_items(a, lds); norm_dual_phase(a.in[I_X], a.in[I_GN1], mod, 0, DM, (bf16*)(ws + WS_H), (signed char*)(ws + WS_HQ), (float*)(ws + WS_SA1)); }
    SEAM(1);
#if RUNG >= 2
    if (IN(2)) {
        if constexpr (NBFT > 0) { pg8::Gemm g{(const bf16*)(ws + WS_H), (const bf16*)(ws + WS_WIN), MROWS, NBFROWS, DM}; pg8::StaticOrder S; S.init(MROWS, NBFROWS, gridDim.x, blockIdx.x, WGM_P2A);
          EpiProj<false> E{ws, a.in[I_GQA], a.in[I_GKS], a.in[I_GKW], a.in[I_GQB], a.in[I_GKB]};
          pg8::gemm_phase<EpiProj<false>, pg8::StaticOrder, true, true>(lds, g, S, E); }
        { pg8::Gemm g{(const bf16*)(ws + WS_HQ), (const bf16*)(ws + WS_WINGQ), MROWS, NI8ROWS, DM / 2}; pg8::StaticOrder S; S.init(MROWS, NI8ROWS, gridDim.x, blockIdx.x, WGM_P2B);
          EpiProj<true> E{ws, a.in[I_GQA], a.in[I_GKS], a.in[I_GKW], a.in[I_GQB], a.in[I_GKB]};
          pg8::gemm_phase<EpiProj<true>, pg8::StaticOrder, true, true, true>(lds, g, S, E); }
    }
    SEAM(2);
    if (IN(3)) REP(3) { compress_phase(a, lds); }
    SEAM(3);
    if (IN(4)) { attn_phase(a, lds); }
    SEAM(4);
    if (IN(5)) {
        pg8::Gemm g{(const bf16*)(ws + WS_OA), (const bf16*)(ws + WS_WOA), 2 * MROWS, 2 * DM, 256}; PairOrder S; S.init(gridDim.x, blockIdx.x);
        EpiYPair E{ws + WS_GA, ws + WS_GB, (bf16*)(ws + WS_Y), ws + WS_Y8, (const float*)(ws + WS_ROWNA), (const float*)(ws + WS_ROWNB), (const float*)(ws + WS_WNMAX),
                   (const float*)(ws + WS_VMAX), (const float*)(ws + WS_SBWO)};
        pg8::gemm_phase<EpiYPair, PairOrder, true, true, false, true>(lds, g, S, E);
    }
    SEAM(6);
    if (IN(7)) {
        pg8::Gemm g{(const bf16*)(ws + WS_Y8), (const bf16*)(ws + WS_WOUT), MROWS, DM, DM / 2}; pg8::StaticOrder S; S.init(MROWS, DM, gridDim.x, blockIdx.x);
        EpiX1 E{a.in[I_X], (bf16*)(ws + WS_X1B), (float*)(ws + WS_ROWSS), mod, (const float*)(ws + WS_ROWNA), (const float*)(ws + WS_ROWNB), (const float*)(ws + WS_WNMAX), (const float*)(ws + WS_SBO)};
        pg8::gemm_phase<EpiX1, pg8::StaticOrder, true, true, false, true>(lds, g, S, E);
    }
    SEAM(7);
#endif
    if (IN(8)) { norm2_quant_phase((const bf16*)(ws + WS_X1B), (const float*)(ws + WS_ROWSS), a.in[I_GN2], mod, (signed char*)(ws + WS_H2), (float*)(ws + WS_SA2), (float*)(ws + WS_SACT), (const float*)(ws + WS_WNMAX)); }
    SEAM(8);
    if (IN(9)) {
        pg8::Gemm g{(const bf16*)(ws + WS_H2), (const bf16*)(ws + WS_WGU), MROWS, 2 * DFF, DM / 2}; pg8::StaticOrder S; S.init(MROWS, 2 * DFF, gridDim.x, blockIdx.x, WGM_P9);
        EpiAct3 E{ws + WS_ACT, (const float*)(ws + WS_SA2), (const float*)(ws + WS_SBWGU), (const float*)(ws + WS_SACT)};
        pg8::gemm_phase<EpiAct3, pg8::StaticOrder, true, true, true>(lds, g, S, E);
    }
    SEAM(9);
    if (IN(10)) {
        pg8::Gemm g{(const bf16*)(ws + WS_ACT), (const bf16*)(ws + WS_WD), MROWS, DM, DFF / 2}; pg8::StaticOrder S; S.init(MROWS, DM, gridDim.x, blockIdx.x);
        EpiOut E{(const bf16*)(ws + WS_X1B), a.out, mod, (const float*)(ws + WS_SACT), (const float*)(ws + WS_SBD)};
        pg8::gemm_phase<EpiOut, pg8::StaticOrder, true, true, false, true>(lds, g, S, E);
    }
#undef IN
#undef SEAM
}

#ifndef N_LAUNCH_MODE
#define N_LAUNCH_MODE 1
#endif
extern "C" void kernel_launch(void* const* d_in, const int* in_sizes, int n_in, void* d_out, int out_size, void* d_ws, size_t ws_size, hipStream_t stream) {
    static int grid = 0;
    if (grid == 0) {
        if (n_in != 25 || out_size != MROWS * DM || ws_size < WS_END) { fprintf(stderr, "kernel_launch: unexpected problem (n_in %d, out %d, ws %zu)\n", n_in, out_size, ws_size); grid = -1; return; }
        int dev = 0, cus = 0, per_cu = 0;
        hipGetDevice(&dev); hipDeviceGetAttribute(&cus, hipDeviceAttributeMultiprocessorCount, dev);
        if (hipFuncSetAttribute((const void*)hybrid_fwd, hipFuncAttributeMaxDynamicSharedMemorySize, LDS_BYTES) != hipSuccess) { fprintf(stderr, "kernel_launch: hipFuncSetAttribute failed\n"); grid = -1; return; }
        if (hipOccupancyMaxActiveBlocksPerMultiprocessor(&per_cu, (const void*)hybrid_fwd, NTHREADS, LDS_BYTES) != hipSuccess || per_cu < 1) { fprintf(stderr, "kernel_launch: occupancy query says %d\n", per_cu); per_cu = 1; }
        (void)hipGetLastError();
        grid = cus * (per_cu > 1 ? 1 : per_cu);
        if (grid > MAXGRID) grid = MAXGRID;
        if (grid < 1) grid = 1;
    }
    if (grid < 0) return;
    Args a{};
    for (int i = 0; i < 25; ++i) a.in[i] = (const float*)d_in[i];
    a.out = (float*)d_out; a.ws = (unsigned char*)d_ws;
#if N_LAUNCH_MODE == 1
    a.ph_lo = 0; a.ph_hi = 11;
    void* args[] = {&a};
    hipError_t e = hipLaunchCooperativeKernel((const void*)hybrid_fwd, dim3(grid), dim3(NTHREADS), args, LDS_BYTES, stream);
    if (e != hipSuccess) fprintf(stderr, "kernel_launch: cooperative launch failed: %s (grid %d)\n", hipGetErrorString(e), grid);
#else
    for (int p = 0; p < 11; ++p) { a.ph_lo = p; a.ph_hi = p + 1; hipLaunchKernelGGL(hybrid_fwd, dim3(grid), dim3(NTHREADS), LDS_BYTES, stream, a); }
#endif
}
```

```cpp
#include <hip/hip_runtime.h>
#include <hip/hip_cooperative_groups.h>
#include <cstdio>
#include <cstdint>
namespace cg = cooperative_groups;
#define RUNG 99
#define N_LAUNCH_MODE 1
#define REPMASK 0
#define REP(k) for (int rp_ = 0; rp_ < (((REPMASK) >> (k)) & 1) + 1; ++rp_)
namespace pg8 {
#define PG8_LAS __attribute__((address_space(3)))
typedef unsigned short bf16_t;
typedef short bf16x8 __attribute__((ext_vector_type(8)));
typedef float f32x4 __attribute__((ext_vector_type(4)));
typedef unsigned u32x4 __attribute__((ext_vector_type(4)));
typedef int i32x4 __attribute__((ext_vector_type(4)));
typedef int i32x8 __attribute__((ext_vector_type(8)));
constexpr int BM = 256, BK = 64, HALF = 128, HTB = HALF * BK * 2  , STAGE_BYTES = 8 * HTB, NXCD = 8, WGM = 4;

__host__ __device__ __forceinline__ int lds_byte(int r, int c) { const int st = (r >> 4) * 2 + (c >> 5), rr = r & 15, cc = c & 31, ob = rr * 64 + cc * 2; return st * 1024 + (ob ^ (((ob >> 9) & 1) << 5)); }
__host__ __device__ __forceinline__ void stage_rc(int b, int& R, int& C) { const int st = b / 1024, sb = b % 1024, swz = sb ^ (((sb >> 9) & 1) << 5); R = (st >> 1) * 16 + swz / 64; C = (st & 1) * 32 + (swz % 64) / 2; }
__host__ __device__ __forceinline__ int perm32(int rho) { const int n = rho >> 4, i = rho & 15; return 8 * (i >> 2) + 4 * n + (i & 3); }

struct Unit { int pm, pn; };
struct Gemm { const bf16_t* A; const bf16_t* Bt; int M, N, K; };

struct StaticOrder {
    int nM, nN, nwg, G, c, wgm;
    __host__ __device__ void init(int M, int N, int G_, int c_, int wgm_ = WGM) { nM = M / BM; nN = N / BM; nwg = nM * nN; G = G_; c = c_; wgm = wgm_; }
    __host__ __device__ bool next(int i, Unit& u) const {
        const long L = (long)i * G + c; if (L >= nwg) return false;
        int wgid = (int)L; { const int q = nwg / NXCD, r = nwg % NXCD, xcd = wgid % NXCD, off = wgid / NXCD; wgid = (xcd < r ? xcd * (q + 1) : r * (q + 1) + (xcd - r) * q) + off; }
        const int nig = wgm * nN, gid = wgid / nig, fm = gid * wgm, gsz = (nM - fm) < wgm ? (nM - fm) : wgm;
        u.pm = fm + ((wgid % nig) % gsz); u.pn = (wgid % nig) / gsz; return true;
    }
    __device__ __forceinline__ void a_ready(const Unit&) const {}
    __device__ __forceinline__ void done(const Unit&) const {}
};

template <class Epi, class Sched, bool ALIGN_EPI = false, bool SP2 = false, bool I8 = false, bool F8 = false>
__device__ __forceinline__ void gemm_phase(PG8_LAS unsigned char* lds, const Gemm g, const Sched& S, const Epi& E) {
    const int tid = threadIdx.x, wid = __builtin_amdgcn_readfirstlane(tid >> 6), lane = tid & 63, wr = wid >> 2, wc = wid & 3, fr = lane & 15, fq = lane >> 4;
    const int K = g.K, nt = K / BK;
    unsigned voffA[2], voffB[2];
#pragma unroll
    for (int i = 0; i < 2; ++i) { int R, C; stage_rc(tid * 16 + i * 8192, R, C); const int Rb = Epi::PERM ? ((R & ~31) + perm32(R & 31)) : R;
        voffA[i] = (unsigned)(R * K + C) * 2u; voffB[i] = (unsigned)(Rb * K + C) * 2u; }
    const size_t kstep = (size_t)(BK * 2);
    const size_t hstep = (size_t)HALF * K * 2;
    const size_t tstep = 2 * hstep;
    const unsigned ldsw = (unsigned)wid * 1024u;
    const int aoff = lds_byte(wr * 64 + fr, fq * 8), boff = lds_byte(wc * 32 + fr, fq * 8);
#define PG8_SA(b, h) (((b) * 2 + (h)) * HTB)
#define PG8_SB(b, h) ((4 + (b) * 2 + (h)) * HTB)
#define PG8_STAGE(bufoff, gbase, voff) do { _Pragma("unroll") for (int _i = 0; _i < 2; ++_i) \
        __builtin_amdgcn_global_load_lds((const unsigned*)((const char*)(gbase) + (voff)[_i]), (PG8_LAS unsigned*)(lds + (bufoff) + ldsw + _i * 8192), 16, 0, 0); } while (0)
#define PG8_LD8(p) PG8_CAT8(*(const PG8_LAS bf16x8*)(p), *(const PG8_LAS bf16x8*)((p) + 1024))
#define PG8_LDA8(dst, b, h) do { _Pragma("unroll") for (int m = 0; m < 4; ++m) dst##8[m] = PG8_LD8(lds + PG8_SA(b, h) + aoff + m * 2048); } while (0)
#define PG8_LDB8(dst, b, h) do { _Pragma("unroll") for (int n = 0; n < 2; ++n) dst##8[n] = PG8_LD8(lds + PG8_SB(b, h) + boff + n * 2048); } while (0)
#define PG8_LDA_(dst, b, h) do { _Pragma("unroll") for (int m = 0; m < 4; ++m) _Pragma("unroll") for (int k = 0; k < 2; ++k) dst[m][k] = *(const PG8_LAS bf16x8*)(lds + PG8_SA(b, h) + aoff + m * 2048 + k * 1024); } while (0)
#define PG8_LDB_(dst, b, h) do { _Pragma("unroll") for (int n = 0; n < 2; ++n) _Pragma("unroll") for (int k = 0; k < 2; ++k) dst[n][k] = *(const PG8_LAS bf16x8*)(lds + PG8_SB(b, h) + boff + n * 2048 + k * 1024); } while (0)
#define PG8_LDA(dst, b, h) do { if constexpr (F8) PG8_LDA8(dst, b, h); else PG8_LDA_(dst, b, h); } while (0)
#define PG8_LDB(dst, b, h) do { if constexpr (F8) PG8_LDB8(dst, b, h); else PG8_LDB_(dst, b, h); } while (0)
#define PG8_MMA(ai, bj, At, Bt) do { __builtin_amdgcn_s_setprio(1); _Pragma("unroll") for (int m = 0; m < 4; ++m) _Pragma("unroll") for (int n = 0; n < 2; ++n) _Pragma("unroll") for (int k = 0; k < 2; ++k) \
        { if constexpr (F8) { if (k == 0) asm volatile("v_mfma_scale_f32_16x16x128_f8f6f4 %0, %1, %2, %0, %3, %3 op_sel_hi:[0,0,0]" : "+v"(acc[ai][bj][m][n]) : "v"(Bt##8[n]), "v"(At##8[m]), "v"(f8scl)); } \
          else if constexpr (I8) acc[ai][bj][m][n] = __builtin_bit_cast(f32x4, __builtin_amdgcn_mfma_i32_16x16x64_i8(__builtin_bit_cast(i32x4, Bt[n][k]), __builtin_bit_cast(i32x4, At[m][k]), __builtin_bit_cast(i32x4, acc[ai][bj][m][n]), 0, 0, 0)); \
          else acc[ai][bj][m][n] = __builtin_amdgcn_mfma_f32_16x16x32_bf16(Bt[n][k], At[m][k], acc[ai][bj][m][n], 0, 0, 0); } __builtin_amdgcn_s_setprio(0); } while (0)
#define PG8_CAT8(x, y) __builtin_shufflevector(__builtin_bit_cast(i32x4, x), __builtin_bit_cast(i32x4, y), 0, 1, 2, 3, 4, 5, 6, 7)
#define PG8_WAIT_V(n) asm volatile("s_waitcnt vmcnt(" #n ")" ::: "memory")
#define PG8_WAIT_L(n) asm volatile("s_waitcnt lgkmcnt(" #n ")" ::: "memory")
#define PG8_BAR __builtin_amdgcn_s_barrier()
#define PG8_SCHED __builtin_amdgcn_sched_barrier(0)
    Unit cur, nxt; int ui = 0;
    if (!S.next(0, cur)) return;
    f32x4 acc[2][2][4][2];
#pragma unroll
    for (int a = 0; a < 2; ++a)
#pragma unroll
        for (int b = 0; b < 2; ++b)
#pragma unroll
            for (int m = 0; m < 4; ++m)
#pragma unroll
                for (int n = 0; n < 2; ++n) acc[a][b][m][n] = (f32x4){0.f, 0.f, 0.f, 0.f};
    bf16x8 At[4][2], B0[2][2], B1[2][2], Bn[2][2];
    const int f8scl = 0x7f7f7f7f;
    i32x8 At8[4], B08[2], B18[2], Bn8[2];
    const char* cA = (const char*)g.A + (size_t)cur.pm * tstep; const char* cB = (const char*)g.Bt + (size_t)cur.pn * tstep;
    S.a_ready(cur);
    if constexpr (SP2) {
        PG8_STAGE(PG8_SB(0, 0), cB, voffB); PG8_STAGE(PG8_SB(0, 1), cB + hstep, voffB); PG8_STAGE(PG8_SA(0, 0), cA, voffA); PG8_STAGE(PG8_SA(0, 1), cA + hstep, voffA);
        if (wr == 1) PG8_BAR;
        PG8_WAIT_V(2); PG8_BAR;
        PG8_STAGE(PG8_SB(1, 0), cB + kstep, voffB); PG8_STAGE(PG8_SA(1, 0), cA + kstep, voffA); PG8_STAGE(PG8_SB(1, 1), cB + hstep + kstep, voffB);
        PG8_WAIT_V(6); PG8_BAR;
    } else {
        PG8_STAGE(PG8_SB(0, 0), cB, voffB); PG8_STAGE(PG8_SA(0, 0), cA, voffA); PG8_STAGE(PG8_SB(0, 1), cB + hstep, voffB); PG8_STAGE(PG8_SA(0, 1), cA + hstep, voffA);
        if (wr == 1) PG8_BAR;
        PG8_WAIT_V(4); PG8_BAR;
        PG8_STAGE(PG8_SB(1, 0), cB + kstep, voffB); PG8_STAGE(PG8_SA(1, 0), cA + kstep, voffA); PG8_STAGE(PG8_SB(1, 1), cB + hstep + kstep, voffB);
        PG8_WAIT_V(6); PG8_BAR;
    }
    for (;;) {
        const bool has_next = S.next(ui + 1, nxt);
        const char* nA = has_next ? (const char*)g.A + (size_t)nxt.pm * tstep : cA; const char* nB = has_next ? (const char*)g.Bt + (size_t)nxt.pn * tstep : cB;
        if constexpr (SP2) PG8_LDB(B0, 0, 0);
        for (int t = 0; t < nt; t += 2) {
            const bool last = (t == nt - 2);
            const char* a1 = cA + (size_t)(t + 1) * kstep;
            const char* a2 = last ? nA : cA + (size_t)(t + 2) * kstep; const char* b2 = last ? nB : cB + (size_t)(t + 2) * kstep;
            const char* a3 = a2 + kstep; const char* b3 = b2 + kstep;
            if (last && has_next) S.a_ready(nxt);
            if constexpr (SP2) {
            PG8_LDB(B1, 0, 1); PG8_SCHED; PG8_LDA(At, 0, 0); PG8_STAGE(PG8_SA(1, 1), a1 + hstep, voffA);
            PG8_WAIT_V(6); PG8_WAIT_L(0); PG8_BAR; PG8_MMA(0, 0, At, B0); PG8_MMA(0, 1, At, B1); PG8_BAR; PG8_SCHED;
            PG8_LDA(At, 0, 1); PG8_LDB(Bn, 1, 0); PG8_STAGE(PG8_SB(0, 0), b2, voffB); PG8_STAGE(PG8_SB(0, 1), b2 + hstep, voffB); PG8_STAGE(PG8_SA(0, 0), a2, voffA);
            PG8_WAIT_V(8); PG8_WAIT_L(0); PG8_BAR; PG8_MMA(1, 0, At, B0); PG8_MMA(1, 1, At, B1); PG8_BAR; PG8_SCHED;
            PG8_LDB(B1, 1, 1); PG8_SCHED; PG8_LDA(At, 1, 0); PG8_STAGE(PG8_SA(0, 1), a2 + hstep, voffA);
            PG8_WAIT_V(6); PG8_WAIT_L(0); PG8_BAR; PG8_MMA(0, 0, At, Bn); PG8_MMA(0, 1, At, B1); PG8_BAR; PG8_SCHED;
            PG8_LDA(At, 1, 1); PG8_LDB(B0, 0, 0); PG8_STAGE(PG8_SB(1, 0), b3, voffB); PG8_STAGE(PG8_SB(1, 1), b3 + hstep, voffB); PG8_STAGE(PG8_SA(1, 0), a3, voffA);
            PG8_WAIT_V(8); PG8_WAIT_L(0); PG8_BAR; PG8_MMA(1, 0, At, Bn); PG8_MMA(1, 1, At, B1); PG8_BAR; PG8_SCHED;
            } else {
            PG8_LDB(B0, 0, 0); PG8_SCHED; PG8_LDA(At, 0, 0); PG8_STAGE(PG8_SA(1, 1), a1 + hstep, voffA);
            PG8_WAIT_L(8); PG8_BAR; PG8_WAIT_L(0); PG8_MMA(0, 0, At, B0); PG8_BAR; PG8_SCHED;
            PG8_LDB(B1, 0, 1); PG8_STAGE(PG8_SB(0, 0), b2, voffB);
            PG8_BAR; PG8_WAIT_L(0); PG8_MMA(0, 1, At, B1); PG8_BAR;
            PG8_LDA(At, 0, 1); PG8_STAGE(PG8_SA(0, 0), a2, voffA);
            PG8_BAR; PG8_WAIT_L(0); PG8_MMA(1, 0, At, B0); PG8_BAR; PG8_SCHED;
            PG8_STAGE(PG8_SB(0, 1), b2 + hstep, voffB);
            PG8_WAIT_V(6); PG8_BAR; PG8_MMA(1, 1, At, B1); PG8_BAR;
            PG8_LDB(B0, 1, 0); PG8_SCHED; PG8_LDA(At, 1, 0); PG8_STAGE(PG8_SA(0, 1), a2 + hstep, voffA);
            PG8_WAIT_L(8); PG8_BAR; PG8_WAIT_L(0); PG8_MMA(0, 0, At, B0); PG8_BAR; PG8_SCHED;
            PG8_LDB(B1, 1, 1); PG8_STAGE(PG8_SB(1, 0), b3, voffB);
            PG8_BAR; PG8_WAIT_L(0); PG8_MMA(0, 1, At, B1); PG8_BAR;
            PG8_LDA(At, 1, 1); PG8_STAGE(PG8_SA(1, 0), a3, voffA);
            PG8_BAR; PG8_WAIT_L(0); PG8_MMA(1, 0, At, B0); PG8_BAR; PG8_SCHED;
            PG8_STAGE(PG8_SB(1, 1), b3 + hstep, voffB);
            PG8_WAIT_V(6); PG8_BAR; PG8_MMA(1, 1, At, B1); PG8_BAR;
            }
        }
        if constexpr (F8) asm volatile("s_nop 15\n\ts_nop 15" ::: "memory");
        if constexpr (ALIGN_EPI) { if (wr == 0) PG8_BAR; }
        if constexpr (I8) {
#pragma unroll
            for (int a = 0; a < 2; ++a)
#pragma unroll
                for (int b2 = 0; b2 < 2; ++b2)
#pragma unroll
                    for (int m = 0; m < 4; ++m)
#pragma unroll
                        for (int n = 0; n < 2; ++n) acc[a][b2][m][n] = __builtin_convertvector(__builtin_bit_cast(i32x4, acc[a][b2][m][n]), f32x4);
        }
        if constexpr (!Epi::AFTER_DRAIN) { E(acc, cur, wr, wc, fr, fq); S.done(cur); }
        if (!has_next) break;
#pragma unroll
        for (int a = 0; a < 2; ++a)
#pragma unroll
            for (int b = 0; b < 2; ++b)
#pragma unroll
                for (int m = 0; m < 4; ++m)
#pragma unroll
                    for (int n = 0; n < 2; ++n) acc[a][b][m][n] = (f32x4){0.f, 0.f, 0.f, 0.f};
        cur = nxt; cA = nA; cB = nB; ++ui;
        if constexpr (ALIGN_EPI) { if (wr == 1) PG8_BAR; }
    }
    PG8_WAIT_V(0);
    if constexpr (!ALIGN_EPI) { if (wr == 0) PG8_BAR; }
    PG8_BAR;
    if constexpr (Epi::AFTER_DRAIN) { E.fused(acc, cur, wr, wc, fr, fq, lds, wid, lane); S.done(cur); }
#undef PG8_SA
#undef PG8_SB
#undef PG8_STAGE
#undef PG8_LDA
#undef PG8_LDA_
#undef PG8_LDB_
#undef PG8_LDA8
#undef PG8_LDB8
#undef PG8_LD8
#undef PG8_LDB
#undef PG8_MMA
#undef PG8_CAT8
#undef PG8_WAIT_V
#undef PG8_WAIT_L
#undef PG8_BAR
#undef PG8_SCHED
}
}

#define LAS __attribute__((address_space(3)))
typedef unsigned short bf16;
typedef short bf16x8 __attribute__((ext_vector_type(8)));
typedef short s16x4 __attribute__((ext_vector_type(4)));
typedef short v4i16_t __attribute__((ext_vector_type(4)));
typedef float f32x4 __attribute__((ext_vector_type(4)));
typedef float f32x16 __attribute__((ext_vector_type(16)));
typedef unsigned u32x4 __attribute__((ext_vector_type(4)));
typedef unsigned u32x2 __attribute__((ext_vector_type(2)));

constexpr int NB = 32, SEQ = 2048, DM = 1024, MROWS = NB * SEQ;
constexpr int DIN = 4576, DINP = 4608, DFF = 2816, NADA = 6 * DM;
constexpr float LOG2E = 1.4426950408889634f;
constexpr float QSCALE = 0.125f * LOG2E;
constexpr float RMS_EPS = 1e-6f;
constexpr int NWAVES = 8, NTHREADS = 512;
constexpr int LDS_BYTES = 147456;
constexpr int MAXGRID = 256;

constexpr size_t MiB = 1ull << 20;
constexpr size_t WS_MOD = 1 * MiB, WS_BIAS = 2 * MiB,
    WS_WIN = 4 * MiB, WS_WOA = 13 * MiB, WS_WOB = 14 * MiB, WS_WOUT = 15 * MiB, WS_WGU = 17 * MiB, WS_WD = 28 * MiB,
    WS_WCK1 = 34 * MiB, WS_WCV1 = 34 * MiB + 512 * 1024, WS_KCO = 35 * MiB, WS_VCO = 36 * MiB,
    WS_H = 40 * MiB, WS_OA = 40 * MiB, WS_OB = 104 * MiB, WS_H2 = 40 * MiB,
    WS_QA = 168 * MiB, WS_QB = 232 * MiB, WS_IQ = 296 * MiB, WS_GA = 360 * MiB, WS_GB = 488 * MiB,
    WS_KC = 616 * MiB, WS_VC = 632 * MiB, WS_KS = 648 * MiB, WS_VS = 664 * MiB, WS_KW = 680 * MiB, WS_VW = 696 * MiB,
    WS_KB = 712 * MiB, WS_VB = 720 * MiB, WS_IK = 728 * MiB, WS_GN = 736 * MiB, WS_IW = 744 * MiB,
    WS_SCR = 748 * MiB, WS_Y = 812 * MiB, WS_ACT = 168 * MiB, WS_END = 940 * MiB,
    WS_ROWSS = 65536  , WS_CB = 3 * MiB  ,
    WS_X1B = 620 * MiB  ;
constexpr size_t ZERO_BYTES = 65536 + 3 * 4 * 65536;
constexpr size_t WS_HQ = 812 * MiB  , WS_WINGQ = WS_WIN + 4 * MiB  ;
constexpr size_t WS_SBWIN = 2 * MiB + 65536, WS_SBWGU = 2 * MiB + 131072, WS_SA1 = 2 * MiB + 262144, WS_SA2 = 2 * MiB + 524288;
constexpr size_t WS_SBO = 2 * MiB + 200704  , WS_ROWNA = 327680, WS_ROWNB = 589824  ;
constexpr size_t WS_Y8 = 168 * MiB  ;
constexpr size_t WS_VMAX = 32768  , WS_SBWO = 2 * MiB + 212992  ;
constexpr size_t WS_OB8 = WS_OA + 32 * MiB  , WS_WOB8 = WS_WOA + 512 * 1024;
__device__ __forceinline__ float so_scale_a(const float* vm) { const float bd = (vm[0] + vm[1] + vm[2]) * (1.01f / 440.f); return (bd > 0.f) ? bd : 1.f; }
__device__ __forceinline__ float so_scale_b(const float* vm) { const float bd = vm[3] * (1.01f / 440.f); return (bd > 0.f) ? bd : 1.f; }
constexpr size_t WS_SBD = 2 * MiB + 196608  , WS_SACT = 2 * MiB + 786432  , WS_WNMAX = 2 * MiB + 208896  , WS_WNI = 2 * MiB + 204800  ;

struct Args { const float* in[25]; float* out; unsigned char* ws; int ph_lo, ph_hi; };

enum { I_X = 0, I_C, I_WADA, I_BADA, I_GN1, I_GN2, I_WIN, I_GQA, I_GKC, I_GKS, I_GKW, I_PECK, I_PECV, I_WCK1, I_WCK2, I_WCV1, I_WCV2,
       I_GQB, I_GKB, I_WOA, I_WOB, I_WOUT, I_WFG, I_WFU, I_WFD };

typedef float f32x2_t __attribute__((ext_vector_type(2))); typedef __bf16 bf16x2_t __attribute__((ext_vector_type(2)));
__device__ __forceinline__ unsigned cvt_pk(float lo, float hi) { const f32x2_t v = {lo, hi}; const bf16x2_t b = __builtin_convertvector(v, bf16x2_t); return __builtin_bit_cast(unsigned, b); }
__device__ __forceinline__ float bf2f(unsigned short v) { return __uint_as_float((unsigned)v << 16); }
__device__ __forceinline__ float sigmoidf_(float x) { return __builtin_amdgcn_rcpf(1.f + __builtin_amdgcn_exp2f(x * -LOG2E)); }
__device__ __forceinline__ float siluf_(float x) { return x * __builtin_amdgcn_rcpf(1.f + __builtin_amdgcn_exp2f(x * -LOG2E)); }
__device__ __forceinline__ float sy_scale(float rna, float rnb, float wa, float wb) { const float bd = (sqrtf(rna) * wa + sqrtf(rnb) * wb) * (1.02f / 440.f); return (bd > 0.f) ? bd : 1.f; }
__device__ __forceinline__ float wave_sum(float v) {
#pragma unroll
    for (int o = 1; o < 64; o <<= 1) v += __shfl_xor(v, o);
    return v;
}
#define LDS_WAIT() asm volatile("s_waitcnt lgkmcnt(0)" ::: "memory")
#define DPP_STEP_F(x, op, ctrl, rmask, bc, ident) { const float y_ = __int_as_float(__builtin_amdgcn_update_dpp(__float_as_int(ident), __float_as_int(x), ctrl, rmask, 0xf, bc)); x = op(x, y_); }
__device__ __forceinline__ float fadd_(float a, float b) { return a + b; }
__device__ __forceinline__ float wave_sum_dpp(float x) {
    DPP_STEP_F(x, fadd_, 0x111, 0xf, true, 0.f) DPP_STEP_F(x, fadd_, 0x112, 0xf, true, 0.f) DPP_STEP_F(x, fadd_, 0x114, 0xf, true, 0.f) DPP_STEP_F(x, fadd_, 0x118, 0xf, true, 0.f)
    DPP_STEP_F(x, fadd_, 0x142, 0xa, false, 0.f) DPP_STEP_F(x, fadd_, 0x143, 0xc, false, 0.f)
    return __int_as_float(__builtin_amdgcn_readlane(__float_as_int(x), 63));
}
__device__ __forceinline__ float wave_max_dpp(float x) {
    DPP_STEP_F(x, fmaxf, 0x111, 0xf, true, 0.f) DPP_STEP_F(x, fmaxf, 0x112, 0xf, true, 0.f) DPP_STEP_F(x, fmaxf, 0x114, 0xf, true, 0.f) DPP_STEP_F(x, fmaxf, 0x118, 0xf, true, 0.f)
    DPP_STEP_F(x, fmaxf, 0x142, 0xa, false, 0.f) DPP_STEP_F(x, fmaxf, 0x143, 0xc, false, 0.f)
    return __int_as_float(__builtin_amdgcn_readlane(__float_as_int(x), 63));
}

__device__ __forceinline__ int win_src_col(int np) {
    const int T = np >> 8, r = np & 255;
    if (T >= 10) return 2528 + (T - 10) * 256 + r;
    const int slot = (r & 127) >> 5, d = ((r >> 7) << 5) + (r & 31);
    switch (T) {
        case 0: return slot * 64 + d;
        case 1: return 256 + slot * 64 + d;
        case 2: return 512 + slot * 64 + d;
        case 3: return 768 + slot * 64 + d;
        case 4: return 1024 + slot * 64 + d;
        case 5: return 1304 + slot * 64 + d;
        case 6: return 1560 + slot * 64 + d;
        case 7: if (slot == 0) return 1816 + d;
                if (slot == 1) return 1880 + d;
                if (slot == 2) return 2456 + d;
                if (d < 24) return 1280 + d;
                if (d < 32) return 2520 + (d - 24);
                return -1;
        case 8: return 1944 + slot * 64 + d;
        default: return 2200 + slot * 64 + d;
    }
}

constexpr int NBFT = 3, NI8T = 15;
__device__ __forceinline__ int tmap_bf(int t) { return t + 7; }
__device__ __forceinline__ int tmap_i8(int t) { return t < 7 ? t : t + 3; }
constexpr int NBFROWS = NBFT * 256, NI8ROWS = NI8T * 256, NBFG = NBFROWS / 32, NI8G = NI8ROWS / 32;
__device__ __forceinline__ int win_src_col_bf(int np) { return win_src_col(tmap_bf(np >> 8) * 256 + (np & 255)); }
__device__ __forceinline__ int win_src_col_i8(int np) { return win_src_col(tmap_i8(np >> 8) * 256 + (np & 255)); }
__device__ __forceinline__ void transpose_item(const float* __restrict__ W, int ldw, int K, bf16* __restrict__ WT, int n0p, int k0, int col, LAS float* scr, int lane) {
#pragma unroll 8
    for (int i = 0; i < 32; ++i) { const int kk = 2 * i + (lane >> 5); scr[kk * 33 + (lane & 31)] = (col >= 0) ? W[(size_t)(k0 + kk) * ldw + col] : 0.f; }
    LDS_WAIT(); asm volatile("" ::: "memory");
    const int c = lane & 7;
#pragma unroll
    for (int j = 0; j < 4; ++j) { const int n = (lane >> 3) + 8 * j; const LAS float* s = scr + (8 * c) * 33 + n;
        u32x4 o; o.x = cvt_pk(s[0 * 33], s[1 * 33]); o.y = cvt_pk(s[2 * 33], s[3 * 33]); o.z = cvt_pk(s[4 * 33], s[5 * 33]); o.w = cvt_pk(s[6 * 33], s[7 * 33]);
        *(u32x4*)(WT + (size_t)(n0p + n) * K + k0 + 8 * c) = o; }
    LDS_WAIT(); asm volatile("" ::: "memory");
}

__device__ __forceinline__ void phase0(const Args& a, LAS unsigned char* lds) {
    const int tid = threadIdx.x, lane = tid & 63, wave = __builtin_amdgcn_readfirstlane(tid >> 6);
    unsigned char* ws = a.ws;
    for (size_t i = (size_t)blockIdx.x * NTHREADS + tid; i < ZERO_BYTES / 16; i += (size_t)gridDim.x * NTHREADS) ((u32x4*)ws)[i] = u32x4{0u, 0u, 0u, 0u};
    {
        LAS float* scr = (LAS float*)(lds + wave * 16384);
        const int gw = blockIdx.x * NWAVES + wave, NGW = gridDim.x * NWAVES;
        constexpr int I0 = 16 * NBFG  , I1 = 0, I2 = 0  , I3 = 0  , I4 = 0  , I5 = 0  , I6 = 32 * 4, I7 = 32 * 4;
        constexpr int NIT = I0 + I1 + I2 + I3 + I4 + I5 + I6 + I7;
        for (int it = gw; it < NIT; it += NGW) {
            int r = it;
            if (r < I0) { const int kb = r / (NBFG > 0 ? NBFG : 1), nb = r % (NBFG > 0 ? NBFG : 1), np = nb * 32 + (lane & 31);
                transpose_item(a.in[I_WIN], DIN, DM, (bf16*)(ws + WS_WIN), nb * 32, kb * 64, win_src_col_bf(np), scr, lane); continue; } r -= I0;
            if (r < I1) { const int kb = r / 32, nb = r % 32;
                transpose_item(a.in[I_WOA], DM, 512, (bf16*)(ws + WS_WOA), nb * 32, kb * 64, nb * 32 + (lane & 31), scr, lane); continue; } r -= I1;
            if (r < I2) { const int kb = r / 32, nb = r % 32;
                transpose_item(a.in[I_WOB], DM, 512, (bf16*)(ws + WS_WOB), nb * 32, kb * 64, nb * 32 + (lane & 31), scr, lane); continue; } r -= I2;
            if (r < I3) { const int kb = r / 32, nb = r % 32;
                transpose_item(a.in[I_WOUT], DM, DM, (bf16*)(ws + WS_WOUT), nb * 32, kb * 64, nb * 32 + (lane & 31), scr, lane); continue; } r -= I3;
            if (r < I4) { const int kb = r / 176, nb = r % 176, np0 = nb * 32, T = np0 >> 8, rr = np0 & 255;
                const float* src = (rr < 128) ? a.in[I_WFG] : a.in[I_WFU];
                transpose_item(src, DFF, DM, (bf16*)(ws + WS_WGU), np0, kb * 64, T * 128 + (rr & 127) + (lane & 31), scr, lane); continue; } r -= I4;
            if (r < I5) { const int kb = r / 32, nb = r % 32;
                transpose_item(a.in[I_WFD], DM, DFF, (bf16*)(ws + WS_WD), nb * 32, kb * 64, nb * 32 + (lane & 31), scr, lane); continue; } r -= I5;
            if (r < I6) { const int kb = r / 4, nb = r % 4;
                transpose_item(a.in[I_WCK1], 128, 2048, (bf16*)(ws + WS_WCK1), nb * 32, kb * 64, nb * 32 + (lane & 31), scr, lane); continue; } r -= I6;
            { const int kb = r / 4, nb = r % 4;
                transpose_item(a.in[I_WCV1], 128, 2048, (bf16*)(ws + WS_WCV1), nb * 32, kb * 64, nb * 32 + (lane & 31), scr, lane); }
        }
    }
    LAS float* sc = (LAS float*)lds;
    for (int it = blockIdx.x; it < 208 + 176 + NI8G + 32 + 96; it += gridDim.x) {
        __syncthreads();
        if (it >= 208 + 176 + NI8G + 32) {
            const int j = it - (208 + 176 + NI8G + 32), which = j >> 5, col = (j & 31) * 32 + (lane & 31);
            const float* W = a.in[which == 0 ? I_WOUT : (which == 1 ? I_WOA : I_WOB)]; const int kw = which == 0 ? 128 : 64;
            float m = 0.f, s2 = 0.f;
#pragma unroll 8
            for (int i = 0; i < kw / 2; ++i) { const int k = kw * wave + 2 * i + (lane >> 5); const float v = W[(size_t)k * DM + col]; m = fmaxf(m, fabsf(v)); s2 += v * v; }
            m = fmaxf(m, __shfl_xor(m, 32)); s2 += __shfl_xor(s2, 32);
            if (lane < 32) { sc[wave * 32 + lane] = m; sc[256 + wave * 32 + lane] = s2; }
            __syncthreads();
            if (tid < 32) { float mm = 0.f, ss = 0.f;
#pragma unroll
                for (int w = 0; w < 8; ++w) { mm = fmaxf(mm, sc[w * 32 + tid]); ss += sc[256 + w * 32 + tid]; }
                if (which == 0) ((float*)(ws + WS_SBO))[(j & 31) * 32 + tid] = (mm > 0.f) ? mm * (1.f / 448.f) : 1.f;
                else { ((float*)(ws + WS_SBWO))[(which - 1) * 1024 + (j & 31) * 32 + tid] = (mm > 0.f) ? mm * (1.f / 448.f) : 1.f;
                    float cn = sqrtf(ss) * 1.0635f;
#pragma unroll
                    for (int o = 1; o < 32; o <<= 1) cn = fmaxf(cn, __shfl_xor(cn, o));
                    if (tid == 0) ((float*)(ws + WS_WNI))[176 + (which - 1) * 32 + (j & 31)] = cn; } }
        } else if (it >= 208 + 176 + NI8G) {
            const int g32 = it - 208 - 176 - NI8G, col = g32 * 32 + (lane & 31); const float* W = a.in[I_WFD];
            float m = 0.f;
#pragma unroll 8
            for (int i = 0; i < 176; ++i) { const int k = 352 * wave + 2 * i + (lane >> 5); m = fmaxf(m, fabsf(W[(size_t)k * DM + col])); }
            m = fmaxf(m, __shfl_xor(m, 32));
            if (lane < 32) sc[wave * 32 + lane] = m;
            __syncthreads();
            if (tid < 32) { float mm = 0.f;
#pragma unroll
                for (int w = 0; w < 8; ++w) mm = fmaxf(mm, sc[w * 32 + tid]);
                ((float*)(ws + WS_SBD))[g32 * 32 + tid] = (mm > 0.f) ? mm * (1.f / 448.f) : 1.f; }
        } else if (it >= 208 + 176) {
            const int g32 = it - 208 - 176, col = win_src_col_i8(g32 * 32 + (lane & 31)); const float* W = a.in[I_WIN];
            float m = 0.f;
#pragma unroll 8
            for (int i = 0; i < 64; ++i) { const int k = 128 * wave + 2 * i + (lane >> 5); const float v = (col >= 0) ? W[(size_t)k * DIN + col] : 0.f; m = fmaxf(m, fabsf(v)); }
            m = fmaxf(m, __shfl_xor(m, 32));
            if (lane < 32) sc[wave * 32 + lane] = m;
            __syncthreads();
            if (tid < 32) { float mm = 0.f;
#pragma unroll
                for (int w = 0; w < 8; ++w) mm = fmaxf(mm, sc[w * 32 + tid]);
                ((float*)(ws + WS_SBWIN))[g32 * 32 + tid] = (mm > 0.f) ? mm * (1.f / 127.f) : 1.f; }
        } else if (it >= 208) {
            const int g32 = it - 208, np0 = g32 * 32, T = np0 >> 8, rr = np0 & 255; const float* W = (rr < 128) ? a.in[I_WFG] : a.in[I_WFU];
            const int col = T * 128 + (rr & 127) + (lane & 31);
            float m = 0.f, s2 = 0.f;
#pragma unroll 8
            for (int i = 0; i < 64; ++i) { const int k = 128 * wave + 2 * i + (lane >> 5); const float v = W[(size_t)k * DFF + col]; m = fmaxf(m, fabsf(v)); s2 += v * v; }
            m = fmaxf(m, __shfl_xor(m, 32)); s2 += __shfl_xor(s2, 32);
            if (lane < 32) { sc[wave * 32 + lane] = m; sc[256 + wave * 32 + lane] = s2; }
            __syncthreads();
            if (tid < 32) { float mm = 0.f, ss = 0.f;
#pragma unroll
                for (int w = 0; w < 8; ++w) { mm = fmaxf(mm, sc[w * 32 + tid]); ss += sc[256 + w * 32 + tid]; }
                const float sb = (mm > 0.f) ? mm * (1.f / 127.f) : 1.f;
                ((float*)(ws + WS_SBWGU))[g32 * 32 + tid] = sb;
                float cn = sqrtf(ss) * 1.0001f + 16.f * sb;
#pragma unroll
                for (int o = 1; o < 32; o <<= 1) cn = fmaxf(cn, __shfl_xor(cn, o));
                if (tid == 0) ((float*)(ws + WS_WNI))[g32] = cn; }
        } else if (it < 192) {
            const float* c = a.in[I_C];
            for (int i = tid; i < NB * DM; i += NTHREADS) { const int bb = i >> 10, kk = i & 1023; sc[kk * 32 + bb] = siluf_(c[i]); }
            __syncthreads();
            const int cl = tid & 31, ks = tid >> 5, col = it * 32 + cl;
            float acc[32];
#pragma unroll
            for (int j = 0; j < 32; ++j) acc[j] = 0.f;
            const float* W = a.in[I_WADA] + (size_t)(ks * 64) * NADA + col;
#pragma unroll 1
            for (int k0 = 0; k0 < 64; k0 += 8) {
                float w[8];
#pragma unroll
                for (int u = 0; u < 8; ++u) w[u] = W[(size_t)(k0 + u) * NADA];
#pragma unroll
                for (int u = 0; u < 8; ++u) { const LAS f32x4* sp = (const LAS f32x4*)(sc + (ks * 64 + k0 + u) * 32);
#pragma unroll
                    for (int q = 0; q < 8; ++q) { const f32x4 v = sp[q]; acc[4 * q] += v.x * w[u]; acc[4 * q + 1] += v.y * w[u]; acc[4 * q + 2] += v.z * w[u]; acc[4 * q + 3] += v.w * w[u]; } }
            }
            __syncthreads();
#pragma unroll
            for (int j = 0; j < 32; ++j) sc[(ks * 32 + j) * 32 + cl] = acc[j];
            __syncthreads();
            float* mod = (float*)(ws + WS_MOD);
            for (int o = tid; o < 1024; o += NTHREADS) { const int b = o >> 5, c2 = o & 31;
                float s2 = 0.f;
#pragma unroll
                for (int q = 0; q < 16; ++q) s2 += sc[(q * 32 + b) * 32 + c2];
                mod[b * NADA + it * 32 + c2] = s2 + a.in[I_BADA][it * 32 + c2]; }
        } else {
            const int which = (it - 192) >> 3, kq = (it - 192) & 7;
            const float* pe = a.in[which ? I_PECV : I_PECK]; const float* w1 = a.in[which ? I_WCV1 : I_WCK1];
            const int col = tid & 127, ks = tid >> 7; float s = 0.f;
#pragma unroll 8
            for (int k = kq * 256 + ks * 64; k < kq * 256 + ks * 64 + 64; ++k) s += pe[k] * w1[(size_t)k * 128 + col];
            sc[ks * 128 + col] = s;
            __syncthreads();
            if (tid < 128) ((float*)(ws + WS_BIAS))[(which * 8 + kq) * 128 + tid] = sc[tid] + sc[128 + tid] + sc[256 + tid] + sc[384 + tid];
        }
    }
    __syncthreads();
}

__device__ __forceinline__ void transpose_item_i8(const float* __restrict__ W, int ldw, int K, signed char* __restrict__ WQ, const float* __restrict__ SB, int n0p, int k0, int col, LAS float* scr, int lane) {
#pragma unroll 8
    for (int i = 0; i < 32; ++i) { const int kk = 2 * i + (lane >> 5); scr[kk * 33 + (lane & 31)] = (col >= 0) ? W[(size_t)(k0 + kk) * ldw + col] : 0.f; }
    LDS_WAIT(); asm volatile("" ::: "memory");
    const int n = lane >> 1, kh = (lane & 1) * 32; const float inv = 1.f / SB[n0p + n];
#pragma unroll
    for (int c = 0; c < 2; ++c) { unsigned w[4];
#pragma unroll
        for (int d = 0; d < 4; ++d) { unsigned pk = 0u;
#pragma unroll
            for (int j = 0; j < 4; ++j) { const float v = scr[(kh + 16 * c + 4 * d + j) * 33 + n] * inv; int q = (int)rintf(v); q = q > 127 ? 127 : (q < -127 ? -127 : q); pk |= ((unsigned)q & 0xffu) << (8 * j); }
            w[d] = pk; }
        *(u32x4*)(WQ + (size_t)(n0p + n) * K + k0 + kh + 16 * c) = u32x4{w[0], w[1], w[2], w[3]}; }
    LDS_WAIT(); asm volatile("" ::: "memory");
}
__device__ __forceinline__ void wing_quant_items(const Args& a, LAS unsigned char* lds) {
    const int tid = threadIdx.x, lane = tid & 63, wave = __builtin_amdgcn_readfirstlane(tid >> 6); unsigned char* ws = a.ws;
    LAS float* scr = (LAS float*)(lds + wave * 16384);
    const int gw = blockIdx.x * NWAVES + wave, NGW = gridDim.x * NWAVES;
    for (int it = gw; it < 16 * NI8G; it += NGW) { const int kb = it / NI8G, nb = it % NI8G;
        transpose_item_i8(a.in[I_WIN], DIN, DM, (signed char*)(ws + WS_WINGQ), (const float*)(ws + WS_SBWIN), nb * 32, kb * 64, win_src_col_i8(nb * 32 + (lane & 31)), scr, lane); }
}
__device__ __forceinline__ void wgu_quant_items(const Args& a, LAS unsigned char* lds) {
    const int tid = threadIdx.x, lane = tid & 63, wave = __builtin_amdgcn_readfirstlane(tid >> 6); unsigned char* ws = a.ws;
    LAS float* scr = (LAS float*)(lds + wave * 16384);
    const int gw = blockIdx.x * NWAVES + wave, NGW = gridDim.x * NWAVES;
    for (int it = gw; it < 16 * 176; it += NGW) { const int kb = it / 176, nb = it % 176, np0 = nb * 32, T = np0 >> 8, rr = np0 & 255;
        const float* src = (rr < 128) ? a.in[I_WFG] : a.in[I_WFU];
        transpose_item_i8(src, DFF, DM, (signed char*)(ws + WS_WGU), (const float*)(ws + WS_SBWGU), np0, kb * 64, T * 128 + (rr & 127) + (lane & 31), scr, lane); }
}
__device__ __forceinline__ void transpose_item_f8(const float* __restrict__ W, int ldw, int K, unsigned char* __restrict__ WQ, const float* __restrict__ SB, int n0p, int k0, int col, LAS float* scr, int lane) {
#pragma unroll 8
    for (int i = 0; i < 32; ++i) { const int kk = 2 * i + (lane >> 5); scr[kk * 33 + (lane & 31)] = W[(size_t)(k0 + kk) * ldw + col]; }
    LDS_WAIT(); asm volatile("" ::: "memory");
    const int n = lane >> 1, kh = (lane & 1) * 32; const float inv = 1.f / SB[n0p + n];
#pragma unroll
    for (int c = 0; c < 2; ++c) { unsigned w[4];
#pragma unroll
        for (int d = 0; d < 4; ++d) { const LAS float* sp = scr + (kh + 16 * c + 4 * d) * 33 + n;
            int pk = __builtin_amdgcn_cvt_pk_fp8_f32(sp[0] * inv, sp[33] * inv, 0, false); pk = __builtin_amdgcn_cvt_pk_fp8_f32(sp[66] * inv, sp[99] * inv, pk, true);
            w[d] = (unsigned)pk; }
        *(u32x4*)(WQ + (size_t)(n0p + n) * K + k0 + kh + 16 * c) = u32x4{w[0], w[1], w[2], w[3]}; }
    LDS_WAIT(); asm volatile("" ::: "memory");
}
__device__ __forceinline__ void wd_quant_items(const Args& a, LAS unsigned char* lds) {
    const int tid = threadIdx.x, lane = tid & 63, wave = __builtin_amdgcn_readfirstlane(tid >> 6); unsigned char* ws = a.ws;
    LAS float* scr = (LAS float*)(lds + wave * 16384);
    const int gw = blockIdx.x * NWAVES + wave, NGW = gridDim.x * NWAVES;
    for (int it = gw; it < 44 * 32; it += NGW) { const int kb = it / 32, nb = it % 32;
        transpose_item_f8(a.in[I_WFD], DM, DFF, ws + WS_WD, (const float*)(ws + WS_SBD), nb * 32, kb * 64, nb * 32 + (lane & 31), scr, lane); }
}
__device__ __forceinline__ void woab_quant_items(const Args& a, LAS unsigned char* lds) {
    const int tid = threadIdx.x, lane = tid & 63, wave = __builtin_amdgcn_readfirstlane(tid >> 6); unsigned char* ws = a.ws;
    LAS float* scr = (LAS float*)(lds + wave * 16384);
    const int gw = blockIdx.x * NWAVES + wave, NGW = gridDim.x * NWAVES;
    for (int it = gw; it < 2 * 8 * 32; it += NGW) { const int which = it >> 8, r = it & 255, kb = r / 32, nb = r % 32;
        transpose_item_f8(a.in[which ? I_WOB : I_WOA], DM, 512, ws + WS_WOA, (const float*)(ws + WS_SBWO), which * 1024 + nb * 32, kb * 64, nb * 32 + (lane & 31), scr, lane); }
}
__device__ __forceinline__ void wout_quant_items(const Args& a, LAS unsigned char* lds) {
    const int tid = threadIdx.x, lane = tid & 63, wave = __builtin_amdgcn_readfirstlane(tid >> 6); unsigned char* ws = a.ws;
    LAS float* scr = (LAS float*)(lds + wave * 16384);
    const int gw = blockIdx.x * NWAVES + wave, NGW = gridDim.x * NWAVES;
    for (int it = gw; it < 16 * 32; it += NGW) { const int kb = it / 32, nb = it % 32;
        transpose_item_f8(a.in[I_WOUT], DM, DM, ws + WS_WOUT, (const float*)(ws + WS_SBO), nb * 32, kb * 64, nb * 32 + (lane & 31), scr, lane); }
}
__device__ __forceinline__ void wnmax_item(unsigned char* ws) {
    const int lane = threadIdx.x & 63; const float* wni = (const float*)(ws + WS_WNI);
    float g = 0.f, u = 0.f;
    for (int i = lane; i < 176; i += 64) { const float v = wni[i]; if ((i & 7) < 4) g = fmaxf(g, v); else u = fmaxf(u, v); }
    float oa = (lane < 32) ? wni[176 + lane] : 0.f, ob = (lane < 32) ? wni[208 + lane] : 0.f;
    g = wave_max_dpp(g); u = wave_max_dpp(u); oa = wave_max_dpp(oa); ob = wave_max_dpp(ob);
    if (lane == 0) *(f32x4*)(ws + WS_WNMAX) = f32x4{g, u, oa, ob};
}
__device__ __forceinline__ void norm2_quant_phase(const bf16* __restrict__ X1B, const float* __restrict__ rowss, const float* __restrict__ gain, const float* __restrict__ mod, signed char* __restrict__ Q, float* __restrict__ SA, float* __restrict__ SACT, const float* __restrict__ wnmax) {
    const int tid = threadIdx.x, lane = tid & 63, wave = tid >> 6;
    const int gw = blockIdx.x * NWAVES + wave, NGW = gridDim.x * NWAVES, wpb = NGW / NB;
    if (wpb * NB != NGW || gw >= wpb * NB) return;
    const int b = gw / wpb, wi = gw % wpb;
    float mg[2][8], sh[2][8];
#pragma unroll
    for (int j = 0; j < 2; ++j) { const int k = 8 * lane + 512 * j;
#pragma unroll
        for (int h = 0; h < 2; ++h) { const f32x4 g = *(const f32x4*)(gain + k + 4 * h), sc = *(const f32x4*)(mod + b * NADA + 4 * DM + k + 4 * h), s2 = *(const f32x4*)(mod + b * NADA + 3 * DM + k + 4 * h);
            mg[j][4 * h] = g.x * (1.f + sc.x); mg[j][4 * h + 1] = g.y * (1.f + sc.y); mg[j][4 * h + 2] = g.z * (1.f + sc.z); mg[j][4 * h + 3] = g.w * (1.f + sc.w);
            sh[j][4 * h] = s2.x; sh[j][4 * h + 1] = s2.y; sh[j][4 * h + 2] = s2.z; sh[j][4 * h + 3] = s2.w; } }
    const float wprod = wnmax[0] * wnmax[1] * (1.f / 440.f);
    u32x4 qn[2]; float rsn;
    { const size_t m0 = (size_t)b * SEQ + wi; const u32x4* xr = (const u32x4*)(X1B + m0 * DM) + lane; qn[0] = xr[0]; qn[1] = xr[64]; rsn = rowss[m0]; }
    for (int t = wi; t < SEQ; t += wpb) {
        const size_t m = (size_t)b * SEQ + t;
        const u32x4 q0 = qn[0], q1 = qn[1]; const float rstd = rsqrtf(rsn * (1.f / DM) + RMS_EPS);
        if (t + wpb < SEQ) { const u32x4* xr = (const u32x4*)(X1B + (m + wpb) * DM) + lane; qn[0] = xr[0]; qn[1] = xr[64]; rsn = rowss[m + wpb]; }
        float v[2][8]; float amax = 0.f, vss = 0.f;
#pragma unroll
        for (int j = 0; j < 2; ++j) { const u32x4 q = j ? q1 : q0; const unsigned w[4] = {q.x, q.y, q.z, q.w};
#pragma unroll
            for (int e = 0; e < 8; ++e) { const float x = __uint_as_float((e & 1) ? (w[e >> 1] & 0xffff0000u) : (w[e >> 1] << 16));
                v[j][e] = x * rstd * mg[j][e] + sh[j][e]; amax = fmaxf(amax, fabsf(v[j][e])); vss += v[j][e] * v[j][e]; } }
        amax = wave_max_dpp(amax); vss = wave_sum_dpp(vss);
        const float inv = (amax > 0.f) ? 127.f / amax : 0.f;
        u32x2* q8 = (u32x2*)(Q + m * DM) + lane;
#pragma unroll
        for (int j = 0; j < 2; ++j) { unsigned pk[2];
#pragma unroll
            for (int d = 0; d < 2; ++d) { unsigned p = 0u;
#pragma unroll
                for (int e = 0; e < 4; ++e) p |= ((unsigned)(int)rintf(v[j][4 * d + e] * inv) & 0xffu) << (8 * e);
                pk[d] = p; }
            q8[64 * j] = u32x2{pk[0], pk[1]}; }
        if (lane == 0) { const float sa = (amax > 0.f) ? amax * (1.f / 127.f) : 1.f; SA[m] = sa;
            const float hn = sqrtf(vss) * 1.0001f + 16.f * sa;
            const float bd = hn * hn * wprod; SACT[m] = (bd > 0.f) ? bd : 1.f; }
    }
}

__device__ __forceinline__ void norm_dual_phase(const float* __restrict__ X, const float* __restrict__ gain, const float* __restrict__ mod, int shift_off, int scale_off, bf16* __restrict__ O, signed char* __restrict__ Q, float* __restrict__ SA) {
    const int tid = threadIdx.x, lane = tid & 63, wave = tid >> 6;
    const int gw = blockIdx.x * NWAVES + wave, NGW = gridDim.x * NWAVES, wpb = NGW / NB;
    if (wpb * NB != NGW || gw >= wpb * NB) return;
    const int b = gw / wpb, wi = gw % wpb;
    f32x4 mg[4], sh[4];
#pragma unroll
    for (int q = 0; q < 4; ++q) { const int k = 8 * lane + 512 * (q >> 1) + 4 * (q & 1);
        const f32x4 g = *(const f32x4*)(gain + k), sc = *(const f32x4*)(mod + b * NADA + scale_off + k); sh[q] = *(const f32x4*)(mod + b * NADA + shift_off + k);
        mg[q] = f32x4{g.x * (1.f + sc.x), g.y * (1.f + sc.y), g.z * (1.f + sc.z), g.w * (1.f + sc.w)}; }
    f32x4 vn[4];
    { const f32x4* xr = (const f32x4*)(X + ((size_t)b * SEQ + wi) * DM) + 2 * lane;
#pragma unroll
      for (int j = 0; j < 2; ++j) { vn[2 * j] = xr[128 * j]; vn[2 * j + 1] = xr[128 * j + 1]; } }
    for (int t = wi; t < SEQ; t += wpb) {
        const size_t m = (size_t)b * SEQ + t;
        f32x4 v[4]; float s = 0.f;
#pragma unroll
        for (int j = 0; j < 4; ++j) { v[j] = vn[j]; s += (v[j].x * v[j].x + v[j].y * v[j].y) + (v[j].z * v[j].z + v[j].w * v[j].w); }
        if (t + wpb < SEQ) { const f32x4* xr = (const f32x4*)(X + (m + wpb) * DM) + 2 * lane;
#pragma unroll
            for (int j = 0; j < 2; ++j) { vn[2 * j] = xr[128 * j]; vn[2 * j + 1] = xr[128 * j + 1]; } }
        const float rstd = rsqrtf(wave_sum_dpp(s) * (1.f / DM) + RMS_EPS);
        float amax = 0.f;
#pragma unroll
        for (int q = 0; q < 4; ++q) {
            v[q].x = v[q].x * rstd * mg[q].x + sh[q].x; v[q].y = v[q].y * rstd * mg[q].y + sh[q].y; v[q].z = v[q].z * rstd * mg[q].z + sh[q].z; v[q].w = v[q].w * rstd * mg[q].w + sh[q].w;
            amax = fmaxf(fmaxf(amax, fmaxf(fabsf(v[q].x), fabsf(v[q].y))), fmaxf(fabsf(v[q].z), fabsf(v[q].w)));
        }
        u32x4* o16 = (u32x4*)(O + m * DM) + lane;
#pragma unroll
        for (int j = 0; j < 2; ++j) o16[64 * j] = u32x4{cvt_pk(v[2 * j].x, v[2 * j].y), cvt_pk(v[2 * j].z, v[2 * j].w), cvt_pk(v[2 * j + 1].x, v[2 * j + 1].y), cvt_pk(v[2 * j + 1].z, v[2 * j + 1].w)};
        amax = wave_max_dpp(amax);
        const float inv = (amax > 0.f) ? 127.f / amax : 0.f;
        u32x2* q8 = (u32x2*)(Q + m * DM) + lane;
#pragma unroll
        for (int j = 0; j < 2; ++j) { unsigned pk[2];
#pragma unroll
            for (int d = 0; d < 2; ++d) { const f32x4 tt = v[2 * j + d]; const int q0 = (int)rintf(tt.x * inv), q1 = (int)rintf(tt.y * inv), q2 = (int)rintf(tt.z * inv), q3 = (int)rintf(tt.w * inv);
                pk[d] = ((unsigned)q0 & 0xffu) | (((unsigned)q1 & 0xffu) << 8) | (((unsigned)q2 & 0xffu) << 16) | (((unsigned)q3 & 0xffu) << 24); }
            q8[64 * j] = u32x2{pk[0], pk[1]}; }
        if (lane == 0) SA[m] = (amax > 0.f) ? amax * (1.f / 127.f) : 1.f;
    }
}

typedef const pg8::f32x4 (&AccRef)[2][2][4][2];

template <bool I8> struct EpiProj {
    static constexpr bool PERM = true, AFTER_DRAIN = false;
    unsigned char* ws; const float *g_q_a, *g_ks_a, *g_kw_a, *g_q_b, *g_k_b;
    __device__ __forceinline__ void operator()(AccRef acc_c, const pg8::Unit& u, int wr, int wc, int fr, int fq) const {
        const int T = I8 ? tmap_i8(u.pn) : tmap_bf(u.pn), row0 = u.pm * 256 + wr * 64 + fr, b = (u.pm * 256) >> 11;
        pg8::f32x4 (&acc)[2][2][4][2] = const_cast<pg8::f32x4 (&)[2][2][4][2]>(acc_c);
        if (I8) {
            const float* SA = (const float*)(ws + WS_SA1); const float* SB = (const float*)(ws + WS_SBWIN) + u.pn * 256 + wc * 32 + 8 * fq;
            f32x4 sb[2][2];
#pragma unroll
            for (int bj = 0; bj < 2; ++bj)
#pragma unroll
                for (int n = 0; n < 2; ++n) sb[bj][n] = *(const f32x4*)(SB + bj * 128 + 4 * n);
#pragma unroll
            for (int ai = 0; ai < 2; ++ai)
#pragma unroll
                for (int m = 0; m < 4; ++m) { const float sa = SA[row0 + ai * 128 + m * 16];
#pragma unroll
                    for (int bj = 0; bj < 2; ++bj)
#pragma unroll
                        for (int n = 0; n < 2; ++n) { acc[ai][bj][m][n][0] *= sa * sb[bj][n].x; acc[ai][bj][m][n][1] *= sa * sb[bj][n].y; acc[ai][bj][m][n][2] *= sa * sb[bj][n].z; acc[ai][bj][m][n][3] *= sa * sb[bj][n].w; } }
        }
        if (T >= 10) {
            unsigned char* G = ws + (T >= 14 ? WS_GB : WS_GA); const int cbase = ((T - 10) & 3) * 256 + wc * 32 + 8 * fq;
#pragma unroll
            for (int ai = 0; ai < 2; ++ai)
#pragma unroll
                for (int m = 0; m < 4; ++m) { const size_t row = row0 + ai * 128 + m * 16;
#pragma unroll
                    for (int bj = 0; bj < 2; ++bj) { const pg8::f32x4 v0 = acc[ai][bj][m][0], v1 = acc[ai][bj][m][1];
                        int w0 = __builtin_amdgcn_cvt_pk_fp8_f32(256.f * sigmoidf_(v0[0]), 256.f * sigmoidf_(v0[1]), 0, false); w0 = __builtin_amdgcn_cvt_pk_fp8_f32(256.f * sigmoidf_(v0[2]), 256.f * sigmoidf_(v0[3]), w0, true);
                        int w1 = __builtin_amdgcn_cvt_pk_fp8_f32(256.f * sigmoidf_(v1[0]), 256.f * sigmoidf_(v1[1]), 0, false); w1 = __builtin_amdgcn_cvt_pk_fp8_f32(256.f * sigmoidf_(v1[2]), 256.f * sigmoidf_(v1[3]), w1, true);
                        *(u32x2*)(G + row * 1024 + cbase + bj * 128) = u32x2{(unsigned)w0, (unsigned)w1}; } }
            return;
        }
        const int slot = wc;
        if (T == 7 && slot == 3) {
            float* GN = (float*)(ws + WS_GN); float* IW = (float*)(ws + WS_IW);
#pragma unroll
            for (int ai = 0; ai < 2; ++ai)
#pragma unroll
                for (int m = 0; m < 4; ++m) { const size_t row = row0 + ai * 128 + m * 16; const pg8::f32x4 v0 = acc[ai][0][m][0], v1 = acc[ai][0][m][1];
                    if (fq < 3) { f32x4 a0 = {sigmoidf_(v0[0]), sigmoidf_(v0[1]), sigmoidf_(v0[2]), sigmoidf_(v0[3])}, a1 = {sigmoidf_(v1[0]), sigmoidf_(v1[1]), sigmoidf_(v1[2]), sigmoidf_(v1[3])};
                        *(f32x4*)(GN + row * 24 + 8 * fq) = a0; *(f32x4*)(GN + row * 24 + 8 * fq + 4) = a1; }
                    else { const float s = 0.35355339059327373f; f32x4 a0 = {v0[0] * s, v0[1] * s, v0[2] * s, v0[3] * s}, a1 = {v1[0] * s, v1[1] * s, v1[2] * s, v1[3] * s};
                        *(f32x4*)(IW + row * 8) = a0; *(f32x4*)(IW + row * 8 + 4) = a1; } }
            return;
        }
        const float* gain = nullptr; float scale = 1.f; bf16* dst; size_t pitch, extra;
        switch (T) {
            case 0: case 1: gain = g_q_a; scale = QSCALE; dst = (bf16*)(ws + WS_QA); pitch = 512; extra = (size_t)(T * 4 + slot) * 64; break;
            case 5: case 6: gain = g_q_b; scale = QSCALE; dst = (bf16*)(ws + WS_QB); pitch = 512; extra = (size_t)((T - 5) * 4 + slot) * 64; break;
            case 8: case 9: scale = 0.125f; dst = (bf16*)(ws + WS_IQ); pitch = 512; extra = (size_t)((T - 8) * 4 + slot) * 64; break;
            case 2: dst = (bf16*)(ws + (slot < 2 ? WS_KC : WS_VC)); pitch = 64; extra = (size_t)(b + (slot & 1)) * SEQ * 64; break;
            case 3: if (slot < 2) gain = g_ks_a; dst = (bf16*)(ws + (slot < 2 ? WS_KS : WS_VS)); pitch = 64; extra = (size_t)(b + (slot & 1)) * SEQ * 64; break;
            case 4: if (slot < 2) gain = g_kw_a; dst = (bf16*)(ws + (slot < 2 ? WS_KW : WS_VW)); pitch = 64; extra = (size_t)(b + (slot & 1)) * SEQ * 64; break;
            default: if (slot == 0) gain = g_k_b; dst = (bf16*)(ws + (slot == 0 ? WS_KB : (slot == 1 ? WS_VB : WS_IK))); pitch = 64; extra = 0; break;
        }
        const int vidx = ((T == 3 || T == 4) && slot >= 2) ? (T - 2) : ((T == 7 && slot == 1) ? 3 : -1);
        float vmx = 0.f;
        float gv[2][8];
#pragma unroll
        for (int bj = 0; bj < 2; ++bj)
#pragma unroll
            for (int e = 0; e < 8; ++e) gv[bj][e] = gain ? gain[32 * bj + 8 * fq + e] * scale : scale;
#pragma unroll
        for (int ai = 0; ai < 2; ++ai)
#pragma unroll
            for (int m = 0; m < 4; ++m) { const size_t row = row0 + ai * 128 + m * 16;
                float rstd = 1.f;
                if (gain) { float ss = 0.f;
#pragma unroll
                    for (int bj = 0; bj < 2; ++bj)
#pragma unroll
                        for (int n = 0; n < 2; ++n) { const pg8::f32x4 v = acc[ai][bj][m][n]; ss += (v[0] * v[0] + v[1] * v[1]) + (v[2] * v[2] + v[3] * v[3]); }
                    ss += __shfl_xor(ss, 16); ss += __shfl_xor(ss, 32);
                    rstd = rsqrtf(ss * (1.f / 64.f) + RMS_EPS); }
#pragma unroll
                for (int bj = 0; bj < 2; ++bj) { const pg8::f32x4 v0 = acc[ai][bj][m][0], v1 = acc[ai][bj][m][1]; u32x4 w;
                    w.x = cvt_pk(v0[0] * rstd * gv[bj][0], v0[1] * rstd * gv[bj][1]); w.y = cvt_pk(v0[2] * rstd * gv[bj][2], v0[3] * rstd * gv[bj][3]);
                    w.z = cvt_pk(v1[0] * rstd * gv[bj][4], v1[1] * rstd * gv[bj][5]); w.w = cvt_pk(v1[2] * rstd * gv[bj][6], v1[3] * rstd * gv[bj][7]);
                    if (vidx >= 0) vmx = fmaxf(fmaxf(fmaxf(vmx, fmaxf(fabsf(v0[0]), fabsf(v0[1]))), fmaxf(fabsf(v0[2]), fabsf(v0[3]))), fmaxf(fmaxf(fabsf(v1[0]), fabsf(v1[1])), fmaxf(fabsf(v1[2]), fabsf(v1[3]))));
                    *(u32x4*)(dst + row * pitch + extra + 32 * bj + 8 * fq) = w; } }
        if (vidx >= 0) { vmx = wave_max_dpp(vmx) * 1.004f; if ((threadIdx.x & 63) == 0) atomicMax((unsigned*)(ws + WS_VMAX) + vidx, __float_as_uint(vmx)); }
    }
};

template <bool SECOND> struct EpiY {
    static constexpr bool PERM = true, AFTER_DRAIN = false;
    const unsigned char* G; bf16* Y; unsigned char* Y8; const float* rna; const float* rnb; const float* wn; float so; const float* sbw;
    __device__ __forceinline__ void operator()(AccRef acc, const pg8::Unit& u, int wr, int wc, int fr, int fq) const {
        const int row0 = u.pm * 256 + wr * 64 + fr, col0 = u.pn * 256 + wc * 32 + 8 * fq;
        float cs[2][8];
#pragma unroll
        for (int bj = 0; bj < 2; ++bj) { const f32x4 c0 = *(const f32x4*)(sbw + col0 + bj * 128), c1 = *(const f32x4*)(sbw + col0 + bj * 128 + 4);
            const float so_ = so * (1.f / 256.f);
            cs[bj][0] = c0.x * so_; cs[bj][1] = c0.y * so_; cs[bj][2] = c0.z * so_; cs[bj][3] = c0.w * so_; cs[bj][4] = c1.x * so_; cs[bj][5] = c1.y * so_; cs[bj][6] = c1.z * so_; cs[bj][7] = c1.w * so_; }
        const float wa = wn[2], wb = wn[3];
        const unsigned gb0 = (unsigned)row0 * 2048u + (unsigned)col0 * 2u;
        u32x2 gq[2][2][2], yq[2][2]; float ra[2], rb[2]; u32x2 o8[2][2];
        unsigned char* YA = (unsigned char*)Y;
#define EPIY_ROW(qd, mm) ((unsigned)(((qd) >> 1) * 128 + (((qd) & 1) * 2 + (mm)) * 16))
#define EPIY_LOAD(qd, B) { _Pragma("unroll") for (int mm = 0; mm < 2; ++mm) { const unsigned rr = EPIY_ROW(qd, mm); \
            _Pragma("unroll") for (int bj = 0; bj < 2; ++bj) gq[B][mm][bj] = *(const u32x2*)(G + ((gb0 + rr * 2048u + (unsigned)bj * 256u) >> 1)); } }
#define EPIY_LOADY(qd) { _Pragma("unroll") for (int mm = 0; mm < 2; ++mm) { const unsigned rr = EPIY_ROW(qd, mm); \
            ra[mm] = *(const float*)((const char*)rna + ((unsigned)row0 + rr) * 4u); rb[mm] = *(const float*)((const char*)rnb + ((unsigned)row0 + rr) * 4u); \
            if (SECOND) { _Pragma("unroll") for (int bj = 0; bj < 2; ++bj) yq[mm][bj] = *(const u32x2*)(YA + ((gb0 + rr * 2048u + (unsigned)bj * 256u) >> 1)); } } }
#define EPIY_COMPUTE(qd, B) { typedef float f32x2g __attribute__((ext_vector_type(2))); _Pragma("unroll") for (int mm = 0; mm < 2; ++mm) { const float is_ = __builtin_amdgcn_rcpf(sy_scale(ra[mm], rb[mm], wa, wb)); \
            _Pragma("unroll") for (int bj = 0; bj < 2; ++bj) { \
            const u32x2 g2 = gq[B][mm][bj]; u32x2 y2 = {0u, 0u}; if (SECOND) y2 = yq[mm][bj]; \
            const f32x2g ga_ = __builtin_amdgcn_cvt_pk_f32_fp8((int)g2.x, false), gb_ = __builtin_amdgcn_cvt_pk_f32_fp8((int)g2.x, true), gc_ = __builtin_amdgcn_cvt_pk_f32_fp8((int)g2.y, false), gd_ = __builtin_amdgcn_cvt_pk_f32_fp8((int)g2.y, true); \
            const f32x2g ya_ = __builtin_amdgcn_cvt_pk_f32_fp8((int)y2.x, false), yb_ = __builtin_amdgcn_cvt_pk_f32_fp8((int)y2.x, true), yc_ = __builtin_amdgcn_cvt_pk_f32_fp8((int)y2.y, false), yd_ = __builtin_amdgcn_cvt_pk_f32_fp8((int)y2.y, true); \
            const float gf[8] = {ga_.x, ga_.y, gb_.x, gb_.y, gc_.x, gc_.y, gd_.x, gd_.y}, yf[8] = {ya_.x, ya_.y, yb_.x, yb_.y, yc_.x, yc_.y, yd_.x, yd_.y}; \
            const pg8::f32x4 v0 = acc[(qd) >> 1][bj][((qd) & 1) * 2 + mm][0], v1 = acc[(qd) >> 1][bj][((qd) & 1) * 2 + mm][1]; float r[8]; \
            _Pragma("unroll") for (int e = 0; e < 8; ++e) { const float a_ = ((e < 4) ? v0[e] : v1[e - 4]) * cs[bj][e]; \
                r[e] = gf[e] * a_ * is_ + (SECOND ? yf[e] : 0.f); }       \
            int w0 = __builtin_amdgcn_cvt_pk_fp8_f32(r[0], r[1], 0, false); w0 = __builtin_amdgcn_cvt_pk_fp8_f32(r[2], r[3], w0, true); \
            int w1 = __builtin_amdgcn_cvt_pk_fp8_f32(r[4], r[5], 0, false); w1 = __builtin_amdgcn_cvt_pk_fp8_f32(r[6], r[7], w1, true); \
            o8[mm][bj] = u32x2{(unsigned)w0, (unsigned)w1}; } } \
        asm volatile("" :: "v"(o8[0][0]), "v"(o8[0][1]), "v"(o8[1][0]), "v"(o8[1][1]) : "memory"); }
#define EPIY_STORE(qd) { _Pragma("unroll") for (int mm = 0; mm < 2; ++mm) _Pragma("unroll") for (int bj = 0; bj < 2; ++bj) { const unsigned ob = (gb0 + EPIY_ROW(qd, mm) * 2048u + (unsigned)bj * 256u) >> 1; \
            *(u32x2*)((SECOND ? Y8 : YA) + ob) = o8[mm][bj]; } }
        EPIY_LOAD(0, 0) EPIY_LOAD(1, 1) EPIY_LOADY(0)
        EPIY_COMPUTE(0, 0) EPIY_LOAD(2, 0) EPIY_LOADY(1) EPIY_STORE(0)
        EPIY_COMPUTE(1, 1) EPIY_LOAD(3, 1) EPIY_LOADY(2) EPIY_STORE(1)
        EPIY_COMPUTE(2, 0) EPIY_LOADY(3) EPIY_STORE(2)
        EPIY_COMPUTE(3, 1) EPIY_STORE(3)
#undef EPIY_ROW
#undef EPIY_LOAD
#undef EPIY_LOADY
#undef EPIY_COMPUTE
#undef EPIY_STORE
    }
};

struct EpiX1 {
    static constexpr bool PERM = true, AFTER_DRAIN = false;
    const float* X; bf16* X1B; float* rowss; const float* mod; const float* rna; const float* rnb; const float* wn; const float* SBO;
    __device__ __forceinline__ void operator()(AccRef acc, const pg8::Unit& u, int wr, int wc, int fr, int fq) const {
        const int row0 = u.pm * 256 + wr * 64 + fr, col0 = u.pn * 256 + wc * 32 + 8 * fq, b = (u.pm * 256) >> 11;
        f32x4 gt[2][2];
#pragma unroll
        for (int bj = 0; bj < 2; ++bj)
#pragma unroll
            for (int n = 0; n < 2; ++n) { const f32x4 g = *(const f32x4*)(mod + b * NADA + 2 * DM + col0 + bj * 128 + 4 * n), sb = *(const f32x4*)(SBO + col0 + bj * 128 + 4 * n);
                gt[bj][n] = f32x4{g.x * sb.x, g.y * sb.y, g.z * sb.z, g.w * sb.w}; }
        const float wa = wn[2], wb = wn[3];
#pragma unroll
        for (int ai = 0; ai < 2; ++ai)
#pragma unroll
            for (int m = 0; m < 4; ++m) { const size_t row = row0 + ai * 128 + m * 16; float ss = 0.f; const float sy = sy_scale(rna[row], rnb[row], wa, wb);
#pragma unroll
                for (int bj = 0; bj < 2; ++bj) { const size_t off = row * 1024 + col0 + bj * 128; float x1[8];
#pragma unroll
                    for (int n = 0; n < 2; ++n) { const f32x4 xv = *(const f32x4*)(X + off + 4 * n); pg8::f32x4 v = acc[ai][bj][m][n]; v[0] *= sy; v[1] *= sy; v[2] *= sy; v[3] *= sy;
                        x1[4 * n] = xv.x + gt[bj][n].x * v[0]; x1[4 * n + 1] = xv.y + gt[bj][n].y * v[1]; x1[4 * n + 2] = xv.z + gt[bj][n].z * v[2]; x1[4 * n + 3] = xv.w + gt[bj][n].w * v[3]; }
#pragma unroll
                    for (int e2 = 0; e2 < 8; ++e2) ss += x1[e2] * x1[e2];
                    u32x4 w1; w1.x = cvt_pk(x1[0], x1[1]); w1.y = cvt_pk(x1[2], x1[3]); w1.z = cvt_pk(x1[4], x1[5]); w1.w = cvt_pk(x1[6], x1[7]);
                    *(u32x4*)(X1B + off) = w1; }
                ss += __shfl_xor(ss, 16); ss += __shfl_xor(ss, 32);
                if (fq == 0) unsafeAtomicAdd(rowss + row, ss); }
    }
};

struct EpiOut {
    static constexpr bool PERM = true, AFTER_DRAIN = false;
    const bf16* X1B; float* OUT; const float* mod; const float* SACT; const float* SBD;
    __device__ __forceinline__ void operator()(AccRef acc, const pg8::Unit& u, int wr, int wc, int fr, int fq) const {
        const int row0 = u.pm * 256 + wr * 64 + fr, col0 = u.pn * 256 + wc * 32 + 8 * fq, b = (u.pm * 256) >> 11;
        f32x4 gt[2][2];
#pragma unroll
        for (int bj = 0; bj < 2; ++bj)
#pragma unroll
            for (int n = 0; n < 2; ++n) { const f32x4 g = *(const f32x4*)(mod + b * NADA + 5 * DM + col0 + bj * 128 + 4 * n), sb = *(const f32x4*)(SBD + col0 + bj * 128 + 4 * n);
                gt[bj][n] = f32x4{g.x * sb.x, g.y * sb.y, g.z * sb.z, g.w * sb.w}; }
#pragma unroll
        for (int ai = 0; ai < 2; ++ai)
#pragma unroll
            for (int m = 0; m < 4; ++m) { const size_t row = row0 + ai * 128 + m * 16; const float sa = SACT[row];
#pragma unroll
                for (int bj = 0; bj < 2; ++bj) { const size_t off = row * 1024 + col0 + bj * 128;
                    const u32x4 xq = *(const u32x4*)(X1B + off); const unsigned xw[4] = {xq.x, xq.y, xq.z, xq.w};
#pragma unroll
                    for (int n = 0; n < 2; ++n) { pg8::f32x4 v = acc[ai][bj][m][n]; v[0] *= sa; v[1] *= sa; v[2] *= sa; v[3] *= sa;
                        const float x0 = __uint_as_float(xw[2 * n] << 16), x1 = __uint_as_float(xw[2 * n] & 0xffff0000u), x2 = __uint_as_float(xw[2 * n + 1] << 16), x3 = __uint_as_float(xw[2 * n + 1] & 0xffff0000u);
                        f32x4 o = {x0 + gt[bj][n].x * v[0], x1 + gt[bj][n].y * v[1], x2 + gt[bj][n].z * v[2], x3 + gt[bj][n].w * v[3]};
                        *(f32x4*)(OUT + off + 4 * n) = o; } } }
    }
};

struct PairOrder {
    pg8::StaticOrder base;
    __device__ __forceinline__ void init(int G, int c) { base.init(MROWS, DM, G, c); }
    __device__ __forceinline__ bool next(int i, pg8::Unit& u) const { if (!base.next(i >> 1, u)) return false; if (i & 1) { u.pm += 256; u.pn += 4; } return true; }
    __device__ __forceinline__ void a_ready(const pg8::Unit&) const {}
    __device__ __forceinline__ void done(const pg8::Unit&) const {}
};
struct EpiYPair {
    static constexpr bool PERM = true, AFTER_DRAIN = false;
    const unsigned char* GA; const unsigned char* GB; bf16* Y; unsigned char* Y8; const float* rna; const float* rnb; const float* wn; const float* vm; const float* sbwo;
    __device__ __forceinline__ void operator()(AccRef acc, const pg8::Unit& u, int wr, int wc, int fr, int fq) const {
        if (u.pm < 256) { EpiY<false> E{GA, Y, Y8, rna, rnb, wn, so_scale_a(vm), sbwo}; E(acc, u, wr, wc, fr, fq); }
        else { pg8::Unit v; v.pm = u.pm - 256; v.pn = u.pn - 4; EpiY<true> E{GB, Y, Y8, rna, rnb, wn, so_scale_b(vm), sbwo + 1024}; E(acc, v, wr, wc, fr, fq); }
    }
};

struct EpiAct3 {
    static constexpr bool PERM = true, AFTER_DRAIN = false, KEEPS = false;
    unsigned char* ACT; const float* SA; const float* SB; const float* SACT;
    __device__ __forceinline__ void operator()(AccRef acc, const pg8::Unit& u, int wr, int wc, int fr, int fq) const {
        const int row0 = u.pm * 256 + wr * 64 + fr, col0 = u.pn * 128 + wc * 32 + 8 * fq;
        const float* sb = SB + u.pn * 256 + wc * 32 + 8 * fq;
        const f32x4 g0 = *(const f32x4*)(sb), g1 = *(const f32x4*)(sb + 4), u0 = *(const f32x4*)(sb + 128), u1 = *(const f32x4*)(sb + 132);
        const float sg[8] = {g0.x, g0.y, g0.z, g0.w, g1.x, g1.y, g1.z, g1.w}, su[8] = {u0.x, u0.y, u0.z, u0.w, u1.x, u1.y, u1.z, u1.w};
#pragma unroll
        for (int ai = 0; ai < 2; ++ai)
#pragma unroll
            for (int m = 0; m < 4; ++m) { const size_t row = row0 + ai * 128 + m * 16; float r[8]; const float sa = SA[row], ia = __builtin_amdgcn_rcpf(SACT[row]);
#pragma unroll
                for (int n = 0; n < 2; ++n)
#pragma unroll
                    for (int e = 0; e < 4; ++e) { const float g = acc[ai][0][m][n][e] * (sa * sg[4 * n + e]), up = acc[ai][1][m][n][e] * (sa * su[4 * n + e]); r[4 * n + e] = siluf_(g) * (up * ia); }
                int w0 = __builtin_amdgcn_cvt_pk_fp8_f32(r[0], r[1], 0, false); w0 = __builtin_amdgcn_cvt_pk_fp8_f32(r[2], r[3], w0, true);
                int w1 = __builtin_amdgcn_cvt_pk_fp8_f32(r[4], r[5], 0, false); w1 = __builtin_amdgcn_cvt_pk_fp8_f32(r[6], r[7], w1, true);
                *(u32x2*)(ACT + row * DFF + col0) = u32x2{(unsigned)w0, (unsigned)w1}; }
    }
};


#define MFMA32(a, b, c) __builtin_amdgcn_mfma_f32_32x32x16_bf16(a, b, c, 0, 0, 0)
#define LDS_BARRIER() asm volatile("s_waitcnt lgkmcnt(0)\n\ts_barrier" ::: "memory")
__device__ __forceinline__ int crow(int r, int hi) { return (r & 3) + 8 * (r >> 2) + 4 * hi; }

__device__ __forceinline__ void compress_phase(const Args& a, LAS unsigned char* lds) {
    const int tid = threadIdx.x, lane = tid & 63, wave = __builtin_amdgcn_readfirstlane(tid >> 6), r32 = lane & 31, hi = lane >> 5;
    unsigned char* ws = a.ws;
    constexpr int PITCH = 528, A_OFF = 0, B_OFF = 64 * PITCH;
    LAS float* hid = (LAS float*)lds;
    for (int u = blockIdx.x; u < 256; u += gridDim.x) {
        const int which = u >> 7, bg = (u >> 1) & 63, n0 = (u & 1) * 64;
        const bf16* A = (const bf16*)(ws + (which ? WS_VC : WS_KC)) + ((size_t)bg * SEQ + (size_t)n0 * 16) * 64;
        const bf16* W1 = (const bf16*)(ws + (which ? WS_WCV1 : WS_WCK1));
        const int rb = wave & 1, cb = wave >> 1;
        f32x16 acc = {};
        u32x4 ra[4], rw[8];
#pragma unroll
        for (int i = 0; i < 4; ++i) { const int p = tid + 512 * i, row = p >> 5, c = p & 31; ra[i] = *(const u32x4*)(A + (size_t)row * 1024 + c * 8); }
#pragma unroll
        for (int i = 0; i < 8; ++i) { const int p = tid + 512 * i, row = p >> 5, c = p & 31; rw[i] = *(const u32x4*)(W1 + (size_t)row * 2048 + c * 8); }
        for (int kc = 0; kc < 8; ++kc) {
            __syncthreads();
#pragma unroll
            for (int i = 0; i < 4; ++i) { const int p = tid + 512 * i, row = p >> 5, c = p & 31; *(LAS u32x4*)(lds + A_OFF + row * PITCH + c * 16) = ra[i]; }
#pragma unroll
            for (int i = 0; i < 8; ++i) { const int p = tid + 512 * i, row = p >> 5, c = p & 31; *(LAS u32x4*)(lds + B_OFF + row * PITCH + c * 16) = rw[i]; }
            if (kc < 7) {
#pragma unroll
                for (int i = 0; i < 4; ++i) { const int p = tid + 512 * i, row = p >> 5, c = p & 31; ra[i] = *(const u32x4*)(A + (size_t)row * 1024 + (kc + 1) * 256 + c * 8); }
#pragma unroll
                for (int i = 0; i < 8; ++i) { const int p = tid + 512 * i, row = p >> 5, c = p & 31; rw[i] = *(const u32x4*)(W1 + (size_t)row * 2048 + (kc + 1) * 256 + c * 8); }
            }
            LDS_BARRIER();
            const LAS unsigned char* ap = lds + A_OFF + (rb * 32 + r32) * PITCH + hi * 16;
            const LAS unsigned char* bp = lds + B_OFF + (cb * 32 + r32) * PITCH + hi * 16;
#pragma unroll
            for (int ks = 0; ks < 16; ++ks) acc = MFMA32(*(const LAS bf16x8*)(ap + ks * 32), *(const LAS bf16x8*)(bp + ks * 32), acc);
        }
        __syncthreads();
        { float bias = 0.f;
#pragma unroll
          for (int q = 0; q < 8; ++q) bias += ((const float*)(ws + WS_BIAS))[(which * 8 + q) * 128 + cb * 32 + r32];
#pragma unroll
          for (int r = 0; r < 16; ++r) hid[(rb * 32 + crow(r, hi)) * 132 + cb * 32 + r32] = siluf_(acc[r] + bias); }
        __syncthreads();
        { const int row = tid >> 3, dc = (tid & 7) * 8; const float* w2 = a.in[which ? I_WCV2 : I_WCK2];
          float o[8];
#pragma unroll
          for (int j = 0; j < 8; ++j) o[j] = 0.f;
#pragma unroll 8
          for (int k = 0; k < 128; ++k) { const float h = hid[row * 132 + k]; const f32x4 wa = *(const f32x4*)(w2 + k * 64 + dc), wb = *(const f32x4*)(w2 + k * 64 + dc + 4);
              o[0] += h * wa.x; o[1] += h * wa.y; o[2] += h * wa.z; o[3] += h * wa.w; o[4] += h * wb.x; o[5] += h * wb.y; o[6] += h * wb.z; o[7] += h * wb.w; }
          if (!which) { float ss = 0.f;
#pragma unroll
              for (int j = 0; j < 8; ++j) ss += o[j] * o[j];
              ss += __shfl_xor(ss, 1); ss += __shfl_xor(ss, 2); ss += __shfl_xor(ss, 4);
              const float rstd = rsqrtf(ss * (1.f / 64.f) + RMS_EPS); const float* gk = a.in[I_GKC];
#pragma unroll
              for (int j = 0; j < 8; ++j) o[j] = o[j] * rstd * gk[dc + j]; }
          const int n = n0 + row;
          if (n >= 127) {
#pragma unroll
              for (int j = 0; j < 8; ++j) o[j] = 0.f; }
          u32x4 w; w.x = cvt_pk(o[0], o[1]); w.y = cvt_pk(o[2], o[3]); w.z = cvt_pk(o[4], o[5]); w.w = cvt_pk(o[6], o[7]);
          if (which) { float vmx = 0.f;
#pragma unroll
              for (int j = 0; j < 8; ++j) vmx = fmaxf(vmx, fabsf(o[j]));
              vmx = wave_max_dpp(vmx) * 1.004f; if (lane == 0) atomicMax((unsigned*)(ws + WS_VMAX), __float_as_uint(vmx)); }
          *(u32x4*)((bf16*)(ws + (which ? WS_VCO : WS_KCO)) + ((size_t)bg * 128 + n) * 64 + dc) = w; }
    }
    __syncthreads();
}

typedef LAS const char* lds_cptr;
__device__ __forceinline__ s16x4 vtr(lds_cptr p) { return __builtin_bit_cast(s16x4, __builtin_amdgcn_ds_read_tr16_b64_v4i16((LAS v4i16_t*)p)); }

struct FlashSt { f32x16 o0, o1; float m, l; };

__device__ __forceinline__ void flash_init(FlashSt& st) { st.o0 = f32x16{}; st.o1 = f32x16{}; st.m = -INFINITY; st.l = 0.f; }

__device__ __forceinline__ void tile_gload(const bf16* __restrict__ Kb, const bf16* __restrict__ Vb, int key0, int tid, u32x4& kr, u32x4& vr) {
    const size_t off = (size_t)(key0 + (tid >> 3)) * 64 + (tid & 7) * 8;
    kr = *(const u32x4*)(Kb + off); vr = *(const u32x4*)(Vb + off);
}
__device__ __forceinline__ void tile_lstore(LAS unsigned char* Kt, LAS unsigned char* Vt, int tid, const u32x4& kr, const u32x4& vr) {
    const int row = tid >> 3, c = tid & 7;
    *(LAS u32x4*)(Kt + c * 1024 + row * 16) = kr;
    *(LAS u32x4*)(Vt + (c >> 2) * 4096 + row * 64 + (c & 3) * 16) = vr;
}

typedef f32x16 CInit;
__device__ __forceinline__ CInit make_cinit(float sl, int hi) { CInit c;
#pragma unroll
    for (int r = 0; r < 16; ++r) c[r] = sl * (float)crow(r, hi);
    return c; }
__device__ __forceinline__ void qk_tile(lds_cptr Kt, const bf16x8 (&qr)[4], const CInit& cinit, f32x16& s0, f32x16& s1, int r32, int hi) {
    const lds_cptr kp = Kt + hi * 1024 + r32 * 16;
    { const bf16x8 k0 = *(const LAS bf16x8*)(kp), k1 = *(const LAS bf16x8*)(kp + 512); s0 = MFMA32(k0, qr[0], cinit); s1 = MFMA32(k1, qr[0], cinit); }
#pragma unroll
    for (int d0 = 1; d0 < 4; ++d0) {
        const bf16x8 k0 = *(const LAS bf16x8*)(kp + d0 * 2048), k1 = *(const LAS bf16x8*)(kp + d0 * 2048 + 512);
        s0 = MFMA32(k0, qr[d0], s0); s1 = MFMA32(k1, qr[d0], s1);
    }
}
__device__ __forceinline__ void pv_tile(lds_cptr Vt, const f32x16& p0, const f32x16& p1, f32x16& o0, f32x16& o1, int lane, int hi) {
    const lds_cptr vp = Vt + ((lane >> 4) & 1) * 32 + (lane & 3) * 8 + (4 * hi + ((lane & 15) >> 2)) * 64;
#pragma unroll
    for (int i = 0; i < 4; ++i) {
        const f32x16& P = (i < 2) ? p0 : p1; const int rb = (i & 1) * 8;
        u32x4 pw; pw.x = cvt_pk(P[rb + 0], P[rb + 1]); pw.y = cvt_pk(P[rb + 2], P[rb + 3]); pw.z = cvt_pk(P[rb + 4], P[rb + 5]); pw.w = cvt_pk(P[rb + 6], P[rb + 7]);
        const bf16x8 pf = __builtin_bit_cast(bf16x8, pw);
        const s16x4 a0 = vtr(vp + i * 1024), a1 = vtr(vp + i * 1024 + 512), b0 = vtr(vp + 4096 + i * 1024), b1 = vtr(vp + 4096 + i * 1024 + 512);
        const bf16x8 v0 = {a0[0], a0[1], a0[2], a0[3], a1[0], a1[1], a1[2], a1[3]}, v1 = {b0[0], b0[1], b0[2], b0[3], b1[0], b1[1], b1[2], b1[3]};
        o0 = MFMA32(v0, pf, o0); o1 = MFMA32(v1, pf, o1);
    }
}
template <bool MASKED, class VF>
__device__ __forceinline__ float flash_probs(lds_cptr Kt, const bf16x8 (&qr)[4], const CInit& cinit, float c32, float off, FlashSt& st, const VF& vf, int lane, f32x16& s0, f32x16& s1) {
    const int r32 = lane & 31, hi = lane >> 5;
    qk_tile(Kt, qr, cinit, s0, s1, r32, hi);
    if (MASKED) {
#pragma unroll
        for (int r = 0; r < 16; ++r) {
            const unsigned m0 = (unsigned)vf(r, 0), m1 = (unsigned)vf(r, 1);
            s0[r] = __uint_as_float((__float_as_uint(s0[r]) & m0) | (0xFF800000u & ~m0)); s1[r] = __uint_as_float((__float_as_uint(s1[r]) & m1) | (0xFF800000u & ~m1)); }
    }
    float m0 = fmaxf(s0[0], s0[1]), m1 = fmaxf(s1[0], s1[1]);
#pragma unroll
    for (int r = 2; r < 16; r += 2) { m0 = fmaxf(fmaxf(m0, s0[r]), s0[r + 1]); m1 = fmaxf(fmaxf(m1, s1[r]), s1[r + 1]); }
    float mx = fmaxf(m0, m1 + c32) + off;
    mx = fmaxf(mx, __shfl_xor(mx, 32));
    const float mnew = fmaxf(st.m, mx), msafe = (mnew == -INFINITY) ? 0.f : mnew;
    const float alpha = __builtin_amdgcn_exp2f(st.m - msafe);
    const float b0 = msafe - off, b1 = b0 - c32;
    { typedef float f32x2 __attribute__((ext_vector_type(2))); const f32x2 nb0 = {-b0, -b0}, nb1 = {-b1, -b1};
#pragma unroll
      for (int r = 0; r < 16; r += 2) { f32x2 a = {s0[r], s0[r + 1]}, c = {s1[r], s1[r + 1]}; a = a + nb0; c = c + nb1;
          s0[r] = __builtin_amdgcn_exp2f(a.x); s0[r + 1] = __builtin_amdgcn_exp2f(a.y); s1[r] = __builtin_amdgcn_exp2f(c.x); s1[r + 1] = __builtin_amdgcn_exp2f(c.y); } }
    float ps;
    { typedef float f32x8 __attribute__((ext_vector_type(8))); typedef float f32x2 __attribute__((ext_vector_type(2)));
      const f32x16 t16 = s0 + s1; const f32x8 t8 = t16.lo + t16.hi; const f32x4 t4 = t8.lo + t8.hi; const f32x2 t2 = t4.lo + t4.hi; ps = t2.x + t2.y; }
    st.l = st.l * alpha + ps; st.m = mnew;
    if (__any(alpha != 1.f)) {
#pragma unroll
        for (int r = 0; r < 16; ++r) { st.o0[r] *= alpha; st.o1[r] *= alpha; }
    }
    return msafe;
}
template <class TI>
__device__ __forceinline__ void flash_loop(const bf16* __restrict__ Kb, const bf16* __restrict__ Vb, int kt_lo, int kt_hi, unsigned long long tmask,
                                           const bf16x8 (&qr)[4], const CInit& cinit, float c32, FlashSt& st, const TI& ti, LAS unsigned char* lds, int tid) {
    const int lane = tid & 63;
    unsigned long long rem = tmask & ((kt_hi >= 63 ? ~0ull : ((1ull << (kt_hi + 1)) - 1ull)) & ~((1ull << kt_lo) - 1ull));
    rem = (unsigned long long)(unsigned)__builtin_amdgcn_readfirstlane((int)(unsigned)rem) | ((unsigned long long)(unsigned)__builtin_amdgcn_readfirstlane((int)(unsigned)(rem >> 32)) << 32);
    int left = __popcll(rem);
    auto pop = [&]() { const int k = 63 - (int)__builtin_clzll(rem); rem &= ~(1ull << k); return k; };
    auto compute = [&](int buf, int kt) {
        const lds_cptr Kt = (lds_cptr)(lds + buf * 8192), Vt = (lds_cptr)(lds + 16384 + buf * 8192);
        if (__all(ti.skipb(kt) < st.m - 40.f)) return;
        f32x16 s0, s1; const float off = ti.off(kt);
        if (ti.masked(kt)) { const auto pd = ti.prep(kt); (void)flash_probs<true>(Kt, qr, cinit, c32, off, st, [&](int r, int half) { return ti.valid(pd, r, half); }, lane, s0, s1); }
        else (void)flash_probs<false>(Kt, qr, cinit, c32, off, st, [](int, int) { return -1; }, lane, s0, s1);
        pv_tile(Vt, s0, s1, st.o0, st.o1, lane, lane >> 5);
    };
    if (left == 0) return;
    u32x4 krA, vrA, krB, vrB;
    int k0 = pop(), k1 = k0;
    tile_gload(Kb, Vb, k0 * 64, tid, krA, vrA);
    if (left >= 2) { k1 = pop(); tile_gload(Kb, Vb, k1 * 64, tid, krB, vrB); }
#pragma unroll 1
    while (left >= 4) {
        tile_lstore(lds, lds + 16384, tid, krA, vrA);
        LDS_BARRIER();
        const int k2 = pop(); tile_gload(Kb, Vb, k2 * 64, tid, krA, vrA);
        compute(0, k0);
        tile_lstore(lds + 8192, lds + 16384 + 8192, tid, krB, vrB);
        LDS_BARRIER();
        const int k3 = pop(); tile_gload(Kb, Vb, k3 * 64, tid, krB, vrB);
        compute(1, k1);
        k0 = k2; k1 = k3; left -= 2;
    }
    {
        int k2 = k0;
        tile_lstore(lds, lds + 16384, tid, krA, vrA);
        LDS_BARRIER();
        if (left == 3) { k2 = pop(); tile_gload(Kb, Vb, k2 * 64, tid, krA, vrA); }
        compute(0, k0);
        if (left >= 2) {
            tile_lstore(lds + 8192, lds + 16384 + 8192, tid, krB, vrB);
            LDS_BARRIER();
            compute(1, k1);
        }
        if (left == 3) {
            tile_lstore(lds, lds + 16384, tid, krA, vrA);
            LDS_BARRIER();
            compute(0, k2);
        }
    }
    LDS_BARRIER();
}
__device__ __forceinline__ void flash_finish(const FlashSt& st, float gate, f32x16& t0, f32x16& t1) {
    const float l = st.l + __shfl_xor(st.l, 32);
    const float f = (l > 0.f) ? gate / l : 0.f;
#pragma unroll
    for (int r = 0; r < 16; ++r) { t0[r] += f * st.o0[r]; t1[r] += f * st.o1[r]; }
}
__device__ __forceinline__ void store_o(unsigned char* __restrict__ O, size_t elem_off, const f32x16& t0, const f32x16& t1, int hi, float* __restrict__ rown, float so) {
    const float inv = __builtin_amdgcn_rcpf(so);
    { float ss = 0.f;
#pragma unroll
      for (int r = 0; r < 16; ++r) ss += t0[r] * t0[r] + t1[r] * t1[r];
      ss += __shfl_xor(ss, 32);
      if (hi == 0) unsafeAtomicAdd(rown, ss * 2.26f + 1.3e-4f * so * so); }
#pragma unroll
    for (int q = 0; q < 4; ++q) {
        int w0 = __builtin_amdgcn_cvt_pk_fp8_f32(t0[4 * q] * inv, t0[4 * q + 1] * inv, 0, false); w0 = __builtin_amdgcn_cvt_pk_fp8_f32(t0[4 * q + 2] * inv, t0[4 * q + 3] * inv, w0, true);
        int w1 = __builtin_amdgcn_cvt_pk_fp8_f32(t1[4 * q] * inv, t1[4 * q + 1] * inv, 0, false); w1 = __builtin_amdgcn_cvt_pk_fp8_f32(t1[4 * q + 2] * inv, t1[4 * q + 3] * inv, w1, true);
        *(unsigned*)(O + elem_off + 8 * q + 4 * hi) = (unsigned)w0; *(unsigned*)(O + elem_off + 32 + 8 * q + 4 * hi) = (unsigned)w1;
    }
}

constexpr int L_IMPA = 32768, L_IMPC = 65536, L_IMPF = 98304, L_FAC = 106496, L_SELM = 108544, L_UNION = 108544 + 256, L_IQL = 32768, L_MSK = 65536, L_IWL = 73728;

__device__ __forceinline__ void nsa_unit(const Args& a, LAS unsigned char* lds, int b, int g, int qt) {
    int tid_ = threadIdx.x; asm volatile("" : "+v"(tid_));
    const int tid = tid_, lane = tid & 63, wave = __builtin_amdgcn_readfirstlane(tid >> 6), r32 = lane & 31, hi = lane >> 5;
    unsigned char* ws = a.ws;
    const int rh = wave & 3, th = wave >> 2, head = g * 4 + rh, t0 = qt * 64, tl = th * 32 + r32, token = t0 + tl;
    const size_t row = (size_t)b * SEQ + token;
    bf16x8 qr[4];
#pragma unroll
    for (int d0 = 0; d0 < 4; ++d0) qr[d0] = *(const bf16x8*)((const bf16*)(ws + WS_QA) + row * 512 + head * 64 + 16 * d0 + 8 * hi);
    const float slope2 = __builtin_amdgcn_exp2f(-(float)(head + 1)) * LOG2E;
    const int tokl = tl + 0;
    const float* gn = (const float*)(ws + WS_GN) + row * 24 + head * 3;
    const float g_cmp = gn[0], g_slc = gn[1], g_win = gn[2];
    f32x16 tot0 = {}, tot1 = {};
    const size_t bgoff = ((size_t)(b * 2 + g)) * SEQ * 64;
    LAS float* impa = (LAS float*)(lds + L_IMPA); LAS float* impc = (LAS float*)(lds + L_IMPC); LAS float* impf = (LAS float*)(lds + L_IMPF); LAS float* facl = (LAS float*)(lds + L_FAC);
    LAS unsigned* selm = (LAS unsigned*)(lds + L_SELM); LAS unsigned* uni = (LAS unsigned*)(lds + L_UNION);

    REP(16) {
        tot0 = f32x16{}; tot1 = f32x16{};
        const bf16* Kc = (const bf16*)(ws + WS_KCO) + (size_t)(b * 2 + g) * 128 * 64; const bf16* Vc = (const bf16*)(ws + WS_VCO) + (size_t)(b * 2 + g) * 128 * 64;
        const bool two = (t0 + 63 - 31) / 16 >= 64;
        { u32x4 kr, vr; tile_gload(Kc, Vc, 0, tid, kr, vr); tile_lstore(lds, lds + 16384, tid, kr, vr);
          tile_gload(Kc, Vc, 64, tid, kr, vr); tile_lstore(lds + 8192, lds + 16384 + 8192, tid, kr, vr); }
        if (tid < 64) selm[tid] = 0u; if (tid == 64) *uni = 0u;
        __syncthreads();
        const int nv = (token >= 31) ? (token - 31) / 16 : -1;
        FlashSt st; flash_init(st);
        float ms0 = 0.f;
        const CInit cinitc = make_cinit(16.f * slope2, hi);
#pragma unroll
        for (int tile = 0; tile < 2; ++tile) {
            if (tile == 0 || two) {
                f32x16 s0, s1;
                const int lim = nv - 64 * tile - 4 * hi;
                auto vf = [=](int r, int half) { return ~((lim - ((r & 3) + 8 * (r >> 2) + 32 * half)) >> 31); };
                const float ms = flash_probs<true>((lds_cptr)(lds + tile * 8192), qr, cinitc, 512.f * slope2, 1024.f * slope2 * (float)tile, st, vf, lane, s0, s1);
                if (tile == 0) ms0 = ms;
#pragma unroll
                for (int blk = 0; blk < 2; ++blk) { const f32x16& P = blk ? s1 : s0;
#pragma unroll
                    for (int q = 0; q < 4; ++q) { const int uq = 16 * tile + 8 * blk + 2 * q + hi;
                        impa[(rh * 32 + uq) * 64 + tl] = (P[4 * q] + P[4 * q + 1]) + (P[4 * q + 2] + P[4 * q + 3]); impc[(rh * 32 + uq) * 64 + tl] = P[4 * q + 3]; } }
                pv_tile((lds_cptr)(lds + 16384 + tile * 8192), s0, s1, st.o0, st.o1, lane, hi);
            } else {
#pragma unroll
                for (int k = 0; k < 8; ++k) { const int uq = 16 + 2 * k + hi; impa[(rh * 32 + uq) * 64 + tl] = 0.f; impc[(rh * 32 + uq) * 64 + tl] = 0.f; }
            }
        }
        { const float l = st.l + __shfl_xor(st.l, 32), inv = (l > 0.f) ? 1.f / l : 0.f, mf = (st.m == -INFINITY) ? 0.f : st.m;
          if (hi == 0) { facl[(rh * 2 + 0) * 64 + tl] = __builtin_amdgcn_exp2f(ms0 - mf) * inv; facl[(rh * 2 + 1) * 64 + tl] = inv; } }
        flash_finish(st, g_cmp, tot0, tot1);
        __syncthreads();
        { const int tk = tid & 63, jg = tid >> 6;
#pragma unroll
          for (int jj = 0; jj < 4; ++jj) { const int j = jg * 4 + jj; float v = 0.f;
#pragma unroll
              for (int h4 = 0; h4 < 4; ++h4) { v += impa[(h4 * 32 + j) * 64 + tk] * facl[(h4 * 2 + (j >> 4)) * 64 + tk];
                  if (j > 0) v += impc[(h4 * 32 + j - 1) * 64 + tk] * facl[(h4 * 2 + ((j - 1) >> 4)) * 64 + tk]; }
              const bool forced = (j == 0) || (j == qt) || (j == qt - 1);
              v = forced ? 1e9f : ((j <= qt) ? v : -1e9f);
              impf[j * 64 + tk] = v; } }
        __syncthreads();
        { const int tk = tid & 63, jg = tid >> 6; unsigned bits = 0u;
#pragma unroll
          for (int jj = 0; jj < 4; ++jj) { const int j = jg * 4 + jj; const float v = impf[j * 64 + tk]; int rank = 0;
              for (int j2 = 0; j2 < 32; ++j2) { const float w = impf[j2 * 64 + tk]; rank += (w > v || (w == v && j2 < j)) ? 1 : 0; }
              if (rank < 16) bits |= 1u << j; }
          atomicOr((unsigned*)&selm[tk], bits); atomicOr((unsigned*)uni, bits); }
        __syncthreads();
    }
    const unsigned mysel = selm[tl]; const unsigned long long um = (unsigned long long)(*uni);
    LAS float* stash = (LAS float*)(lds + L_IMPA) + tid;
#pragma unroll
    for (int r = 0; r < 16; ++r) { stash[r * 512] = tot0[r]; stash[(16 + r) * 512] = tot1[r]; }
    const CInit cinit = make_cinit(slope2, hi);

    REP(17) {
        FlashSt st; flash_init(st);
        struct TI { int qt, lim; unsigned mysel; float sl64;
            __device__ __forceinline__ bool masked(int kt) const { return kt == qt; }
            __device__ __forceinline__ float off(int kt) const { return ((mysel >> kt) & 1u) ? sl64 * (float)kt : -INFINITY; }
            __device__ __forceinline__ float skipb(int) const { return INFINITY; }
            __device__ __forceinline__ int prep(int kt) const { return kt; }
            __device__ __forceinline__ int valid(int, int r, int half) const { return ~((lim - ((r & 3) + 8 * (r >> 2) + 32 * half)) >> 31); } };
        const TI ti{qt, tokl - 4 * hi, mysel, 64.f * slope2};
        flash_loop((const bf16*)(ws + WS_KS) + bgoff, (const bf16*)(ws + WS_VS) + bgoff, 0, qt, um, qr, cinit, 32.f * slope2, st, ti, lds, tid);
        f32x16 a0 = {}, a1 = {}; flash_finish(st, g_slc, a0, a1);
        if (rp_ == 0) {
#pragma unroll
        for (int r = 0; r < 16; ++r) { stash[r * 512] += a0[r]; stash[(16 + r) * 512] += a1[r]; } }
    }
    REP(18) {
        FlashSt st; flash_init(st);
        struct TI { int qt, lim; float sl64;
            __device__ __forceinline__ bool masked(int kt) const { return kt == qt || kt == qt - 8; }
            __device__ __forceinline__ float off(int kt) const { return sl64 * (float)kt; }
            __device__ __forceinline__ float skipb(int) const { return INFINITY; }
            __device__ __forceinline__ int prep(int kt) const { return kt; }
            __device__ __forceinline__ int valid(int kt, int r, int half) const { const int gt = (lim - ((r & 3) + 8 * (r >> 2) + 32 * half)) >> 31; return (kt == qt) ? ~gt : gt; } };
        const TI ti{qt, tokl - 4 * hi, 64.f * slope2};
        flash_loop((const bf16*)(ws + WS_KW) + bgoff, (const bf16*)(ws + WS_VW) + bgoff, (qt >= 8) ? qt - 8 : 0, qt, ~0ull, qr, cinit, 32.f * slope2, st, ti, lds, tid);
        f32x16 a0 = {}, a1 = {}; flash_finish(st, g_win, a0, a1);
#pragma unroll
        for (int r = 0; r < 16; ++r) { a0[r] += stash[r * 512]; a1[r] += stash[(16 + r) * 512]; }
        store_o(ws + WS_OA, row * 512 + head * 64, a0, a1, hi, (float*)(ws + WS_ROWNA) + row, so_scale_a((const float*)(ws + WS_VMAX)));
    }
}

__device__ __forceinline__ unsigned ordkey(float f) { f = f + 0.f; const unsigned u = __float_as_uint(f); return u ^ ((unsigned)((int)u >> 31) | 0x80000000u); }

__device__ __forceinline__ int wave_sum_i32(int x) {
    x += __builtin_amdgcn_update_dpp(0, x, 0x111, 0xf, 0xf, true);
    x += __builtin_amdgcn_update_dpp(0, x, 0x112, 0xf, 0xf, true);
    x += __builtin_amdgcn_update_dpp(0, x, 0x114, 0xf, 0xf, true);
    x += __builtin_amdgcn_update_dpp(0, x, 0x118, 0xf, 0xf, true);
    x += __builtin_amdgcn_update_dpp(0, x, 0x142, 0xa, 0xf, false);
    x += __builtin_amdgcn_update_dpp(0, x, 0x143, 0xc, 0xf, false);
    return __builtin_amdgcn_readlane(x, 63);
}
__device__ __forceinline__ unsigned wave_max_u32(unsigned x) {
    unsigned y;
    y = (unsigned)__builtin_amdgcn_update_dpp(0, (int)x, 0x111, 0xf, 0xf, true); x = x > y ? x : y;
    y = (unsigned)__builtin_amdgcn_update_dpp(0, (int)x, 0x112, 0xf, 0xf, true); x = x > y ? x : y;
    y = (unsigned)__builtin_amdgcn_update_dpp(0, (int)x, 0x114, 0xf, 0xf, true); x = x > y ? x : y;
    y = (unsigned)__builtin_amdgcn_update_dpp(0, (int)x, 0x118, 0xf, 0xf, true); x = x > y ? x : y;
    y = (unsigned)__builtin_amdgcn_update_dpp(0, (int)x, 0x142, 0xa, 0xf, false); x = x > y ? x : y;
    y = (unsigned)__builtin_amdgcn_update_dpp(0, (int)x, 0x143, 0xc, 0xf, false); x = x > y ? x : y;
    return (unsigned)__builtin_amdgcn_readlane((int)x, 63);
}
template <int NI>
__device__ __forceinline__ void dsa_select(const float* __restrict__ scr, LAS unsigned long long* msk, int wave, int lane, int t0, int nkt) {
    unsigned u[NI], un[NI];
    auto loadrow = [&](int tk, unsigned (&dst)[NI]) {
#pragma unroll
        for (int i = 0; i < NI; ++i) { const int ii = (i < nkt) ? i : 0; const float f = scr[(size_t)tk * 2048 + ii * 64 + lane]; dst[i] = (i < nkt) ? ordkey(f) : 0u; } };
    loadrow(wave * 4, un);
#pragma unroll 1
    for (int tq = 0; tq < 4; ++tq) {
        const int tk = wave * 4 + tq, tpos = t0 + tk;
#pragma unroll
        for (int i = 0; i < NI; ++i) u[i] = un[i];
        if (tq < 3) loadrow(tk + 1, un);
        if (tpos + 1 <= 256) {
#pragma unroll
            for (int i = 0; i < NI; ++i) { const unsigned long long m = __ballot(i * 64 + lane <= tpos); if (lane == 0) msk[tk * 32 + i] = m; }
        } else {
            int h[NI];
#pragma unroll
            for (int i = 0; i < NI; ++i) h[i] = (int)(u[i] >> 1);
            auto count_ge = [&](int c) { int lt = 0;
#pragma unroll
                for (int i = 0; i < NI; i += 4) { int d0 = h[i] - c, d1 = h[i + 1] - c, d2 = h[i + 2] - c, d3 = h[i + 3] - c;
                    asm volatile("" : "+v"(d0), "+v"(d1), "+v"(d2), "+v"(d3));
                    lt += ((int)((unsigned)d0 >> 31) + (int)((unsigned)d1 >> 31)) + ((int)((unsigned)d2 >> 31) + (int)((unsigned)d3 >> 31)); }
                return NI * 64 - wave_sum_i32(lt); };
            int T31 = 0, bit0 = 30; bool exact = false;
            { int mx = 0;
#pragma unroll
              for (int i = 0; i < NI; ++i) mx = (h[i] > mx) ? h[i] : mx;
              mx = (int)wave_max_u32((unsigned)mx);
              int P = mx >> 22;
#pragma unroll 1
              for (int tr = 0; tr < 4 && P > 0; ++tr, --P) {
                  const int cand = P << 22; const int cnt = count_ge(cand);
                  if (cnt >= 256) { T31 = cand; bit0 = 21; exact = (cnt == 256); break; }
              } }
            if (!exact) {
#pragma unroll 1
                for (int bit = bit0; bit >= 0; --bit) {
                    const int cand = T31 | (1 << bit); const int cnt = count_ge(cand);
                    if (cnt >= 256) { T31 = cand; if (cnt == 256) { exact = true; break; } }
                }
            }
            unsigned T = (unsigned)T31 << 1; int cge = 256;
            if (!exact) { const unsigned Thi = T | 1u; int lc = 0;
#pragma unroll
                for (int i = 0; i < NI; ++i) lc += (u[i] >= Thi) ? 1 : 0;
                const int chi = wave_sum_i32(lc);
                if (chi >= 256) { T = Thi; cge = chi; } else cge = count_ge(T31); }
            if (cge == 256) {
                int mlo = 0, mhi = 0;
#pragma unroll
                for (int i = 0; i < NI; ++i) { const unsigned long long bm = __ballot(u[i] >= T);
                    const bool me = (lane == i); mlo = me ? (int)(unsigned)bm : mlo; mhi = me ? (int)(unsigned)(bm >> 32) : mhi; }
                if (lane < NI) msk[tk * 32 + lane] = ((unsigned long long)(unsigned)mhi << 32) | (unsigned long long)(unsigned)mlo;
                continue;
            }
            int cgt = 0;
#pragma unroll
            for (int i = 0; i < NI; ++i) cgt += __popcll(__ballot(u[i] > T));
            const int need = 256 - cgt;
            int run = 0; const unsigned long long lt = (1ull << lane) - 1ull;
#pragma unroll
            for (int i = 0; i < NI; ++i) {
                const bool eq = (u[i] == T); const unsigned long long eqm = __ballot(eq);
                const int myrank = run + __popcll(eqm & lt); const bool sel = (u[i] > T) || (eq && myrank < need);
                run += __popcll(eqm); const unsigned long long m = __ballot(sel); if (lane == 0) msk[tk * 32 + i] = m; }
        }
    }
}

__device__ __forceinline__ void dsa_unit(const Args& a, LAS unsigned char* lds, int b, int qt) {
    int tid_ = threadIdx.x; asm volatile("" : "+v"(tid_));
    __syncthreads();
    const int tid = tid_, lane = tid & 63, wave = __builtin_amdgcn_readfirstlane(tid >> 6), r32 = lane & 31, hi = lane >> 5;
    unsigned char* ws = a.ws;
    const int t0 = qt * 32, token = t0 + r32, nkt = (t0 + 31) / 64 + 1;
    const size_t row = (size_t)b * SEQ + token;
    float* scr = (float*)(ws + WS_SCR) + (size_t)blockIdx.x * 32 * 2048;
    LAS unsigned char* iql = lds + L_IQL; LAS unsigned long long* msk = (LAS unsigned long long*)(lds + L_MSK);
    REP(13) {
        const bf16* IQ = (const bf16*)(ws + WS_IQ);
#pragma unroll
        for (int c4 = 0; c4 < 4; ++c4) { const int id = tid + 512 * c4, tok = id >> 6, c = id & 63, h = c >> 3, d0 = (c >> 1) & 3, hh = c & 1;
            const u32x4 v = *(const u32x4*)(IQ + ((size_t)b * SEQ + t0 + tok) * 512 + c * 8);
            *(LAS u32x4*)(iql + (((h * 4 + d0) * 2 + hh) * 32 + tok) * 16) = v; }
        if (tid < 256) { const int tok = tid >> 3, h = tid & 7; ((LAS float*)(lds + L_IWL))[h * 32 + tok] = ((const float*)(ws + WS_IW))[((size_t)b * SEQ + t0 + tok) * 8 + h]; }
        __syncthreads();
        const bf16* IK = (const bf16*)(ws + WS_IK) + (size_t)b * SEQ * 64;
        bf16x8 kf[8], kn[8];
        auto kload = [&](int kt, bf16x8 (&d)[8]) {
#pragma unroll
            for (int d0 = 0; d0 < 4; ++d0) { d[2 * d0] = *(const bf16x8*)(IK + (size_t)(kt * 64 + r32) * 64 + 16 * d0 + 8 * hi); d[2 * d0 + 1] = *(const bf16x8*)(IK + (size_t)(kt * 64 + 32 + r32) * 64 + 16 * d0 + 8 * hi); } };
        if (wave < nkt) kload(wave, kn);
#pragma unroll 1
        for (int kt = wave; kt < nkt; kt += NWAVES) {
#pragma unroll
            for (int i = 0; i < 8; ++i) kf[i] = kn[i];
            if (kt + NWAVES < nkt) kload(kt + NWAVES, kn);
            f32x16 acc0 = {}, acc1 = {};
#pragma unroll 1
            for (int h = 0; h < 8; ++h) {
                const float wh = ((const LAS float*)(lds + L_IWL))[h * 32 + r32];
                f32x16 s0 = {}, s1 = {};
#pragma unroll
                for (int d0 = 0; d0 < 4; ++d0) { const bf16x8 q = *(const LAS bf16x8*)(iql + (((h * 4 + d0) * 2 + hi) * 32 + r32) * 16);
                    s0 = MFMA32(kf[2 * d0], q, s0); s1 = MFMA32(kf[2 * d0 + 1], q, s1); }
#pragma unroll
                for (int r = 0; r < 16; ++r) {
                    const int i0 = __float_as_int(s0[r]), i1 = __float_as_int(s1[r]);
                    acc0[r] += wh * __int_as_float(i0 > 0 ? i0 : 0); acc1[r] += wh * __int_as_float(i1 > 0 ? i1 : 0); }
            }
#pragma unroll
            for (int q = 0; q < 4; ++q) { const int k0 = kt * 64 + 8 * q + 4 * hi; f32x4 v0, v1;
#pragma unroll
                for (int e = 0; e < 4; ++e) { v0[e] = (k0 + e <= token) ? acc0[4 * q + e] : -INFINITY; v1[e] = (k0 + 32 + e <= token) ? acc1[4 * q + e] : -INFINITY; }
                *(f32x4*)(scr + (size_t)r32 * 2048 + k0) = v0; *(f32x4*)(scr + (size_t)r32 * 2048 + k0 + 32) = v1; }
        }
        __syncthreads();
    }
    REP(14) {
        if (nkt <= 8) dsa_select<8>(scr, msk, wave, lane, t0, nkt);
        else if (nkt <= 12) dsa_select<12>(scr, msk, wave, lane, t0, nkt);
        else if (nkt <= 16) dsa_select<16>(scr, msk, wave, lane, t0, nkt);
        else if (nkt <= 20) dsa_select<20>(scr, msk, wave, lane, t0, nkt);
        else if (nkt <= 24) dsa_select<24>(scr, msk, wave, lane, t0, nkt);
        else if (nkt <= 28) dsa_select<28>(scr, msk, wave, lane, t0, nkt);
        else dsa_select<32>(scr, msk, wave, lane, t0, nkt);
    }
    __syncthreads();
    REP(15) {
        const int head = (wave < 4) ? wave : 11 - wave;
        bf16x8 qr[4];
#pragma unroll
        for (int d0 = 0; d0 < 4; ++d0) qr[d0] = *(const bf16x8*)((const bf16*)(ws + WS_QB) + row * 512 + head * 64 + 16 * d0 + 8 * hi);
        const float slope2 = __builtin_amdgcn_exp2f(-(float)(head + 1)) * LOG2E;
        const float sbound = 64.f * QSCALE * 1.01f * wave_max_dpp(fabsf(a.in[I_GQB][lane])) * wave_max_dpp(fabsf(a.in[I_GKB][lane]));
        const CInit cinit = make_cinit(slope2, hi);
        FlashSt st; flash_init(st);
        struct TI { const LAS unsigned long long* mrow; int sh; float sl64, sb63;
            __device__ __forceinline__ bool masked(int) const { return true; }
            __device__ __forceinline__ float off(int kt) const { return sl64 * (float)kt; }
            __device__ __forceinline__ float skipb(int kt) const { return sb63 + sl64 * (float)kt; }
            __device__ __forceinline__ u32x2 prep(int kt) const { const unsigned long long mm = mrow[kt] >> sh; u32x2 w; w.x = (unsigned)mm; w.y = (unsigned)(mm >> 32); return w; }
            __device__ __forceinline__ int valid(const u32x2& w, int r, int half) const { return __builtin_amdgcn_sbfe((int)(half ? w.y : w.x), (r & 3) + 8 * (r >> 2), 1); } };
        const TI ti{msk + r32 * 32, 4 * hi, 64.f * slope2, sbound + 63.f * slope2};
        flash_loop((const bf16*)(ws + WS_KB) + (size_t)b * SEQ * 64, (const bf16*)(ws + WS_VB) + (size_t)b * SEQ * 64, 0, nkt - 1, ~0ull, qr, cinit, 32.f * slope2, st, ti, lds, tid);
        f32x16 t0v = {}, t1v = {};
        flash_finish(st, 1.f, t0v, t1v);
        store_o(ws + WS_OB8, row * 512 + head * 64, t0v, t1v, hi, (float*)(ws + WS_ROWNB) + row, so_scale_b((const float*)(ws + WS_VMAX)));
    }
    __syncthreads();
}

__device__ __forceinline__ void attn_phase(const Args& a, LAS unsigned char* lds) {
    const int c = blockIdx.x, G = gridDim.x;
    REP(11) for (int i = c; i < 2048; i += G) { const int k = i / 256, cc = i % 256, j = cc / 64, bg = cc % 64, jj = (k & 1) ? 3 - j : j, qt = 31 - (4 * k + jj);
        nsa_unit(a, lds, bg >> 1, bg & 1, qt); }
    REP(12) for (int i = c; i < 2048; i += G) { const int k = i / 256, cc = i % 256, j = cc / 32, b = cc % 32, jj = (k & 1) ? 7 - j : j, qt = 63 - (8 * k + jj);
        dsa_unit(a, lds, b, qt); }
}

#define RLX_AGENT __ATOMIC_RELAXED, __HIP_MEMORY_SCOPE_AGENT
#define XB_TMO      128
#define XB_XCNT(j)  (256  + 64 * (j))
#define XB_XSUB(j)  (1280 + 64 * (j))
#define XB_XGEN(j)  (2304 + 64 * (j))
#define XB_TOP      3328
#define XB_TOPGEN   3392
#define XCD_BAR_WORDS 3456
#define XB_SPIN_CAP (1u << 18)

__device__ __forceinline__ unsigned xb_ld(unsigned* p)              { return __hip_atomic_load(p, __ATOMIC_RELAXED, __HIP_MEMORY_SCOPE_AGENT); }
__device__ __forceinline__ unsigned xb_add(unsigned* p, unsigned v) { return __hip_atomic_fetch_add(p, v, __ATOMIC_RELAXED, __HIP_MEMORY_SCOPE_AGENT); }
__device__ __forceinline__ unsigned xb_xcc_id() { return (unsigned)__builtin_amdgcn_s_getreg((3 << 11) | 20) & 0xFu; }
#define XB_SPIN(cond, bar) do { unsigned _sp = 0; while (cond) { __builtin_amdgcn_s_sleep(1); \
    if ((++_sp & 255u) == 0u) { if (xb_ld(&(bar)[XB_TMO])) break; if (_sp > XB_SPIN_CAP) { atomicAdd(&(bar)[XB_TMO], 1u); break; } } } } while (0)

struct XcdBarrier {
    unsigned* bar; unsigned x;
    volatile LAS unsigned* st;
};

__device__ __forceinline__ XcdBarrier xcd_barrier_post(unsigned* bar, volatile LAS unsigned* st) {
    XcdBarrier b; b.bar = bar; b.x = xb_xcc_id(); b.st = st;
    if (threadIdx.x == 0) (void)xb_add(&bar[XB_XCNT(b.x)], 1u);
    return b;
}
__device__ __forceinline__ void xcd_barrier_complete(unsigned* bar, unsigned x, unsigned& nloc, unsigned& nx) {
    const unsigned G = gridDim.x * gridDim.y * gridDim.z;
    unsigned sum, cnt, mine, sp = 0u;
    for (;;) {
        sum = 0u; cnt = 0u; mine = 0u;
#pragma unroll
        for (unsigned j = 0; j < 16; ++j) { const unsigned c = xb_ld(&bar[XB_XCNT(j)]); sum += c; cnt += (c > 0u) ? 1u : 0u; mine = (j == x) ? c : mine; }
        if (sum == G) break;
        __builtin_amdgcn_s_sleep(1);
        if ((++sp & 255u) == 0u) { if (xb_ld(&bar[XB_TMO])) break; if (sp > XB_SPIN_CAP) { atomicAdd(&bar[XB_TMO], 1u); break; } }
    }
    nloc = mine > 0u ? mine : 1u; nx = cnt > 0u ? cnt : 1u;
}

__device__ __forceinline__ void xcd_barrier(const XcdBarrier& b) {
    asm volatile("s_waitcnt vmcnt(0)" ::: "memory");
    __syncthreads();
    if (threadIdx.x == 0) {
        unsigned* bar = b.bar;
        __builtin_amdgcn_s_waitcnt(0);
        unsigned nloc = b.st[0], nx = b.st[1];
        if (nloc == 0u) { xcd_barrier_complete(bar, b.x, nloc, nx); b.st[0] = nloc; b.st[1] = nx; }
        const unsigned old = xb_add(&bar[XB_XSUB(b.x)], 1u);
        const unsigned gen = old / nloc;
        if (old + 1u == (gen + 1u) * nloc) {
            __builtin_amdgcn_fence(__ATOMIC_RELEASE, "agent");
            asm volatile("s_waitcnt vmcnt(0)" ::: "memory");
            const unsigned og = xb_add(&bar[XB_TOP], 1u);
            const unsigned tg = og / nx;
            if (og + 1u == (tg + 1u) * nx) xb_add(&bar[XB_TOPGEN], 1u);
            else XB_SPIN(xb_ld(&bar[XB_TOPGEN]) == tg, bar);
            __builtin_amdgcn_fence(__ATOMIC_ACQUIRE, "agent");
            xb_add(&bar[XB_XGEN(b.x)], 1u);
            asm volatile("s_waitcnt vmcnt(0)" ::: "memory");
        } else {
            XB_SPIN(xb_ld(&bar[XB_XGEN(b.x)]) == gen, bar);
            __builtin_amdgcn_fence(__ATOMIC_ACQUIRE, "agent");
            asm volatile("s_waitcnt vmcnt(0)" ::: "memory");
        }
    }
    __syncthreads();
}

#ifndef WGM_P2A
#define WGM_P2A 4
#endif
#ifndef WGM_P2B
#define WGM_P2B 4
#endif
#ifndef WGM_P9
#define WGM_P9 4
#endif
#ifndef RUNG
#define RUNG 99
#endif
__global__ void __launch_bounds__(NTHREADS, 2) hybrid_fwd(Args a) {
    extern __shared__ __attribute__((aligned(16))) unsigned char lds_raw[];
    LAS unsigned char* lds = (LAS unsigned char*)lds_raw;
    cg::grid_group grid = cg::this_grid();
    unsigned char* ws = a.ws;
    volatile LAS unsigned* bst = (volatile LAS unsigned*)(lds + LDS_BYTES - 64);
    if (threadIdx.x < 2) bst[threadIdx.x] = 0u;
    __syncthreads();
    XcdBarrier xbar; xbar.bar = (unsigned*)ws; xbar.x = 0u; xbar.st = bst;
    const float* mod = (const float*)(ws + WS_MOD);
    const int lo = a.ph_lo, hi = a.ph_hi;
#define IN(k) (lo <= (k) && (k) < hi)
#define SEAM(k) do { if (IN(k) && IN((k) + 1)) { if ((k) == 0) grid.sync(); else xcd_barrier(xbar); } } while (0)

    if (IN(0)) REP(0) { phase0(a, lds); }
    SEAM(0);
    if (IN(0) && IN(1)) xbar = xcd_barrier_post((unsigned*)ws, bst);
    if (IN(1)) REP(1) { if (blockIdx.x == 0 && threadIdx.x < 64) wnmax_item(ws); wgu_quant_items(a, lds); wing_quant_items(a, lds); wd_quant_items(a, lds); wout_quant_items(a, lds); woab_quant_items(a, lds); norm_dual_phase(a.in[I_X], a.in[I_GN1], mod, 0, DM, (bf16*)(ws + WS_H), (signed char*)(ws + WS_HQ), (float*)(ws + WS_SA1)); }
    SEAM(1);
#if RUNG >= 2
    if (IN(2)) {
        if constexpr (NBFT > 0) { pg8::Gemm g{(const bf16*)(ws + WS_H), (const bf16*)(ws + WS_WIN), MROWS, NBFROWS, DM}; pg8::StaticOrder S; S.init(MROWS, NBFROWS, gridDim.x, blockIdx.x, WGM_P2A);
          EpiProj<false> E{ws, a.in[I_GQA], a.in[I_GKS], a.in[I_GKW], a.in[I_GQB], a.in[I_GKB]};
          pg8::gemm_phase<EpiProj<false>, pg8::StaticOrder, true, true>(lds, g, S, E); }
        { pg8::Gemm g{(const bf16*)(ws + WS_HQ), (const bf16*)(ws + WS_WINGQ), MROWS, NI8ROWS, DM / 2}; pg8::StaticOrder S; S.init(MROWS, NI8ROWS, gridDim.x, blockIdx.x, WGM_P2B);
          EpiProj<true> E{ws, a.in[I_GQA], a.in[I_GKS], a.in[I_GKW], a.in[I_GQB], a.in[I_GKB]};
          pg8::gemm_phase<EpiProj<true>, pg8::StaticOrder, true, true, true>(lds, g, S, E); }
    }
    SEAM(2);
    if (IN(3)) REP(3) { compress_phase(a, lds); }
    SEAM(3);
    if (IN(4)) { attn_phase(a, lds); }
    SEAM(4);
    if (IN(5)) {
        pg8::Gemm g{(const bf16*)(ws + WS_OA), (const bf16*)(ws + WS_WOA), 2 * MROWS, 2 * DM, 256}; PairOrder S; S.init(gridDim.x, blockIdx.x);
        EpiYPair E{ws + WS_GA, ws + WS_GB, (bf16*)(ws + WS_Y), ws + WS_Y8, (const float*)(ws + WS_ROWNA), (const float*)(ws + WS_ROWNB), (const float*)(ws + WS_WNMAX),
                   (const float*)(ws + WS_VMAX), (const float*)(ws + WS_SBWO)};
        pg8::gemm_phase<EpiYPair, PairOrder, true, true, false, true>(lds, g, S, E);
    }
    SEAM(6);
    if (IN(7)) {
        pg8::Gemm g{(const bf16*)(ws + WS_Y8), (const bf16*)(ws + WS_WOUT), MROWS, DM, DM / 2}; pg8::StaticOrder S; S.init(MROWS, DM, gridDim.x, blockIdx.x);
        EpiX1 E{a.in[I_X], (bf16*)(ws + WS_X1B), (float*)(ws + WS_ROWSS), mod, (const float*)(ws + WS_ROWNA), (const float*)(ws + WS_ROWNB), (const float*)(ws + WS_WNMAX), (const float*)(ws + WS_SBO)};
        pg8::gemm_phase<EpiX1, pg8::StaticOrder, true, true, false, true>(lds, g, S, E);
    }
    SEAM(7);
#endif
    if (IN(8)) { norm2_quant_phase((const bf16*)(ws + WS_X1B), (const float*)(ws + WS_ROWSS), a.in[I_GN2], mod, (signed char*)(ws + WS_H2), (float*)(ws + WS_SA2), (float*)(ws + WS_SACT), (const float*)(ws + WS_WNMAX)); }
    SEAM(8);
    if (IN(9)) {
        pg8::Gemm g{(const bf16*)(ws + WS_H2), (const bf16*)(ws + WS_WGU), MROWS, 2 * DFF, DM / 2}; pg8::StaticOrder S; S.init(MROWS, 2 * DFF, gridDim.x, blockIdx.x, WGM_P9);
        EpiAct3 E{ws + WS_ACT, (const float*)(ws + WS_SA2), (const float*)(ws + WS_SBWGU), (const float*)(ws + WS_SACT)};
        pg8::gemm_phase<EpiAct3, pg8::StaticOrder, true, true, true>(lds, g, S, E);
    }
    SEAM(9);
    if (IN(10)) {
        pg8::Gemm g{(const bf16*)(ws + WS_ACT), (const bf16*)(ws + WS_WD), MROWS, DM, DFF / 2}; pg8::StaticOrder S; S.init(MROWS, DM, gridDim.x, blockIdx.x);
        EpiOut E{(const bf16*)(ws + WS_X1B), a.out, mod, (const float*)(ws + WS_SACT), (const float*)(ws + WS_SBD)};
        pg8::gemm_phase<EpiOut, pg8::StaticOrder, true, true, false, true>(lds, g, S, E);
    }
#undef IN
#undef SEAM
}

#ifndef N_LAUNCH_MODE
#define N_LAUNCH_MODE 1
#endif
extern "C" void kernel_launch(void* const* d_in, const int* in_sizes, int n_in, void* d_out, int out_size, void* d_ws, size_t ws_size, hipStream_t stream) {
    static int grid = 0;
    if (grid == 0) {
        if (n_in != 25 || out_size != MROWS * DM || ws_size < WS_END) { fprintf(stderr, "kernel_launch: unexpected problem (n_in %d, out %d, ws %zu)\n", n_in, out_size, ws_size); grid = -1; return; }
        int dev = 0, cus = 0, per_cu = 0;
        hipGetDevice(&dev); hipDeviceGetAttribute(&cus, hipDeviceAttributeMultiprocessorCount, dev);
        if (hipFuncSetAttribute((const void*)hybrid_fwd, hipFuncAttributeMaxDynamicSharedMemorySize, LDS_BYTES) != hipSuccess) { fprintf(stderr, "kernel_launch: hipFuncSetAttribute failed\n"); grid = -1; return; }
        if (hipOccupancyMaxActiveBlocksPerMultiprocessor(&per_cu, (const void*)hybrid_fwd, NTHREADS, LDS_BYTES) != hipSuccess || per_cu < 1) { fprintf(stderr, "kernel_launch: occupancy query says %d\n", per_cu); per_cu = 1; }
        (void)hipGetLastError();
        grid = cus * (per_cu > 1 ? 1 : per_cu);
        if (grid > MAXGRID) grid = MAXGRID;
        if (grid < 1) grid = 1;
    }
    if (grid < 0) return;
    Args a{};
    for (int i = 0; i < 25; ++i) a.in[i] = (const float*)d_in[i];
    a.out = (float*)d_out; a.ws = (unsigned char*)d_ws;
#if N_LAUNCH_MODE == 1
    a.ph_lo = 0; a.ph_hi = 11;
    void* args[] = {&a};
    hipError_t e = hipLaunchCooperativeKernel((const void*)hybrid_fwd, dim3(grid), dim3(NTHREADS), args, LDS_BYTES, stream);
    if (e != hipSuccess) fprintf(stderr, "kernel_launch: cooperative launch failed: %s (grid %d)\n", hipGetErrorString(e), grid);
#else
    for (int p = 0; p < 11; ++p) { a.ph_lo = p; a.ph_hi = p + 1; hipLaunchKernelGGL(hybrid_fwd, dim3(grid), dim3(NTHREADS), LDS_BYTES, stream, a); }
#endif
}
```

```cpp
#include <hip/hip_runtime.h>
#include <hip/hip_cooperative_groups.h>
#include <cstdio>
#include <cstdint>
namespace cg = cooperative_groups;
#define RUNG 99
#define N_LAUNCH_MODE 1
#define REPMASK 0
#define REP(k) for (int rp_ = 0; rp_ < (((REPMASK) >> (k)) & 1) + 1; ++rp_)
namespace pg8 {
#define PG8_LAS __attribute__((address_space(3)))
typedef unsigned short bf16_t;
typedef short bf16x8 __attribute__((ext_vector_type(8)));
typedef float f32x4 __attribute__((ext_vector_type(4)));
typedef unsigned u32x4 __attribute__((ext_vector_type(4)));
typedef int i32x4 __attribute__((ext_vector_type(4)));
typedef int i32x8 __attribute__((ext_vector_type(8)));
constexpr int BM = 256, BK = 64, HALF = 128, HTB = HALF * BK * 2  , STAGE_BYTES = 8 * HTB, NXCD = 8, WGM = 4;

__host__ __device__ __forceinline__ int lds_byte(int r, int c) { const int st = (r >> 4) * 2 + (c >> 5), rr = r & 15, cc = c & 31, ob = rr * 64 + cc * 2; return st * 1024 + (ob ^ (((ob >> 9) & 1) << 5)); }
__host__ __device__ __forceinline__ void stage_rc(int b, int& R, int& C) { const int st = b / 1024, sb = b % 1024, swz = sb ^ (((sb >> 9) & 1) << 5); R = (st >> 1) * 16 + swz / 64; C = (st & 1) * 32 + (swz % 64) / 2; }
__host__ __device__ __forceinline__ int perm32(int rho) { const int n = rho >> 4, i = rho & 15; return 8 * (i >> 2) + 4 * n + (i & 3); }

struct Unit { int pm, pn; };
struct Gemm { const bf16_t* A; const bf16_t* Bt; int M, N, K; };

struct StaticOrder {
    int nM, nN, nwg, G, c, wgm;
    __host__ __device__ void init(int M, int N, int G_, int c_, int wgm_ = WGM) { nM = M / BM; nN = N / BM; nwg = nM * nN; G = G_; c = c_; wgm = wgm_; }
    __host__ __device__ bool next(int i, Unit& u) const {
        const long L = (long)i * G + c; if (L >= nwg) return false;
        int wgid = (int)L; { const int q = nwg / NXCD, r = nwg % NXCD, xcd = wgid % NXCD, off = wgid / NXCD; wgid = (xcd < r ? xcd * (q + 1) : r * (q + 1) + (xcd - r) * q) + off; }
        const int nig = wgm * nN, gid = wgid / nig, fm = gid * wgm, gsz = (nM - fm) < wgm ? (nM - fm) : wgm;
        u.pm = fm + ((wgid % nig) % gsz); u.pn = (wgid % nig) / gsz; return true;
    }
    __device__ __forceinline__ void a_ready(const Unit&) const {}
    __device__ __forceinline__ void done(const Unit&) const {}
};

template <class Epi, class Sched, bool ALIGN_EPI = false, bool SP2 = false, bool I8 = false, bool F8 = false>
__device__ __forceinline__ void gemm_phase(PG8_LAS unsigned char* lds, const Gemm g, const Sched& S, const Epi& E) {
    const int tid = threadIdx.x, wid = __builtin_amdgcn_readfirstlane(tid >> 6), lane = tid & 63, wr = wid >> 2, wc = wid & 3, fr = lane & 15, fq = lane >> 4;
    const int K = g.K, nt = K / BK;
    unsigned voffA[2], voffB[2];
#pragma unroll
    for (int i = 0; i < 2; ++i) { int R, C; stage_rc(tid * 16 + i * 8192, R, C); const int Rb = Epi::PERM ? ((R & ~31) + perm32(R & 31)) : R;
        voffA[i] = (unsigned)(R * K + C) * 2u; voffB[i] = (unsigned)(Rb * K + C) * 2u; }
    const size_t kstep = (size_t)(BK * 2);
    const size_t hstep = (size_t)HALF * K * 2;
    const size_t tstep = 2 * hstep;
    const unsigned ldsw = (unsigned)wid * 1024u;
    const int aoff = lds_byte(wr * 64 + fr, fq * 8), boff = lds_byte(wc * 32 + fr, fq * 8);
#define PG8_SA(b, h) (((b) * 2 + (h)) * HTB)
#define PG8_SB(b, h) ((4 + (b) * 2 + (h)) * HTB)
#define PG8_STAGE(bufoff, gbase, voff) do { _Pragma("unroll") for (int _i = 0; _i < 2; ++_i) \
        __builtin_amdgcn_global_load_lds((const unsigned*)((const char*)(gbase) + (voff)[_i]), (PG8_LAS unsigned*)(lds + (bufoff) + ldsw + _i * 8192), 16, 0, 0); } while (0)
#define PG8_LD8(p) PG8_CAT8(*(const PG8_LAS bf16x8*)(p), *(const PG8_LAS bf16x8*)((p) + 1024))
#define PG8_LDA8(dst, b, h) do { _Pragma("unroll") for (int m = 0; m < 4; ++m) dst##8[m] = PG8_LD8(lds + PG8_SA(b, h) + aoff + m * 2048); } while (0)
#define PG8_LDB8(dst, b, h) do { _Pragma("unroll") for (int n = 0; n < 2; ++n) dst##8[n] = PG8_LD8(lds + PG8_SB(b, h) + boff + n * 2048); } while (0)
#define PG8_LDA_(dst, b, h) do { _Pragma("unroll") for (int m = 0; m < 4; ++m) _Pragma("unroll") for (int k = 0; k < 2; ++k) dst[m][k] = *(const PG8_LAS bf16x8*)(lds + PG8_SA(b, h) + aoff + m * 2048 + k * 1024); } while (0)
#define PG8_LDB_(dst, b, h) do { _Pragma("unroll") for (int n = 0; n < 2; ++n) _Pragma("unroll") for (int k = 0; k < 2; ++k) dst[n][k] = *(const PG8_LAS bf16x8*)(lds + PG8_SB(b, h) + boff + n * 2048 + k * 1024); } while (0)
#define PG8_LDA(dst, b, h) do { if constexpr (F8) PG8_LDA8(dst, b, h); else PG8_LDA_(dst, b, h); } while (0)
#define PG8_LDB(dst, b, h) do { if constexpr (F8) PG8_LDB8(dst, b, h); else PG8_LDB_(dst, b, h); } while (0)
#define PG8_MMA(ai, bj, At, Bt) do { __builtin_amdgcn_s_setprio(1); _Pragma("unroll") for (int m = 0; m < 4; ++m) _Pragma("unroll") for (int n = 0; n < 2; ++n) _Pragma("unroll") for (int k = 0; k < 2; ++k) \
        { if constexpr (F8) { if (k == 0) asm volatile("v_mfma_scale_f32_16x16x128_f8f6f4 %0, %1, %2, %0, %3, %3 op_sel_hi:[0,0,0]" : "+v"(acc[ai][bj][m][n]) : "v"(Bt##8[n]), "v"(At##8[m]), "v"(f8scl)); } \
          else if constexpr (I8) acc[ai][bj][m][n] = __builtin_bit_cast(f32x4, __builtin_amdgcn_mfma_i32_16x16x64_i8(__builtin_bit_cast(i32x4, Bt[n][k]), __builtin_bit_cast(i32x4, At[m][k]), __builtin_bit_cast(i32x4, acc[ai][bj][m][n]), 0, 0, 0)); \
          else acc[ai][bj][m][n] = __builtin_amdgcn_mfma_f32_16x16x32_bf16(Bt[n][k], At[m][k], acc[ai][bj][m][n], 0, 0, 0); } __builtin_amdgcn_s_setprio(0); } while (0)
#define PG8_CAT8(x, y) __builtin_shufflevector(__builtin_bit_cast(i32x4, x), __builtin_bit_cast(i32x4, y), 0, 1, 2, 3, 4, 5, 6, 7)
#define PG8_WAIT_V(n) asm volatile("s_waitcnt vmcnt(" #n ")" ::: "memory")
#define PG8_WAIT_L(n) asm volatile("s_waitcnt lgkmcnt(" #n ")" ::: "memory")
#define PG8_BAR __builtin_amdgcn_s_barrier()
#define PG8_SCHED __builtin_amdgcn_sched_barrier(0)
    Unit cur, nxt; int ui = 0;
    if (!S.next(0, cur)) return;
    f32x4 acc[2][2][4][2];
#pragma unroll
    for (int a = 0; a < 2; ++a)
#pragma unroll
        for (int b = 0; b < 2; ++b)
#pragma unroll
            for (int m = 0; m < 4; ++m)
#pragma unroll
                for (int n = 0; n < 2; ++n) acc[a][b][m][n] = (f32x4){0.f, 0.f, 0.f, 0.f};
    bf16x8 At[4][2], B0[2][2], B1[2][2], Bn[2][2];
    const int f8scl = 0x7f7f7f7f;
    i32x8 At8[4], B08[2], B18[2], Bn8[2];
    const char* cA = (const char*)g.A + (size_t)cur.pm * tstep; const char* cB = (const char*)g.Bt + (size_t)cur.pn * tstep;
    S.a_ready(cur);
    if constexpr (SP2) {
        PG8_STAGE(PG8_SB(0, 0), cB, voffB); PG8_STAGE(PG8_SB(0, 1), cB + hstep, voffB); PG8_STAGE(PG8_SA(0, 0), cA, voffA); PG8_STAGE(PG8_SA(0, 1), cA + hstep, voffA);
        if (wr == 1) PG8_BAR;
        PG8_WAIT_V(2); PG8_BAR;
        PG8_STAGE(PG8_SB(1, 0), cB + kstep, voffB); PG8_STAGE(PG8_SA(1, 0), cA + kstep, voffA); PG8_STAGE(PG8_SB(1, 1), cB + hstep + kstep, voffB);
        PG8_WAIT_V(6); PG8_BAR;
    } else {
        PG8_STAGE(PG8_SB(0, 0), cB, voffB); PG8_STAGE(PG8_SA(0, 0), cA, voffA); PG8_STAGE(PG8_SB(0, 1), cB + hstep, voffB); PG8_STAGE(PG8_SA(0, 1), cA + hstep, voffA);
        if (wr == 1) PG8_BAR;
        PG8_WAIT_V(4); PG8_BAR;
        PG8_STAGE(PG8_SB(1, 0), cB + kstep, voffB); PG8_STAGE(PG8_SA(1, 0), cA + kstep, voffA); PG8_STAGE(PG8_SB(1, 1), cB + hstep + kstep, voffB);
        PG8_WAIT_V(6); PG8_BAR;
    }
    for (;;) {
        const bool has_next = S.next(ui + 1, nxt);
        const char* nA = has_next ? (const char*)g.A + (size_t)nxt.pm * tstep : cA; const char* nB = has_next ? (const char*)g.Bt + (size_t)nxt.pn * tstep : cB;
        if constexpr (SP2) PG8_LDB(B0, 0, 0);
        for (int t = 0; t < nt; t += 2) {
            const bool last = (t == nt - 2);
            const char* a1 = cA + (size_t)(t + 1) * kstep;
            const char* a2 = last ? nA : cA + (size_t)(t + 2) * kstep; const char* b2 = last ? nB : cB + (size_t)(t + 2) * kstep;
            const char* a3 = a2 + kstep; const char* b3 = b2 + kstep;
            if (last && has_next) S.a_ready(nxt);
            if constexpr (SP2) {
            PG8_LDB(B1, 0, 1); PG8_SCHED; PG8_LDA(At, 0, 0); PG8_STAGE(PG8_SA(1, 1), a1 + hstep, voffA);
            PG8_WAIT_V(6); PG8_WAIT_L(0); PG8_BAR; PG8_MMA(0, 0, At, B0); PG8_MMA(0, 1, At, B1); PG8_BAR; PG8_SCHED;
            PG8_LDA(At, 0, 1); PG8_LDB(Bn, 1, 0); PG8_STAGE(PG8_SB(0, 0), b2, voffB); PG8_STAGE(PG8_SB(0, 1), b2 + hstep, voffB); PG8_STAGE(PG8_SA(0, 0), a2, voffA);
            PG8_WAIT_V(8); PG8_WAIT_L(0); PG8_BAR; PG8_MMA(1, 0, At, B0); PG8_MMA(1, 1, At, B1); PG8_BAR; PG8_SCHED;
            PG8_LDB(B1, 1, 1); PG8_SCHED; PG8_LDA(At, 1, 0); PG8_STAGE(PG8_SA(0, 1), a2 + hstep, voffA);
            PG8_WAIT_V(6); PG8_WAIT_L(0); PG8_BAR; PG8_MMA(0, 0, At, Bn); PG8_MMA(0, 1, At, B1); PG8_BAR; PG8_SCHED;
            PG8_LDA(At, 1, 1); PG8_LDB(B0, 0, 0); PG8_STAGE(PG8_SB(1, 0), b3, voffB); PG8_STAGE(PG8_SB(1, 1), b3 + hstep, voffB); PG8_STAGE(PG8_SA(1, 0), a3, voffA);
            PG8_WAIT_V(8); PG8_WAIT_L(0); PG8_BAR; PG8_MMA(1, 0, At, Bn); PG8_MMA(1, 1, At, B1); PG8_BAR; PG8_SCHED;
            } else {
            PG8_LDB(B0, 0, 0); PG8_SCHED; PG8_LDA(At, 0, 0); PG8_STAGE(PG8_SA(1, 1), a1 + hstep, voffA);
            PG8_WAIT_L(8); PG8_BAR; PG8_WAIT_L(0); PG8_MMA(0, 0, At, B0); PG8_BAR; PG8_SCHED;
            PG8_LDB(B1, 0, 1); PG8_STAGE(PG8_SB(0, 0), b2, voffB);
            PG8_BAR; PG8_WAIT_L(0); PG8_MMA(0, 1, At, B1); PG8_BAR;
            PG8_LDA(At, 0, 1); PG8_STAGE(PG8_SA(0, 0), a2, voffA);
            PG8_BAR; PG8_WAIT_L(0); PG8_MMA(1, 0, At, B0); PG8_BAR; PG8_SCHED;
            PG8_STAGE(PG8_SB(0, 1), b2 + hstep, voffB);
            PG8_WAIT_V(6); PG8_BAR; PG8_MMA(1, 1, At, B1); PG8_BAR;
            PG8_LDB(B0, 1, 0); PG8_SCHED; PG8_LDA(At, 1, 0); PG8_STAGE(PG8_SA(0, 1), a2 + hstep, voffA);
            PG8_WAIT_L(8); PG8_BAR; PG8_WAIT_L(0); PG8_MMA(0, 0, At, B0); PG8_BAR; PG8_SCHED;
            PG8_LDB(B1, 1, 1); PG8_STAGE(PG8_SB(1, 0), b3, voffB);
            PG8_BAR; PG8_WAIT_L(0); PG8_MMA(0, 1, At, B1); PG8_BAR;
            PG8_LDA(At, 1, 1); PG8_STAGE(PG8_SA(1, 0), a3, voffA);
            PG8_BAR; PG8_WAIT_L(0); PG8_MMA(1, 0, At, B0); PG8_BAR; PG8_SCHED;
            PG8_STAGE(PG8_SB(1, 1), b3 + hstep, voffB);
            PG8_WAIT_V(6); PG8_BAR; PG8_MMA(1, 1, At, B1); PG8_BAR;
            }
        }
        if constexpr (F8) asm volatile("s_nop 15\n\ts_nop 15" ::: "memory");
        if constexpr (ALIGN_EPI) { if (wr == 0) PG8_BAR; }
        if constexpr (I8) {
#pragma unroll
            for (int a = 0; a < 2; ++a)
#pragma unroll
                for (int b2 = 0; b2 < 2; ++b2)
#pragma unroll
                    for (int m = 0; m < 4; ++m)
#pragma unroll
                        for (int n = 0; n < 2; ++n) acc[a][b2][m][n] = __builtin_convertvector(__builtin_bit_cast(i32x4, acc[a][b2][m][n]), f32x4);
        }
        if constexpr (!Epi::AFTER_DRAIN) { E(acc, cur, wr, wc, fr, fq); S.done(cur); }
        if (!has_next) break;
#pragma unroll
        for (int a = 0; a < 2; ++a)
#pragma unroll
            for (int b = 0; b < 2; ++b)
#pragma unroll
                for (int m = 0; m < 4; ++m)
#pragma unroll
                    for (int n = 0; n < 2; ++n) acc[a][b][m][n] = (f32x4){0.f, 0.f, 0.f, 0.f};
        cur = nxt; cA = nA; cB = nB; ++ui;
        if constexpr (ALIGN_EPI) { if (wr == 1) PG8_BAR; }
    }
    PG8_WAIT_V(0);
    if constexpr (!ALIGN_EPI) { if (wr == 0) PG8_BAR; }
    PG8_BAR;
    if constexpr (Epi::AFTER_DRAIN) { E.fused(acc, cur, wr, wc, fr, fq, lds, wid, lane); S.done(cur); }
#undef PG8_SA
#undef PG8_SB
#undef PG8_STAGE
#undef PG8_LDA
#undef PG8_LDA_
#undef PG8_LDB_
#undef PG8_LDA8
#undef PG8_LDB8
#undef PG8_LD8
#undef PG8_LDB
#undef PG8_MMA
#undef PG8_CAT8
#undef PG8_WAIT_V
#undef PG8_WAIT_L
#undef PG8_BAR
#undef PG8_SCHED
}
}

#define LAS __attribute__((address_space(3)))
typedef unsigned short bf16;
typedef short bf16x8 __attribute__((ext_vector_type(8)));
typedef short s16x4 __attribute__((ext_vector_type(4)));
typedef short v4i16_t __attribute__((ext_vector_type(4)));
typedef float f32x4 __attribute__((ext_vector_type(4)));
typedef float f32x16 __attribute__((ext_vector_type(16)));
typedef unsigned u32x4 __attribute__((ext_vector_type(4)));
typedef unsigned u32x2 __attribute__((ext_vector_type(2)));

constexpr int NB = 32, SEQ = 2048, DM = 1024, MROWS = NB * SEQ;
constexpr int DIN = 4576, DINP = 4608, DFF = 2816, NADA = 6 * DM;
constexpr float LOG2E = 1.4426950408889634f;
constexpr float QSCALE = 0.125f * LOG2E;
constexpr float RMS_EPS = 1e-6f;
constexpr int NWAVES = 8, NTHREADS = 512;
constexpr int LDS_BYTES = 147456;
constexpr int MAXGRID = 256;

constexpr size_t MiB = 1ull << 20;
constexpr size_t WS_MOD = 1 * MiB, WS_BIAS = 2 * MiB,
    WS_WIN = 4 * MiB, WS_WOA = 13 * MiB, WS_WOB = 14 * MiB, WS_WOUT = 15 * MiB, WS_WGU = 17 * MiB, WS_WD = 28 * MiB,
    WS_WCK1 = 34 * MiB, WS_WCV1 = 34 * MiB + 512 * 1024, WS_KCO = 35 * MiB, WS_VCO = 36 * MiB,
    WS_H = 40 * MiB, WS_OA = 40 * MiB, WS_OB = 104 * MiB, WS_H2 = 40 * MiB,
    WS_QA = 168 * MiB, WS_QB = 232 * MiB, WS_IQ = 296 * MiB, WS_GA = 360 * MiB, WS_GB = 488 * MiB,
    WS_KC = 616 * MiB, WS_VC = 632 * MiB, WS_KS = 648 * MiB, WS_VS = 664 * MiB, WS_KW = 680 * MiB, WS_VW = 696 * MiB,
    WS_KB = 712 * MiB, WS_VB = 720 * MiB, WS_IK = 728 * MiB, WS_GN = 736 * MiB, WS_IW = 744 * MiB,
    WS_SCR = 748 * MiB, WS_Y = 812 * MiB, WS_ACT = 168 * MiB, WS_END = 940 * MiB,
    WS_ROWSS = 65536  , WS_CB = 3 * MiB  ,
    WS_X1B = 620 * MiB  ;
constexpr size_t ZERO_BYTES = 65536 + 3 * 4 * 65536;
constexpr size_t WS_HQ = 812 * MiB  , WS_WINGQ = WS_WIN + 4 * MiB  ;
constexpr size_t WS_SBWIN = 2 * MiB + 65536, WS_SBWGU = 2 * MiB + 131072, WS_SA1 = 2 * MiB + 262144, WS_SA2 = 2 * MiB + 524288;
constexpr size_t WS_SBO = 2 * MiB + 200704  , WS_ROWNA = 327680, WS_ROWNB = 589824  ;
constexpr size_t WS_Y8 = 168 * MiB  ;
constexpr size_t WS_DSACTR = 32768 + 64  ;
constexpr size_t WS_VMAX = 32768  , WS_SBWO = 2 * MiB + 212992  ;
constexpr size_t WS_OB8 = WS_OA + 32 * MiB  , WS_WOB8 = WS_WOA + 512 * 1024;
__device__ __forceinline__ float so_scale_a(const float* vm) { const float bd = (vm[0] + vm[1] + vm[2]) * (1.01f / 440.f); return (bd > 0.f) ? bd : 1.f; }
__device__ __forceinline__ float so_scale_b(const float* vm) { const float bd = vm[3] * (1.01f / 440.f); return (bd > 0.f) ? bd : 1.f; }
constexpr size_t WS_SBD = 2 * MiB + 196608  , WS_SACT = 2 * MiB + 786432  , WS_WNMAX = 2 * MiB + 208896  , WS_WNI = 2 * MiB + 204800  ;

struct Args { const float* in[25]; float* out; unsigned char* ws; int ph_lo, ph_hi; };

enum { I_X = 0, I_C, I_WADA, I_BADA, I_GN1, I_GN2, I_WIN, I_GQA, I_GKC, I_GKS, I_GKW, I_PECK, I_PECV, I_WCK1, I_WCK2, I_WCV1, I_WCV2,
       I_GQB, I_GKB, I_WOA, I_WOB, I_WOUT, I_WFG, I_WFU, I_WFD };

typedef float f32x2_t __attribute__((ext_vector_type(2))); typedef __bf16 bf16x2_t __attribute__((ext_vector_type(2)));
__device__ __forceinline__ unsigned cvt_pk(float lo, float hi) { const f32x2_t v = {lo, hi}; const bf16x2_t b = __builtin_convertvector(v, bf16x2_t); return __builtin_bit_cast(unsigned, b); }
__device__ __forceinline__ float bf2f(unsigned short v) { return __uint_as_float((unsigned)v << 16); }
__device__ __forceinline__ float sigmoidf_(float x) { return __builtin_amdgcn_rcpf(1.f + __builtin_amdgcn_exp2f(x * -LOG2E)); }
__device__ __forceinline__ float siluf_(float x) { return x * __builtin_amdgcn_rcpf(1.f + __builtin_amdgcn_exp2f(x * -LOG2E)); }
__device__ __forceinline__ float sy_scale(float rna, float rnb, float wa, float wb) { const float bd = (sqrtf(rna) * wa + sqrtf(rnb) * wb) * (1.02f / 440.f); return (bd > 0.f) ? bd : 1.f; }
__device__ __forceinline__ float wave_sum(float v) {
#pragma unroll
    for (int o = 1; o < 64; o <<= 1) v += __shfl_xor(v, o);
    return v;
}
#define LDS_WAIT() asm volatile("s_waitcnt lgkmcnt(0)" ::: "memory")
#define DPP_STEP_F(x, op, ctrl, rmask, bc, ident) { const float y_ = __int_as_float(__builtin_amdgcn_update_dpp(__float_as_int(ident), __float_as_int(x), ctrl, rmask, 0xf, bc)); x = op(x, y_); }
__device__ __forceinline__ float fadd_(float a, float b) { return a + b; }
__device__ __forceinline__ float wave_sum_dpp(float x) {
    DPP_STEP_F(x, fadd_, 0x111, 0xf, true, 0.f) DPP_STEP_F(x, fadd_, 0x112, 0xf, true, 0.f) DPP_STEP_F(x, fadd_, 0x114, 0xf, true, 0.f) DPP_STEP_F(x, fadd_, 0x118, 0xf, true, 0.f)
    DPP_STEP_F(x, fadd_, 0x142, 0xa, false, 0.f) DPP_STEP_F(x, fadd_, 0x143, 0xc, false, 0.f)
    return __int_as_float(__builtin_amdgcn_readlane(__float_as_int(x), 63));
}
__device__ __forceinline__ float wave_max_dpp(float x) {
    DPP_STEP_F(x, fmaxf, 0x111, 0xf, true, 0.f) DPP_STEP_F(x, fmaxf, 0x112, 0xf, true, 0.f) DPP_STEP_F(x, fmaxf, 0x114, 0xf, true, 0.f) DPP_STEP_F(x, fmaxf, 0x118, 0xf, true, 0.f)
    DPP_STEP_F(x, fmaxf, 0x142, 0xa, false, 0.f) DPP_STEP_F(x, fmaxf, 0x143, 0xc, false, 0.f)
    return __int_as_float(__builtin_amdgcn_readlane(__float_as_int(x), 63));
}

__device__ __forceinline__ int win_src_col(int np) {
    const int T = np >> 8, r = np & 255;
    if (T >= 10) return 2528 + (T - 10) * 256 + r;
    const int slot = (r & 127) >> 5, d = ((r >> 7) << 5) + (r & 31);
    switch (T) {
        case 0: return slot * 64 + d;
        case 1: return 256 + slot * 64 + d;
        case 2: return 512 + slot * 64 + d;
        case 3: return 768 + slot * 64 + d;
        case 4: return 1024 + slot * 64 + d;
        case 5: return 1304 + slot * 64 + d;
        case 6: return 1560 + slot * 64 + d;
        case 7: if (slot == 0) return 1816 + d;
                if (slot == 1) return 1880 + d;
                if (slot == 2) return 2456 + d;
                if (d < 24) return 1280 + d;
                if (d < 32) return 2520 + (d - 24);
                return -1;
        case 8: return 1944 + slot * 64 + d;
        default: return 2200 + slot * 64 + d;
    }
}

constexpr int NBFT = 3, NI8T = 15;
__device__ __forceinline__ int tmap_bf(int t) { return t + 7; }
__device__ __forceinline__ int tmap_i8(int t) { return t < 7 ? t : t + 3; }
constexpr int NBFROWS = NBFT * 256, NI8ROWS = NI8T * 256, NBFG = NBFROWS / 32, NI8G = NI8ROWS / 32;
__device__ __forceinline__ int win_src_col_bf(int np) { return win_src_col(tmap_bf(np >> 8) * 256 + (np & 255)); }
__device__ __forceinline__ int win_src_col_i8(int np) { return win_src_col(tmap_i8(np >> 8) * 256 + (np & 255)); }
__device__ __forceinline__ void transpose_item(const float* __restrict__ W, int ldw, int K, bf16* __restrict__ WT, int n0p, int k0, int col, LAS float* scr, int lane) {
#pragma unroll 8
    for (int i = 0; i < 32; ++i) { const int kk = 2 * i + (lane >> 5); scr[kk * 33 + (lane & 31)] = (col >= 0) ? W[(size_t)(k0 + kk) * ldw + col] : 0.f; }
    LDS_WAIT(); asm volatile("" ::: "memory");
    const int c = lane & 7;
#pragma unroll
    for (int j = 0; j < 4; ++j) { const int n = (lane >> 3) + 8 * j; const LAS float* s = scr + (8 * c) * 33 + n;
        u32x4 o; o.x = cvt_pk(s[0 * 33], s[1 * 33]); o.y = cvt_pk(s[2 * 33], s[3 * 33]); o.z = cvt_pk(s[4 * 33], s[5 * 33]); o.w = cvt_pk(s[6 * 33], s[7 * 33]);
        *(u32x4*)(WT + (size_t)(n0p + n) * K + k0 + 8 * c) = o; }
    LDS_WAIT(); asm volatile("" ::: "memory");
}

__device__ __forceinline__ void phase0(const Args& a, LAS unsigned char* lds) {
    const int tid = threadIdx.x, lane = tid & 63, wave = __builtin_amdgcn_readfirstlane(tid >> 6);
    unsigned char* ws = a.ws;
    for (size_t i = (size_t)blockIdx.x * NTHREADS + tid; i < ZERO_BYTES / 16; i += (size_t)gridDim.x * NTHREADS) ((u32x4*)ws)[i] = u32x4{0u, 0u, 0u, 0u};
    {
        LAS float* scr = (LAS float*)(lds + wave * 16384);
        const int gw = blockIdx.x * NWAVES + wave, NGW = gridDim.x * NWAVES;
        constexpr int I0 = 16 * NBFG  , I1 = 0, I2 = 0  , I3 = 0  , I4 = 0  , I5 = 0  , I6 = 32 * 4, I7 = 32 * 4;
        constexpr int NIT = I0 + I1 + I2 + I3 + I4 + I5 + I6 + I7;
        for (int it = gw; it < NIT; it += NGW) {
            int r = it;
            if (r < I0) { const int kb = r / (NBFG > 0 ? NBFG : 1), nb = r % (NBFG > 0 ? NBFG : 1), np = nb * 32 + (lane & 31);
                transpose_item(a.in[I_WIN], DIN, DM, (bf16*)(ws + WS_WIN), nb * 32, kb * 64, win_src_col_bf(np), scr, lane); continue; } r -= I0;
            if (r < I1) { const int kb = r / 32, nb = r % 32;
                transpose_item(a.in[I_WOA], DM, 512, (bf16*)(ws + WS_WOA), nb * 32, kb * 64, nb * 32 + (lane & 31), scr, lane); continue; } r -= I1;
            if (r < I2) { const int kb = r / 32, nb = r % 32;
                transpose_item(a.in[I_WOB], DM, 512, (bf16*)(ws + WS_WOB), nb * 32, kb * 64, nb * 32 + (lane & 31), scr, lane); continue; } r -= I2;
            if (r < I3) { const int kb = r / 32, nb = r % 32;
                transpose_item(a.in[I_WOUT], DM, DM, (bf16*)(ws + WS_WOUT), nb * 32, kb * 64, nb * 32 + (lane & 31), scr, lane); continue; } r -= I3;
            if (r < I4) { const int kb = r / 176, nb = r % 176, np0 = nb * 32, T = np0 >> 8, rr = np0 & 255;
                const float* src = (rr < 128) ? a.in[I_WFG] : a.in[I_WFU];
                transpose_item(src, DFF, DM, (bf16*)(ws + WS_WGU), np0, kb * 64, T * 128 + (rr & 127) + (lane & 31), scr, lane); continue; } r -= I4;
            if (r < I5) { const int kb = r / 32, nb = r % 32;
                transpose_item(a.in[I_WFD], DM, DFF, (bf16*)(ws + WS_WD), nb * 32, kb * 64, nb * 32 + (lane & 31), scr, lane); continue; } r -= I5;
            if (r < I6) { const int kb = r / 4, nb = r % 4;
                transpose_item(a.in[I_WCK1], 128, 2048, (bf16*)(ws + WS_WCK1), nb * 32, kb * 64, nb * 32 + (lane & 31), scr, lane); continue; } r -= I6;
            { const int kb = r / 4, nb = r % 4;
                transpose_item(a.in[I_WCV1], 128, 2048, (bf16*)(ws + WS_WCV1), nb * 32, kb * 64, nb * 32 + (lane & 31), scr, lane); }
        }
    }
    LAS float* sc = (LAS float*)lds;
    for (int it = blockIdx.x; it < 208 + 176 + NI8G + 32 + 96; it += gridDim.x) {
        __syncthreads();
        if (it >= 208 + 176 + NI8G + 32) {
            const int j = it - (208 + 176 + NI8G + 32), which = j >> 5, col = (j & 31) * 32 + (lane & 31);
            const float* W = a.in[which == 0 ? I_WOUT : (which == 1 ? I_WOA : I_WOB)]; const int kw = which == 0 ? 128 : 64;
            float m = 0.f, s2 = 0.f;
#pragma unroll 8
            for (int i = 0; i < kw / 2; ++i) { const int k = kw * wave + 2 * i + (lane >> 5); const float v = W[(size_t)k * DM + col]; m = fmaxf(m, fabsf(v)); s2 += v * v; }
            m = fmaxf(m, __shfl_xor(m, 32)); s2 += __shfl_xor(s2, 32);
            if (lane < 32) { sc[wave * 32 + lane] = m; sc[256 + wave * 32 + lane] = s2; }
            __syncthreads();
            if (tid < 32) { float mm = 0.f, ss = 0.f;
#pragma unroll
                for (int w = 0; w < 8; ++w) { mm = fmaxf(mm, sc[w * 32 + tid]); ss += sc[256 + w * 32 + tid]; }
                if (which == 0) ((float*)(ws + WS_SBO))[(j & 31) * 32 + tid] = (mm > 0.f) ? mm * (1.f / 448.f) : 1.f;
                else { ((float*)(ws + WS_SBWO))[(which - 1) * 1024 + (j & 31) * 32 + tid] = (mm > 0.f) ? mm * (1.f / 448.f) : 1.f;
                    float cn = sqrtf(ss) * 1.0635f;
#pragma unroll
                    for (int o = 1; o < 32; o <<= 1) cn = fmaxf(cn, __shfl_xor(cn, o));
                    if (tid == 0) ((float*)(ws + WS_WNI))[176 + (which - 1) * 32 + (j & 31)] = cn; } }
        } else if (it >= 208 + 176 + NI8G) {
            const int g32 = it - 208 - 176 - NI8G, col = g32 * 32 + (lane & 31); const float* W = a.in[I_WFD];
            float m = 0.f;
#pragma unroll 8
            for (int i = 0; i < 176; ++i) { const int k = 352 * wave + 2 * i + (lane >> 5); m = fmaxf(m, fabsf(W[(size_t)k * DM + col])); }
            m = fmaxf(m, __shfl_xor(m, 32));
            if (lane < 32) sc[wave * 32 + lane] = m;
            __syncthreads();
            if (tid < 32) { float mm = 0.f;
#pragma unroll
                for (int w = 0; w < 8; ++w) mm = fmaxf(mm, sc[w * 32 + tid]);
                ((float*)(ws + WS_SBD))[g32 * 32 + tid] = (mm > 0.f) ? mm * (1.f / 448.f) : 1.f; }
        } else if (it >= 208 + 176) {
            const int g32 = it - 208 - 176, col = win_src_col_i8(g32 * 32 + (lane & 31)); const float* W = a.in[I_WIN];
            float m = 0.f;
#pragma unroll 8
            for (int i = 0; i < 64; ++i) { const int k = 128 * wave + 2 * i + (lane >> 5); const float v = (col >= 0) ? W[(size_t)k * DIN + col] : 0.f; m = fmaxf(m, fabsf(v)); }
            m = fmaxf(m, __shfl_xor(m, 32));
            if (lane < 32) sc[wave * 32 + lane] = m;
            __syncthreads();
            if (tid < 32) { float mm = 0.f;
#pragma unroll
                for (int w = 0; w < 8; ++w) mm = fmaxf(mm, sc[w * 32 + tid]);
                ((float*)(ws + WS_SBWIN))[g32 * 32 + tid] = (mm > 0.f) ? mm * (1.f / 127.f) : 1.f; }
        } else if (it >= 208) {
            const int g32 = it - 208, np0 = g32 * 32, T = np0 >> 8, rr = np0 & 255; const float* W = (rr < 128) ? a.in[I_WFG] : a.in[I_WFU];
            const int col = T * 128 + (rr & 127) + (lane & 31);
            float m = 0.f, s2 = 0.f;
#pragma unroll 8
            for (int i = 0; i < 64; ++i) { const int k = 128 * wave + 2 * i + (lane >> 5); const float v = W[(size_t)k * DFF + col]; m = fmaxf(m, fabsf(v)); s2 += v * v; }
            m = fmaxf(m, __shfl_xor(m, 32)); s2 += __shfl_xor(s2, 32);
            if (lane < 32) { sc[wave * 32 + lane] = m; sc[256 + wave * 32 + lane] = s2; }
            __syncthreads();
            if (tid < 32) { float mm = 0.f, ss = 0.f;
#pragma unroll
                for (int w = 0; w < 8; ++w) { mm = fmaxf(mm, sc[w * 32 + tid]); ss += sc[256 + w * 32 + tid]; }
                const float sb = (mm > 0.f) ? mm * (1.f / 127.f) : 1.f;
                ((float*)(ws + WS_SBWGU))[g32 * 32 + tid] = sb;
                float cn = sqrtf(ss) * 1.0001f + 16.f * sb;
#pragma unroll
                for (int o = 1; o < 32; o <<= 1) cn = fmaxf(cn, __shfl_xor(cn, o));
                if (tid == 0) ((float*)(ws + WS_WNI))[g32] = cn; }
        } else if (it < 192) {
            const float* c = a.in[I_C];
            for (int i = tid; i < NB * DM; i += NTHREADS) { const int bb = i >> 10, kk = i & 1023; sc[kk * 32 + bb] = siluf_(c[i]); }
            __syncthreads();
            const int cl = tid & 31, ks = tid >> 5, col = it * 32 + cl;
            float acc[32];
#pragma unroll
            for (int j = 0; j < 32; ++j) acc[j] = 0.f;
            const float* W = a.in[I_WADA] + (size_t)(ks * 64) * NADA + col;
#pragma unroll 1
            for (int k0 = 0; k0 < 64; k0 += 8) {
                float w[8];
#pragma unroll
                for (int u = 0; u < 8; ++u) w[u] = W[(size_t)(k0 + u) * NADA];
#pragma unroll
                for (int u = 0; u < 8; ++u) { const LAS f32x4* sp = (const LAS f32x4*)(sc + (ks * 64 + k0 + u) * 32);
#pragma unroll
                    for (int q = 0; q < 8; ++q) { const f32x4 v = sp[q]; acc[4 * q] += v.x * w[u]; acc[4 * q + 1] += v.y * w[u]; acc[4 * q + 2] += v.z * w[u]; acc[4 * q + 3] += v.w * w[u]; } }
            }
            __syncthreads();
#pragma unroll
            for (int j = 0; j < 32; ++j) sc[(ks * 32 + j) * 32 + cl] = acc[j];
            __syncthreads();
            float* mod = (float*)(ws + WS_MOD);
            for (int o = tid; o < 1024; o += NTHREADS) { const int b = o >> 5, c2 = o & 31;
                float s2 = 0.f;
#pragma unroll
                for (int q = 0; q < 16; ++q) s2 += sc[(q * 32 + b) * 32 + c2];
                mod[b * NADA + it * 32 + c2] = s2 + a.in[I_BADA][it * 32 + c2]; }
        } else {
            const int which = (it - 192) >> 3, kq = (it - 192) & 7;
            const float* pe = a.in[which ? I_PECV : I_PECK]; const float* w1 = a.in[which ? I_WCV1 : I_WCK1];
            const int col = tid & 127, ks = tid >> 7; float s = 0.f;
#pragma unroll 8
            for (int k = kq * 256 + ks * 64; k < kq * 256 + ks * 64 + 64; ++k) s += pe[k] * w1[(size_t)k * 128 + col];
            sc[ks * 128 + col] = s;
            __syncthreads();
            if (tid < 128) ((float*)(ws + WS_BIAS))[(which * 8 + kq) * 128 + tid] = sc[tid] + sc[128 + tid] + sc[256 + tid] + sc[384 + tid];
        }
    }
    __syncthreads();
}

__device__ __forceinline__ void transpose_item_i8(const float* __restrict__ W, int ldw, int K, signed char* __restrict__ WQ, const float* __restrict__ SB, int n0p, int k0, int col, LAS float* scr, int lane) {
#pragma unroll 8
    for (int i = 0; i < 32; ++i) { const int kk = 2 * i + (lane >> 5); scr[kk * 33 + (lane & 31)] = (col >= 0) ? W[(size_t)(k0 + kk) * ldw + col] : 0.f; }
    LDS_WAIT(); asm volatile("" ::: "memory");
    const int n = lane >> 1, kh = (lane & 1) * 32; const float inv = 1.f / SB[n0p + n];
#pragma unroll
    for (int c = 0; c < 2; ++c) { unsigned w[4];
#pragma unroll
        for (int d = 0; d < 4; ++d) { unsigned pk = 0u;
#pragma unroll
            for (int j = 0; j < 4; ++j) { const float v = scr[(kh + 16 * c + 4 * d + j) * 33 + n] * inv; int q = (int)rintf(v); q = q > 127 ? 127 : (q < -127 ? -127 : q); pk |= ((unsigned)q & 0xffu) << (8 * j); }
            w[d] = pk; }
        *(u32x4*)(WQ + (size_t)(n0p + n) * K + k0 + kh + 16 * c) = u32x4{w[0], w[1], w[2], w[3]}; }
    LDS_WAIT(); asm volatile("" ::: "memory");
}
__device__ __forceinline__ void wing_quant_items(const Args& a, LAS unsigned char* lds) {
    const int tid = threadIdx.x, lane = tid & 63, wave = __builtin_amdgcn_readfirstlane(tid >> 6); unsigned char* ws = a.ws;
    LAS float* scr = (LAS float*)(lds + wave * 16384);
    const int gw = blockIdx.x * NWAVES + wave, NGW = gridDim.x * NWAVES;
    for (int it = gw; it < 16 * NI8G; it += NGW) { const int kb = it / NI8G, nb = it % NI8G;
        transpose_item_i8(a.in[I_WIN], DIN, DM, (signed char*)(ws + WS_WINGQ), (const float*)(ws + WS_SBWIN), nb * 32, kb * 64, win_src_col_i8(nb * 32 + (lane & 31)), scr, lane); }
}
__device__ __forceinline__ void wgu_quant_items(const Args& a, LAS unsigned char* lds) {
    const int tid = threadIdx.x, lane = tid & 63, wave = __builtin_amdgcn_readfirstlane(tid >> 6); unsigned char* ws = a.ws;
    LAS float* scr = (LAS float*)(lds + wave * 16384);
    const int gw = blockIdx.x * NWAVES + wave, NGW = gridDim.x * NWAVES;
    for (int it = gw; it < 16 * 176; it += NGW) { const int kb = it / 176, nb = it % 176, np0 = nb * 32, T = np0 >> 8, rr = np0 & 255;
        const float* src = (rr < 128) ? a.in[I_WFG] : a.in[I_WFU];
        transpose_item_i8(src, DFF, DM, (signed char*)(ws + WS_WGU), (const float*)(ws + WS_SBWGU), np0, kb * 64, T * 128 + (rr & 127) + (lane & 31), scr, lane); }
}
__device__ __forceinline__ void transpose_item_f8(const float* __restrict__ W, int ldw, int K, unsigned char* __restrict__ WQ, const float* __restrict__ SB, int n0p, int k0, int col, LAS float* scr, int lane) {
#pragma unroll 8
    for (int i = 0; i < 32; ++i) { const int kk = 2 * i + (lane >> 5); scr[kk * 33 + (lane & 31)] = W[(size_t)(k0 + kk) * ldw + col]; }
    LDS_WAIT(); asm volatile("" ::: "memory");
    const int n = lane >> 1, kh = (lane & 1) * 32; const float inv = 1.f / SB[n0p + n];
#pragma unroll
    for (int c = 0; c < 2; ++c) { unsigned w[4];
#pragma unroll
        for (int d = 0; d < 4; ++d) { const LAS float* sp = scr + (kh + 16 * c + 4 * d) * 33 + n;
            int pk = __builtin_amdgcn_cvt_pk_fp8_f32(sp[0] * inv, sp[33] * inv, 0, false); pk = __builtin_amdgcn_cvt_pk_fp8_f32(sp[66] * inv, sp[99] * inv, pk, true);
            w[d] = (unsigned)pk; }
        *(u32x4*)(WQ + (size_t)(n0p + n) * K + k0 + kh + 16 * c) = u32x4{w[0], w[1], w[2], w[3]}; }
    LDS_WAIT(); asm volatile("" ::: "memory");
}
__device__ __forceinline__ void wd_quant_items(const Args& a, LAS unsigned char* lds) {
    const int tid = threadIdx.x, lane = tid & 63, wave = __builtin_amdgcn_readfirstlane(tid >> 6); unsigned char* ws = a.ws;
    LAS float* scr = (LAS float*)(lds + wave * 16384);
    const int gw = blockIdx.x * NWAVES + wave, NGW = gridDim.x * NWAVES;
    for (int it = gw; it < 44 * 32; it += NGW) { const int kb = it / 32, nb = it % 32;
        transpose_item_f8(a.in[I_WFD], DM, DFF, ws + WS_WD, (const float*)(ws + WS_SBD), nb * 32, kb * 64, nb * 32 + (lane & 31), scr, lane); }
}
__device__ __forceinline__ void woab_quant_items(const Args& a, LAS unsigned char* lds) {
    const int tid = threadIdx.x, lane = tid & 63, wave = __builtin_amdgcn_readfirstlane(tid >> 6); unsigned char* ws = a.ws;
    LAS float* scr = (LAS float*)(lds + wave * 16384);
    const int gw = blockIdx.x * NWAVES + wave, NGW = gridDim.x * NWAVES;
    for (int it = gw; it < 2 * 8 * 32; it += NGW) { const int which = it >> 8, r = it & 255, kb = r / 32, nb = r % 32;
        transpose_item_f8(a.in[which ? I_WOB : I_WOA], DM, 512, ws + WS_WOA, (const float*)(ws + WS_SBWO), which * 1024 + nb * 32, kb * 64, nb * 32 + (lane & 31), scr, lane); }
}
__device__ __forceinline__ void wout_quant_items(const Args& a, LAS unsigned char* lds) {
    const int tid = threadIdx.x, lane = tid & 63, wave = __builtin_amdgcn_readfirstlane(tid >> 6); unsigned char* ws = a.ws;
    LAS float* scr = (LAS float*)(lds + wave * 16384);
    const int gw = blockIdx.x * NWAVES + wave, NGW = gridDim.x * NWAVES;
    for (int it = gw; it < 16 * 32; it += NGW) { const int kb = it / 32, nb = it % 32;
        transpose_item_f8(a.in[I_WOUT], DM, DM, ws + WS_WOUT, (const float*)(ws + WS_SBO), nb * 32, kb * 64, nb * 32 + (lane & 31), scr, lane); }
}
__device__ __forceinline__ void wnmax_item(unsigned char* ws) {
    const int lane = threadIdx.x & 63; const float* wni = (const float*)(ws + WS_WNI);
    float g = 0.f, u = 0.f;
    for (int i = lane; i < 176; i += 64) { const float v = wni[i]; if ((i & 7) < 4) g = fmaxf(g, v); else u = fmaxf(u, v); }
    float oa = (lane < 32) ? wni[176 + lane] : 0.f, ob = (lane < 32) ? wni[208 + lane] : 0.f;
    g = wave_max_dpp(g); u = wave_max_dpp(u); oa = wave_max_dpp(oa); ob = wave_max_dpp(ob);
    if (lane == 0) *(f32x4*)(ws + WS_WNMAX) = f32x4{g, u, oa, ob};
}
__device__ __forceinline__ void norm2_quant_phase(const bf16* __restrict__ X1B, const float* __restrict__ rowss, const float* __restrict__ gain, const float* __restrict__ mod, signed char* __restrict__ Q, float* __restrict__ SA, float* __restrict__ SACT, const float* __restrict__ wnmax) {
    const int tid = threadIdx.x, lane = tid & 63, wave = tid >> 6;
    const int gw = blockIdx.x * NWAVES + wave, NGW = gridDim.x * NWAVES, wpb = NGW / NB;
    if (wpb * NB != NGW || gw >= wpb * NB) return;
    const int b = gw / wpb, wi = gw % wpb;
    float mg[2][8], sh[2][8];
#pragma unroll
    for (int j = 0; j < 2; ++j) { const int k = 8 * lane + 512 * j;
#pragma unroll
        for (int h = 0; h < 2; ++h) { const f32x4 g = *(const f32x4*)(gain + k + 4 * h), sc = *(const f32x4*)(mod + b * NADA + 4 * DM + k + 4 * h), s2 = *(const f32x4*)(mod + b * NADA + 3 * DM + k + 4 * h);
            mg[j][4 * h] = g.x * (1.f + sc.x); mg[j][4 * h + 1] = g.y * (1.f + sc.y); mg[j][4 * h + 2] = g.z * (1.f + sc.z); mg[j][4 * h + 3] = g.w * (1.f + sc.w);
            sh[j][4 * h] = s2.x; sh[j][4 * h + 1] = s2.y; sh[j][4 * h + 2] = s2.z; sh[j][4 * h + 3] = s2.w; } }
    const float wprod = wnmax[0] * wnmax[1] * (1.f / 440.f);
    u32x4 qn[2]; float rsn;
    { const size_t m0 = (size_t)b * SEQ + wi; const u32x4* xr = (const u32x4*)(X1B + m0 * DM) + lane; qn[0] = xr[0]; qn[1] = xr[64]; rsn = rowss[m0]; }
    for (int t = wi; t < SEQ; t += wpb) {
        const size_t m = (size_t)b * SEQ + t;
        const u32x4 q0 = qn[0], q1 = qn[1]; const float rstd = rsqrtf(rsn * (1.f / DM) + RMS_EPS);
        if (t + wpb < SEQ) { const u32x4* xr = (const u32x4*)(X1B + (m + wpb) * DM) + lane; qn[0] = xr[0]; qn[1] = xr[64]; rsn = rowss[m + wpb]; }
        float v[2][8]; float amax = 0.f, vss = 0.f;
#pragma unroll
        for (int j = 0; j < 2; ++j) { const u32x4 q = j ? q1 : q0; const unsigned w[4] = {q.x, q.y, q.z, q.w};
#pragma unroll
            for (int e = 0; e < 8; ++e) { const float x = __uint_as_float((e & 1) ? (w[e >> 1] & 0xffff0000u) : (w[e >> 1] << 16));
                v[j][e] = x * rstd * mg[j][e] + sh[j][e]; amax = fmaxf(amax, fabsf(v[j][e])); vss += v[j][e] * v[j][e]; } }
        amax = wave_max_dpp(amax); vss = wave_sum_dpp(vss);
        const float inv = (amax > 0.f) ? 127.f / amax : 0.f;
        u32x2* q8 = (u32x2*)(Q + m * DM) + lane;
#pragma unroll
        for (int j = 0; j < 2; ++j) { unsigned pk[2];
#pragma unroll
            for (int d = 0; d < 2; ++d) { unsigned p = 0u;
#pragma unroll
                for (int e = 0; e < 4; ++e) p |= ((unsigned)(int)rintf(v[j][4 * d + e] * inv) & 0xffu) << (8 * e);
                pk[d] = p; }
            q8[64 * j] = u32x2{pk[0], pk[1]}; }
        if (lane == 0) { const float sa = (amax > 0.f) ? amax * (1.f / 127.f) : 1.f; SA[m] = sa;
            const float hn = sqrtf(vss) * 1.0001f + 16.f * sa;
            const float bd = hn * hn * wprod; SACT[m] = (bd > 0.f) ? bd : 1.f; }
    }
}

__device__ __forceinline__ void norm_dual_phase(const float* __restrict__ X, const float* __restrict__ gain, const float* __restrict__ mod, int shift_off, int scale_off, bf16* __restrict__ O, signed char* __restrict__ Q, float* __restrict__ SA) {
    const int tid = threadIdx.x, lane = tid & 63, wave = tid >> 6;
    const int gw = blockIdx.x * NWAVES + wave, NGW = gridDim.x * NWAVES, wpb = NGW / NB;
    if (wpb * NB != NGW || gw >= wpb * NB) return;
    const int b = gw / wpb, wi = gw % wpb;
    f32x4 mg[4], sh[4];
#pragma unroll
    for (int q = 0; q < 4; ++q) { const int k = 8 * lane + 512 * (q >> 1) + 4 * (q & 1);
        const f32x4 g = *(const f32x4*)(gain + k), sc = *(const f32x4*)(mod + b * NADA + scale_off + k); sh[q] = *(const f32x4*)(mod + b * NADA + shift_off + k);
        mg[q] = f32x4{g.x * (1.f + sc.x), g.y * (1.f + sc.y), g.z * (1.f + sc.z), g.w * (1.f + sc.w)}; }
    f32x4 vn[4];
    { const f32x4* xr = (const f32x4*)(X + ((size_t)b * SEQ + wi) * DM) + 2 * lane;
#pragma unroll
      for (int j = 0; j < 2; ++j) { vn[2 * j] = __builtin_nontemporal_load(xr + 128 * j); vn[2 * j + 1] = __builtin_nontemporal_load(xr + 128 * j + 1); } }
    for (int t = wi; t < SEQ; t += wpb) {
        const size_t m = (size_t)b * SEQ + t;
        f32x4 v[4]; float s = 0.f;
#pragma unroll
        for (int j = 0; j < 4; ++j) { v[j] = vn[j]; s += (v[j].x * v[j].x + v[j].y * v[j].y) + (v[j].z * v[j].z + v[j].w * v[j].w); }
        if (t + wpb < SEQ) { const f32x4* xr = (const f32x4*)(X + (m + wpb) * DM) + 2 * lane;
#pragma unroll
            for (int j = 0; j < 2; ++j) { vn[2 * j] = __builtin_nontemporal_load(xr + 128 * j); vn[2 * j + 1] = __builtin_nontemporal_load(xr + 128 * j + 1); } }
        const float rstd = rsqrtf(wave_sum_dpp(s) * (1.f / DM) + RMS_EPS);
        float amax = 0.f;
#pragma unroll
        for (int q = 0; q < 4; ++q) {
            v[q].x = v[q].x * rstd * mg[q].x + sh[q].x; v[q].y = v[q].y * rstd * mg[q].y + sh[q].y; v[q].z = v[q].z * rstd * mg[q].z + sh[q].z; v[q].w = v[q].w * rstd * mg[q].w + sh[q].w;
            amax = fmaxf(fmaxf(amax, fmaxf(fabsf(v[q].x), fabsf(v[q].y))), fmaxf(fabsf(v[q].z), fabsf(v[q].w)));
        }
        u32x4* o16 = (u32x4*)(O + m * DM) + lane;
#pragma unroll
        for (int j = 0; j < 2; ++j) o16[64 * j] = u32x4{cvt_pk(v[2 * j].x, v[2 * j].y), cvt_pk(v[2 * j].z, v[2 * j].w), cvt_pk(v[2 * j + 1].x, v[2 * j + 1].y), cvt_pk(v[2 * j + 1].z, v[2 * j + 1].w)};
        amax = wave_max_dpp(amax);
        const float inv = (amax > 0.f) ? 127.f / amax : 0.f;
        u32x2* q8 = (u32x2*)(Q + m * DM) + lane;
#pragma unroll
        for (int j = 0; j < 2; ++j) { unsigned pk[2];
#pragma unroll
            for (int d = 0; d < 2; ++d) { const f32x4 tt = v[2 * j + d]; const int q0 = (int)rintf(tt.x * inv), q1 = (int)rintf(tt.y * inv), q2 = (int)rintf(tt.z * inv), q3 = (int)rintf(tt.w * inv);
                pk[d] = ((unsigned)q0 & 0xffu) | (((unsigned)q1 & 0xffu) << 8) | (((unsigned)q2 & 0xffu) << 16) | (((unsigned)q3 & 0xffu) << 24); }
            q8[64 * j] = u32x2{pk[0], pk[1]}; }
        if (lane == 0) SA[m] = (amax > 0.f) ? amax * (1.f / 127.f) : 1.f;
    }
}

typedef const pg8::f32x4 (&AccRef)[2][2][4][2];

template <bool I8> struct EpiProj {
    static constexpr bool PERM = true, AFTER_DRAIN = false;
    unsigned char* ws; const float *g_q_a, *g_ks_a, *g_kw_a, *g_q_b, *g_k_b;
    __device__ __forceinline__ void operator()(AccRef acc_c, const pg8::Unit& u, int wr, int wc, int fr, int fq) const {
        const int T = I8 ? tmap_i8(u.pn) : tmap_bf(u.pn), row0 = u.pm * 256 + wr * 64 + fr, b = (u.pm * 256) >> 11;
        pg8::f32x4 (&acc)[2][2][4][2] = const_cast<pg8::f32x4 (&)[2][2][4][2]>(acc_c);
        if (I8) {
            const float* SA = (const float*)(ws + WS_SA1); const float* SB = (const float*)(ws + WS_SBWIN) + u.pn * 256 + wc * 32 + 8 * fq;
            f32x4 sb[2][2];
#pragma unroll
            for (int bj = 0; bj < 2; ++bj)
#pragma unroll
                for (int n = 0; n < 2; ++n) sb[bj][n] = *(const f32x4*)(SB + bj * 128 + 4 * n);
#pragma unroll
            for (int ai = 0; ai < 2; ++ai)
#pragma unroll
                for (int m = 0; m < 4; ++m) { const float sa = SA[row0 + ai * 128 + m * 16];
#pragma unroll
                    for (int bj = 0; bj < 2; ++bj)
#pragma unroll
                        for (int n = 0; n < 2; ++n) { acc[ai][bj][m][n][0] *= sa * sb[bj][n].x; acc[ai][bj][m][n][1] *= sa * sb[bj][n].y; acc[ai][bj][m][n][2] *= sa * sb[bj][n].z; acc[ai][bj][m][n][3] *= sa * sb[bj][n].w; } }
        }
        if (T >= 10) {
            unsigned char* G = ws + (T >= 14 ? WS_GB : WS_GA); const int cbase = ((T - 10) & 3) * 256 + wc * 32 + 8 * fq;
#pragma unroll
            for (int ai = 0; ai < 2; ++ai)
#pragma unroll
                for (int m = 0; m < 4; ++m) { const size_t row = row0 + ai * 128 + m * 16;
#pragma unroll
                    for (int bj = 0; bj < 2; ++bj) { const pg8::f32x4 v0 = acc[ai][bj][m][0], v1 = acc[ai][bj][m][1];
#define GLOGIT(x) __builtin_amdgcn_fmed3f((x) * 16.f, -440.f, 440.f)
                        int w0 = __builtin_amdgcn_cvt_pk_fp8_f32(GLOGIT(v0[0]), GLOGIT(v0[1]), 0, false); w0 = __builtin_amdgcn_cvt_pk_fp8_f32(GLOGIT(v0[2]), GLOGIT(v0[3]), w0, true);
                        int w1 = __builtin_amdgcn_cvt_pk_fp8_f32(GLOGIT(v1[0]), GLOGIT(v1[1]), 0, false); w1 = __builtin_amdgcn_cvt_pk_fp8_f32(GLOGIT(v1[2]), GLOGIT(v1[3]), w1, true);
#undef GLOGIT
                        *(u32x2*)(G + row * 1024 + cbase + bj * 128) = u32x2{(unsigned)w0, (unsigned)w1}; } }
            return;
        }
        const int slot = wc;
        if (T == 7 && slot == 3) {
            float* GN = (float*)(ws + WS_GN); float* IW = (float*)(ws + WS_IW);
#pragma unroll
            for (int ai = 0; ai < 2; ++ai)
#pragma unroll
                for (int m = 0; m < 4; ++m) { const size_t row = row0 + ai * 128 + m * 16; const pg8::f32x4 v0 = acc[ai][0][m][0], v1 = acc[ai][0][m][1];
                    if (fq < 3) { f32x4 a0 = {sigmoidf_(v0[0]), sigmoidf_(v0[1]), sigmoidf_(v0[2]), sigmoidf_(v0[3])}, a1 = {sigmoidf_(v1[0]), sigmoidf_(v1[1]), sigmoidf_(v1[2]), sigmoidf_(v1[3])};
                        *(f32x4*)(GN + row * 24 + 8 * fq) = a0; *(f32x4*)(GN + row * 24 + 8 * fq + 4) = a1; }
                    else { const float s = 0.35355339059327373f; f32x4 a0 = {v0[0] * s, v0[1] * s, v0[2] * s, v0[3] * s}, a1 = {v1[0] * s, v1[1] * s, v1[2] * s, v1[3] * s};
                        *(f32x4*)(IW + row * 8) = a0; *(f32x4*)(IW + row * 8 + 4) = a1; } }
            return;
        }
        const float* gain = nullptr; float scale = 1.f; bf16* dst; size_t pitch, extra;
        switch (T) {
            case 0: case 1: gain = g_q_a; scale = QSCALE; dst = (bf16*)(ws + WS_QA); pitch = 512; extra = (size_t)(T * 4 + slot) * 64; break;
            case 5: case 6: gain = g_q_b; scale = QSCALE; dst = (bf16*)(ws + WS_QB); pitch = 512; extra = (size_t)((T - 5) * 4 + slot) * 64; break;
            case 8: case 9: scale = 0.125f; dst = (bf16*)(ws + WS_IQ); pitch = 512; extra = (size_t)((T - 8) * 4 + slot) * 64; break;
            case 2: dst = (bf16*)(ws + (slot < 2 ? WS_KC : WS_VC)); pitch = 64; extra = (size_t)(b + (slot & 1)) * SEQ * 64; break;
            case 3: if (slot < 2) gain = g_ks_a; dst = (bf16*)(ws + (slot < 2 ? WS_KS : WS_VS)); pitch = 64; extra = (size_t)(b + (slot & 1)) * SEQ * 64; break;
            case 4: if (slot < 2) gain = g_kw_a; dst = (bf16*)(ws + (slot < 2 ? WS_KW : WS_VW)); pitch = 64; extra = (size_t)(b + (slot & 1)) * SEQ * 64; break;
            default: if (slot == 0) gain = g_k_b; dst = (bf16*)(ws + (slot == 0 ? WS_KB : (slot == 1 ? WS_VB : WS_IK))); pitch = 64; extra = 0; break;
        }
        const int vidx = ((T == 3 || T == 4) && slot >= 2) ? (T - 2) : ((T == 7 && slot == 1) ? 3 : -1);
        float vmx = 0.f;
        float gv[2][8];
#pragma unroll
        for (int bj = 0; bj < 2; ++bj)
#pragma unroll
            for (int e = 0; e < 8; ++e) gv[bj][e] = gain ? gain[32 * bj + 8 * fq + e] * scale : scale;
#pragma unroll
        for (int ai = 0; ai < 2; ++ai)
#pragma unroll
            for (int m = 0; m < 4; ++m) { const size_t row = row0 + ai * 128 + m * 16;
                float rstd = 1.f;
                if (gain) { float ss = 0.f;
#pragma unroll
                    for (int bj = 0; bj < 2; ++bj)
#pragma unroll
                        for (int n = 0; n < 2; ++n) { const pg8::f32x4 v = acc[ai][bj][m][n]; ss += (v[0] * v[0] + v[1] * v[1]) + (v[2] * v[2] + v[3] * v[3]); }
                    ss += __shfl_xor(ss, 16); ss += __shfl_xor(ss, 32);
                    rstd = rsqrtf(ss * (1.f / 64.f) + RMS_EPS); }
#pragma unroll
                for (int bj = 0; bj < 2; ++bj) { const pg8::f32x4 v0 = acc[ai][bj][m][0], v1 = acc[ai][bj][m][1]; u32x4 w;
                    w.x = cvt_pk(v0[0] * rstd * gv[bj][0], v0[1] * rstd * gv[bj][1]); w.y = cvt_pk(v0[2] * rstd * gv[bj][2], v0[3] * rstd * gv[bj][3]);
                    w.z = cvt_pk(v1[0] * rstd * gv[bj][4], v1[1] * rstd * gv[bj][5]); w.w = cvt_pk(v1[2] * rstd * gv[bj][6], v1[3] * rstd * gv[bj][7]);
                    if (vidx >= 0) vmx = fmaxf(fmaxf(fmaxf(vmx, fmaxf(fabsf(v0[0]), fabsf(v0[1]))), fmaxf(fabsf(v0[2]), fabsf(v0[3]))), fmaxf(fmaxf(fabsf(v1[0]), fabsf(v1[1])), fmaxf(fabsf(v1[2]), fabsf(v1[3]))));
                    *(u32x4*)(dst + row * pitch + extra + 32 * bj + 8 * fq) = w; } }
        if (vidx >= 0) { vmx = wave_max_dpp(vmx) * 1.004f; if ((threadIdx.x & 63) == 0) atomicMax((unsigned*)(ws + WS_VMAX) + vidx, __float_as_uint(vmx)); }
    }
};

template <bool SECOND> struct EpiY {
    static constexpr bool PERM = true, AFTER_DRAIN = false;
    const unsigned char* G; bf16* Y; unsigned char* Y8; const float* rna; const float* rnb; const float* wn; float so; const float* sbw;
    __device__ __forceinline__ void operator()(AccRef acc, const pg8::Unit& u, int wr, int wc, int fr, int fq) const {
        const int row0 = u.pm * 256 + wr * 64 + fr, col0 = u.pn * 256 + wc * 32 + 8 * fq;
        float cs[2][8];
#pragma unroll
        for (int bj = 0; bj < 2; ++bj) { const f32x4 c0 = *(const f32x4*)(sbw + col0 + bj * 128), c1 = *(const f32x4*)(sbw + col0 + bj * 128 + 4);
            const float so_ = so;
            cs[bj][0] = c0.x * so_; cs[bj][1] = c0.y * so_; cs[bj][2] = c0.z * so_; cs[bj][3] = c0.w * so_; cs[bj][4] = c1.x * so_; cs[bj][5] = c1.y * so_; cs[bj][6] = c1.z * so_; cs[bj][7] = c1.w * so_; }
        const float wa = wn[2], wb = wn[3];
        const unsigned gb0 = (unsigned)row0 * 2048u + (unsigned)col0 * 2u;
        u32x2 gq[2][2][2], yq[2][2]; float ra[2], rb[2]; u32x2 o8[2][2];
        unsigned char* YA = (unsigned char*)Y;
#define EPIY_ROW(qd, mm) ((unsigned)(((qd) >> 1) * 128 + (((qd) & 1) * 2 + (mm)) * 16))
#define EPIY_LOAD(qd, B) { _Pragma("unroll") for (int mm = 0; mm < 2; ++mm) { const unsigned rr = EPIY_ROW(qd, mm); \
            _Pragma("unroll") for (int bj = 0; bj < 2; ++bj) gq[B][mm][bj] = *(const u32x2*)(G + ((gb0 + rr * 2048u + (unsigned)bj * 256u) >> 1)); } }
#define EPIY_LOADY(qd) { _Pragma("unroll") for (int mm = 0; mm < 2; ++mm) { const unsigned rr = EPIY_ROW(qd, mm); \
            ra[mm] = *(const float*)((const char*)rna + ((unsigned)row0 + rr) * 4u); rb[mm] = *(const float*)((const char*)rnb + ((unsigned)row0 + rr) * 4u); \
            if (SECOND) { _Pragma("unroll") for (int bj = 0; bj < 2; ++bj) yq[mm][bj] = *(const u32x2*)(YA + ((gb0 + rr * 2048u + (unsigned)bj * 256u) >> 1)); } } }
#define EPIY_COMPUTE(qd, B) { typedef float f32x2g __attribute__((ext_vector_type(2))); _Pragma("unroll") for (int mm = 0; mm < 2; ++mm) { const float is_ = __builtin_amdgcn_rcpf(sy_scale(ra[mm], rb[mm], wa, wb)); \
            _Pragma("unroll") for (int bj = 0; bj < 2; ++bj) { \
            const u32x2 g2 = gq[B][mm][bj]; u32x2 y2 = {0u, 0u}; if (SECOND) y2 = yq[mm][bj]; \
            const f32x2g ga_ = __builtin_amdgcn_cvt_pk_f32_fp8((int)g2.x, false), gb_ = __builtin_amdgcn_cvt_pk_f32_fp8((int)g2.x, true), gc_ = __builtin_amdgcn_cvt_pk_f32_fp8((int)g2.y, false), gd_ = __builtin_amdgcn_cvt_pk_f32_fp8((int)g2.y, true); \
            const f32x2g ya_ = __builtin_amdgcn_cvt_pk_f32_fp8((int)y2.x, false), yb_ = __builtin_amdgcn_cvt_pk_f32_fp8((int)y2.x, true), yc_ = __builtin_amdgcn_cvt_pk_f32_fp8((int)y2.y, false), yd_ = __builtin_amdgcn_cvt_pk_f32_fp8((int)y2.y, true); \
            const float gl[8] = {ga_.x, ga_.y, gb_.x, gb_.y, gc_.x, gc_.y, gd_.x, gd_.y}; float gf[8]; \
            _Pragma("unroll") for (int e = 0; e < 8; ++e) gf[e] = __builtin_amdgcn_rcpf(1.f + __builtin_amdgcn_exp2f(gl[e] * (-LOG2E / 16.f)));     \
            const float yf[8] = {ya_.x, ya_.y, yb_.x, yb_.y, yc_.x, yc_.y, yd_.x, yd_.y}; \
            const pg8::f32x4 v0 = acc[(qd) >> 1][bj][((qd) & 1) * 2 + mm][0], v1 = acc[(qd) >> 1][bj][((qd) & 1) * 2 + mm][1]; float r[8]; \
            _Pragma("unroll") for (int e = 0; e < 8; ++e) { const float a_ = ((e < 4) ? v0[e] : v1[e - 4]) * cs[bj][e]; \
                r[e] = gf[e] * a_ * is_ + (SECOND ? yf[e] : 0.f); }       \
            int w0 = __builtin_amdgcn_cvt_pk_fp8_f32(r[0], r[1], 0, false); w0 = __builtin_amdgcn_cvt_pk_fp8_f32(r[2], r[3], w0, true); \
            int w1 = __builtin_amdgcn_cvt_pk_fp8_f32(r[4], r[5], 0, false); w1 = __builtin_amdgcn_cvt_pk_fp8_f32(r[6], r[7], w1, true); \
            o8[mm][bj] = u32x2{(unsigned)w0, (unsigned)w1}; } } \
        asm volatile("" :: "v"(o8[0][0]), "v"(o8[0][1]), "v"(o8[1][0]), "v"(o8[1][1]) : "memory"); }
#define EPIY_STORE(qd) { _Pragma("unroll") for (int mm = 0; mm < 2; ++mm) _Pragma("unroll") for (int bj = 0; bj < 2; ++bj) { const unsigned ob = (gb0 + EPIY_ROW(qd, mm) * 2048u + (unsigned)bj * 256u) >> 1; \
            *(u32x2*)((SECOND ? Y8 : YA) + ob) = o8[mm][bj]; } }
        EPIY_LOAD(0, 0) EPIY_LOAD(1, 1) EPIY_LOADY(0)
        EPIY_COMPUTE(0, 0) EPIY_LOAD(2, 0) EPIY_LOADY(1) EPIY_STORE(0)
        EPIY_COMPUTE(1, 1) EPIY_LOAD(3, 1) EPIY_LOADY(2) EPIY_STORE(1)
        EPIY_COMPUTE(2, 0) EPIY_LOADY(3) EPIY_STORE(2)
        EPIY_COMPUTE(3, 1) EPIY_STORE(3)
#undef EPIY_ROW
#undef EPIY_LOAD
#undef EPIY_LOADY
#undef EPIY_COMPUTE
#undef EPIY_STORE
    }
};

struct EpiX1 {
    static constexpr bool PERM = true, AFTER_DRAIN = false;
    const float* X; bf16* X1B; float* rowss; const float* mod; const float* rna; const float* rnb; const float* wn; const float* SBO;
    __device__ __forceinline__ void operator()(AccRef acc, const pg8::Unit& u, int wr, int wc, int fr, int fq) const {
        const int row0 = u.pm * 256 + wr * 64 + fr, col0 = u.pn * 256 + wc * 32 + 8 * fq, b = (u.pm * 256) >> 11;
        f32x4 gt[2][2];
#pragma unroll
        for (int bj = 0; bj < 2; ++bj)
#pragma unroll
            for (int n = 0; n < 2; ++n) { const f32x4 g = *(const f32x4*)(mod + b * NADA + 2 * DM + col0 + bj * 128 + 4 * n), sb = *(const f32x4*)(SBO + col0 + bj * 128 + 4 * n);
                gt[bj][n] = f32x4{g.x * sb.x, g.y * sb.y, g.z * sb.z, g.w * sb.w}; }
        const float wa = wn[2], wb = wn[3];
#pragma unroll
        for (int ai = 0; ai < 2; ++ai)
#pragma unroll
            for (int m = 0; m < 4; ++m) { const size_t row = row0 + ai * 128 + m * 16; float ss = 0.f; const float sy = sy_scale(rna[row], rnb[row], wa, wb);
#pragma unroll
                for (int bj = 0; bj < 2; ++bj) { const size_t off = row * 1024 + col0 + bj * 128; float x1[8];
#pragma unroll
                    for (int n = 0; n < 2; ++n) { const f32x4 xv = __builtin_nontemporal_load((const f32x4*)(X + off + 4 * n)); pg8::f32x4 v = acc[ai][bj][m][n]; v[0] *= sy; v[1] *= sy; v[2] *= sy; v[3] *= sy;
                        x1[4 * n] = xv.x + gt[bj][n].x * v[0]; x1[4 * n + 1] = xv.y + gt[bj][n].y * v[1]; x1[4 * n + 2] = xv.z + gt[bj][n].z * v[2]; x1[4 * n + 3] = xv.w + gt[bj][n].w * v[3]; }
#pragma unroll
                    for (int e2 = 0; e2 < 8; ++e2) ss += x1[e2] * x1[e2];
                    u32x4 w1; w1.x = cvt_pk(x1[0], x1[1]); w1.y = cvt_pk(x1[2], x1[3]); w1.z = cvt_pk(x1[4], x1[5]); w1.w = cvt_pk(x1[6], x1[7]);
                    *(u32x4*)(X1B + off) = w1; }
                ss += __shfl_xor(ss, 16); ss += __shfl_xor(ss, 32);
                if (fq == 0) unsafeAtomicAdd(rowss + row, ss); }
    }
};

struct EpiOut {
    static constexpr bool PERM = true, AFTER_DRAIN = false;
    const bf16* X1B; float* OUT; const float* mod; const float* SACT; const float* SBD;
    __device__ __forceinline__ void operator()(AccRef acc, const pg8::Unit& u, int wr, int wc, int fr, int fq) const {
        const int row0 = u.pm * 256 + wr * 64 + fr, col0 = u.pn * 256 + wc * 32 + 8 * fq, b = (u.pm * 256) >> 11;
        f32x4 gt[2][2];
#pragma unroll
        for (int bj = 0; bj < 2; ++bj)
#pragma unroll
            for (int n = 0; n < 2; ++n) { const f32x4 g = *(const f32x4*)(mod + b * NADA + 5 * DM + col0 + bj * 128 + 4 * n), sb = *(const f32x4*)(SBD + col0 + bj * 128 + 4 * n);
                gt[bj][n] = f32x4{g.x * sb.x, g.y * sb.y, g.z * sb.z, g.w * sb.w}; }
#pragma unroll
        for (int ai = 0; ai < 2; ++ai)
#pragma unroll
            for (int m = 0; m < 4; ++m) { const size_t row = row0 + ai * 128 + m * 16; const float sa = SACT[row];
#pragma unroll
                for (int bj = 0; bj < 2; ++bj) { const size_t off = row * 1024 + col0 + bj * 128;
                    const u32x4 xq = *(const u32x4*)(X1B + off); const unsigned xw[4] = {xq.x, xq.y, xq.z, xq.w};
#pragma unroll
                    for (int n = 0; n < 2; ++n) { pg8::f32x4 v = acc[ai][bj][m][n]; v[0] *= sa; v[1] *= sa; v[2] *= sa; v[3] *= sa;
                        const float x0 = __uint_as_float(xw[2 * n] << 16), x1 = __uint_as_float(xw[2 * n] & 0xffff0000u), x2 = __uint_as_float(xw[2 * n + 1] << 16), x3 = __uint_as_float(xw[2 * n + 1] & 0xffff0000u);
                        f32x4 o = {x0 + gt[bj][n].x * v[0], x1 + gt[bj][n].y * v[1], x2 + gt[bj][n].z * v[2], x3 + gt[bj][n].w * v[3]};
                        *(f32x4*)(OUT + off + 4 * n) = o; } } }
    }
};

struct PairOrder {
    pg8::StaticOrder base;
    __device__ __forceinline__ void init(int G, int c) { base.init(MROWS, DM, G, c); }
    __device__ __forceinline__ bool next(int i, pg8::Unit& u) const { if (!base.next(i >> 1, u)) return false; if (i & 1) { u.pm += 256; u.pn += 4; } return true; }
    __device__ __forceinline__ void a_ready(const pg8::Unit&) const {}
    __device__ __forceinline__ void done(const pg8::Unit&) const {}
};
struct EpiYPair {
    static constexpr bool PERM = true, AFTER_DRAIN = false;
    const unsigned char* GA; const unsigned char* GB; bf16* Y; unsigned char* Y8; const float* rna; const float* rnb; const float* wn; const float* vm; const float* sbwo;
    __device__ __forceinline__ void operator()(AccRef acc, const pg8::Unit& u, int wr, int wc, int fr, int fq) const {
        if (u.pm < 256) { EpiY<false> E{GA, Y, Y8, rna, rnb, wn, so_scale_a(vm), sbwo}; E(acc, u, wr, wc, fr, fq); }
        else { pg8::Unit v; v.pm = u.pm - 256; v.pn = u.pn - 4; EpiY<true> E{GB, Y, Y8, rna, rnb, wn, so_scale_b(vm), sbwo + 1024}; E(acc, v, wr, wc, fr, fq); }
    }
};

struct EpiAct3 {
    static constexpr bool PERM = true, AFTER_DRAIN = false, KEEPS = false;
    unsigned char* ACT; const float* SA; const float* SB; const float* SACT;
    __device__ __forceinline__ void operator()(AccRef acc, const pg8::Unit& u, int wr, int wc, int fr, int fq) const {
        const int row0 = u.pm * 256 + wr * 64 + fr, col0 = u.pn * 128 + wc * 32 + 8 * fq;
        const float* sb = SB + u.pn * 256 + wc * 32 + 8 * fq;
        const f32x4 g0 = *(const f32x4*)(sb), g1 = *(const f32x4*)(sb + 4), u0 = *(const f32x4*)(sb + 128), u1 = *(const f32x4*)(sb + 132);
        const float sg[8] = {g0.x, g0.y, g0.z, g0.w, g1.x, g1.y, g1.z, g1.w}, su[8] = {u0.x, u0.y, u0.z, u0.w, u1.x, u1.y, u1.z, u1.w};
#pragma unroll
        for (int ai = 0; ai < 2; ++ai)
#pragma unroll
            for (int m = 0; m < 4; ++m) { const size_t row = row0 + ai * 128 + m * 16; float r[8]; const float sa = SA[row], ia = __builtin_amdgcn_rcpf(SACT[row]);
#pragma unroll
                for (int n = 0; n < 2; ++n)
#pragma unroll
                    for (int e = 0; e < 4; ++e) { const float g = acc[ai][0][m][n][e] * (sa * sg[4 * n + e]), up = acc[ai][1][m][n][e] * (sa * su[4 * n + e]); r[4 * n + e] = siluf_(g) * (up * ia); }
                int w0 = __builtin_amdgcn_cvt_pk_fp8_f32(r[0], r[1], 0, false); w0 = __builtin_amdgcn_cvt_pk_fp8_f32(r[2], r[3], w0, true);
                int w1 = __builtin_amdgcn_cvt_pk_fp8_f32(r[4], r[5], 0, false); w1 = __builtin_amdgcn_cvt_pk_fp8_f32(r[6], r[7], w1, true);
                *(u32x2*)(ACT + row * DFF + col0) = u32x2{(unsigned)w0, (unsigned)w1}; }
    }
};


#define MFMA32(a, b, c) __builtin_amdgcn_mfma_f32_32x32x16_bf16(a, b, c, 0, 0, 0)
#define LDS_BARRIER() asm volatile("s_waitcnt lgkmcnt(0)\n\ts_barrier" ::: "memory")
__device__ __forceinline__ int crow(int r, int hi) { return (r & 3) + 8 * (r >> 2) + 4 * hi; }

__device__ __forceinline__ void compress_phase(const Args& a, LAS unsigned char* lds) {
    const int tid = threadIdx.x, lane = tid & 63, wave = __builtin_amdgcn_readfirstlane(tid >> 6), r32 = lane & 31, hi = lane >> 5;
    unsigned char* ws = a.ws;
    constexpr int PITCH = 528, A_OFF = 0, B_OFF = 64 * PITCH;
    LAS float* hid = (LAS float*)lds;
    for (int u = blockIdx.x; u < 256; u += gridDim.x) {
        const int which = u >> 7, bg = (u >> 1) & 63, n0 = (u & 1) * 64;
        const bf16* A = (const bf16*)(ws + (which ? WS_VC : WS_KC)) + ((size_t)bg * SEQ + (size_t)n0 * 16) * 64;
        const bf16* W1 = (const bf16*)(ws + (which ? WS_WCV1 : WS_WCK1));
        const int rb = wave & 1, cb = wave >> 1;
        f32x16 acc = {};
        u32x4 ra[4], rw[8];
#pragma unroll
        for (int i = 0; i < 4; ++i) { const int p = tid + 512 * i, row = p >> 5, c = p & 31; ra[i] = *(const u32x4*)(A + (size_t)row * 1024 + c * 8); }
#pragma unroll
        for (int i = 0; i < 8; ++i) { const int p = tid + 512 * i, row = p >> 5, c = p & 31; rw[i] = *(const u32x4*)(W1 + (size_t)row * 2048 + c * 8); }
        for (int kc = 0; kc < 8; ++kc) {
            __syncthreads();
#pragma unroll
            for (int i = 0; i < 4; ++i) { const int p = tid + 512 * i, row = p >> 5, c = p & 31; *(LAS u32x4*)(lds + A_OFF + row * PITCH + c * 16) = ra[i]; }
#pragma unroll
            for (int i = 0; i < 8; ++i) { const int p = tid + 512 * i, row = p >> 5, c = p & 31; *(LAS u32x4*)(lds + B_OFF + row * PITCH + c * 16) = rw[i]; }
            if (kc < 7) {
#pragma unroll
                for (int i = 0; i < 4; ++i) { const int p = tid + 512 * i, row = p >> 5, c = p & 31; ra[i] = *(const u32x4*)(A + (size_t)row * 1024 + (kc + 1) * 256 + c * 8); }
#pragma unroll
                for (int i = 0; i < 8; ++i) { const int p = tid + 512 * i, row = p >> 5, c = p & 31; rw[i] = *(const u32x4*)(W1 + (size_t)row * 2048 + (kc + 1) * 256 + c * 8); }
            }
            LDS_BARRIER();
            const LAS unsigned char* ap = lds + A_OFF + (rb * 32 + r32) * PITCH + hi * 16;
            const LAS unsigned char* bp = lds + B_OFF + (cb * 32 + r32) * PITCH + hi * 16;
#pragma unroll
            for (int ks = 0; ks < 16; ++ks) acc = MFMA32(*(const LAS bf16x8*)(ap + ks * 32), *(const LAS bf16x8*)(bp + ks * 32), acc);
        }
        __syncthreads();
        { float bias = 0.f;
#pragma unroll
          for (int q = 0; q < 8; ++q) bias += ((const float*)(ws + WS_BIAS))[(which * 8 + q) * 128 + cb * 32 + r32];
#pragma unroll
          for (int r = 0; r < 16; ++r) hid[(rb * 32 + crow(r, hi)) * 132 + cb * 32 + r32] = siluf_(acc[r] + bias); }
        __syncthreads();
        { const int row = tid >> 3, dc = (tid & 7) * 8; const float* w2 = a.in[which ? I_WCV2 : I_WCK2];
          float o[8];
#pragma unroll
          for (int j = 0; j < 8; ++j) o[j] = 0.f;
#pragma unroll 8
          for (int k = 0; k < 128; ++k) { const float h = hid[row * 132 + k]; const f32x4 wa = *(const f32x4*)(w2 + k * 64 + dc), wb = *(const f32x4*)(w2 + k * 64 + dc + 4);
              o[0] += h * wa.x; o[1] += h * wa.y; o[2] += h * wa.z; o[3] += h * wa.w; o[4] += h * wb.x; o[5] += h * wb.y; o[6] += h * wb.z; o[7] += h * wb.w; }
          if (!which) { float ss = 0.f;
#pragma unroll
              for (int j = 0; j < 8; ++j) ss += o[j] * o[j];
              ss += __shfl_xor(ss, 1); ss += __shfl_xor(ss, 2); ss += __shfl_xor(ss, 4);
              const float rstd = rsqrtf(ss * (1.f / 64.f) + RMS_EPS); const float* gk = a.in[I_GKC];
#pragma unroll
              for (int j = 0; j < 8; ++j) o[j] = o[j] * rstd * gk[dc + j]; }
          const int n = n0 + row;
          if (n >= 127) {
#pragma unroll
              for (int j = 0; j < 8; ++j) o[j] = 0.f; }
          u32x4 w; w.x = cvt_pk(o[0], o[1]); w.y = cvt_pk(o[2], o[3]); w.z = cvt_pk(o[4], o[5]); w.w = cvt_pk(o[6], o[7]);
          if (which) { float vmx = 0.f;
#pragma unroll
              for (int j = 0; j < 8; ++j) vmx = fmaxf(vmx, fabsf(o[j]));
              vmx = wave_max_dpp(vmx) * 1.004f; if (lane == 0) atomicMax((unsigned*)(ws + WS_VMAX), __float_as_uint(vmx)); }
          *(u32x4*)((bf16*)(ws + (which ? WS_VCO : WS_KCO)) + ((size_t)bg * 128 + n) * 64 + dc) = w; }
    }
    __syncthreads();
}

typedef LAS const char* lds_cptr;
__device__ __forceinline__ s16x4 vtr(lds_cptr p) { return __builtin_bit_cast(s16x4, __builtin_amdgcn_ds_read_tr16_b64_v4i16((LAS v4i16_t*)p)); }

struct FlashSt { f32x16 o0, o1; float m, l; };

__device__ __forceinline__ void flash_init(FlashSt& st) { st.o0 = f32x16{}; st.o1 = f32x16{}; st.m = -INFINITY; st.l = 0.f; }

__device__ __forceinline__ void tile_gload(const bf16* __restrict__ Kb, const bf16* __restrict__ Vb, int key0, int tid, u32x4& kr, u32x4& vr) {
    const size_t off = (size_t)(key0 + (tid >> 3)) * 64 + (tid & 7) * 8;
    kr = *(const u32x4*)(Kb + off); vr = *(const u32x4*)(Vb + off);
}
__device__ __forceinline__ void tile_lstore(LAS unsigned char* Kt, LAS unsigned char* Vt, int tid, const u32x4& kr, const u32x4& vr) {
    const int row = tid >> 3, c = tid & 7;
    *(LAS u32x4*)(Kt + c * 1024 + row * 16) = kr;
    *(LAS u32x4*)(Vt + (c >> 2) * 4096 + row * 64 + (c & 3) * 16) = vr;
}

typedef f32x16 CInit;
__device__ __forceinline__ CInit make_cinit(float sl, int hi) { CInit c;
#pragma unroll
    for (int r = 0; r < 16; ++r) c[r] = sl * (float)crow(r, hi);
    return c; }
__device__ __forceinline__ void qk_tile(lds_cptr Kt, const bf16x8 (&qr)[4], const CInit& cinit, f32x16& s0, f32x16& s1, int r32, int hi) {
    const lds_cptr kp = Kt + hi * 1024 + r32 * 16;
    { const bf16x8 k0 = *(const LAS bf16x8*)(kp), k1 = *(const LAS bf16x8*)(kp + 512); s0 = MFMA32(k0, qr[0], cinit); s1 = MFMA32(k1, qr[0], cinit); }
#pragma unroll
    for (int d0 = 1; d0 < 4; ++d0) {
        const bf16x8 k0 = *(const LAS bf16x8*)(kp + d0 * 2048), k1 = *(const LAS bf16x8*)(kp + d0 * 2048 + 512);
        s0 = MFMA32(k0, qr[d0], s0); s1 = MFMA32(k1, qr[d0], s1);
    }
}
__device__ __forceinline__ void pv_tile(lds_cptr Vt, const f32x16& p0, const f32x16& p1, f32x16& o0, f32x16& o1, int lane, int hi) {
    const lds_cptr vp = Vt + ((lane >> 4) & 1) * 32 + (lane & 3) * 8 + (4 * hi + ((lane & 15) >> 2)) * 64;
#pragma unroll
    for (int i = 0; i < 4; ++i) {
        const f32x16& P = (i < 2) ? p0 : p1; const int rb = (i & 1) * 8;
        u32x4 pw; pw.x = cvt_pk(P[rb + 0], P[rb + 1]); pw.y = cvt_pk(P[rb + 2], P[rb + 3]); pw.z = cvt_pk(P[rb + 4], P[rb + 5]); pw.w = cvt_pk(P[rb + 6], P[rb + 7]);
        const bf16x8 pf = __builtin_bit_cast(bf16x8, pw);
        const s16x4 a0 = vtr(vp + i * 1024), a1 = vtr(vp + i * 1024 + 512), b0 = vtr(vp + 4096 + i * 1024), b1 = vtr(vp + 4096 + i * 1024 + 512);
        const bf16x8 v0 = {a0[0], a0[1], a0[2], a0[3], a1[0], a1[1], a1[2], a1[3]}, v1 = {b0[0], b0[1], b0[2], b0[3], b1[0], b1[1], b1[2], b1[3]};
        o0 = MFMA32(v0, pf, o0); o1 = MFMA32(v1, pf, o1);
    }
}
template <bool MASKED, class VF>
__device__ __forceinline__ float flash_probs(lds_cptr Kt, const bf16x8 (&qr)[4], const CInit& cinit, float c32, float off, FlashSt& st, const VF& vf, int lane, f32x16& s0, f32x16& s1) {
    const int r32 = lane & 31, hi = lane >> 5;
    qk_tile(Kt, qr, cinit, s0, s1, r32, hi);
    if (MASKED) {
#pragma unroll
        for (int r = 0; r < 16; ++r) {
            const unsigned m0 = (unsigned)vf(r, 0), m1 = (unsigned)vf(r, 1);
            s0[r] = __uint_as_float((__float_as_uint(s0[r]) & m0) | (0xFF800000u & ~m0)); s1[r] = __uint_as_float((__float_as_uint(s1[r]) & m1) | (0xFF800000u & ~m1)); }
    }
    float m0 = fmaxf(s0[0], s0[1]), m1 = fmaxf(s1[0], s1[1]);
#pragma unroll
    for (int r = 2; r < 16; r += 2) { m0 = fmaxf(fmaxf(m0, s0[r]), s0[r + 1]); m1 = fmaxf(fmaxf(m1, s1[r]), s1[r + 1]); }
    float mx = fmaxf(m0, m1 + c32) + off;
    mx = fmaxf(mx, __shfl_xor(mx, 32));
    const float mnew = fmaxf(st.m, mx), msafe = (mnew == -INFINITY) ? 0.f : mnew;
    const float alpha = __builtin_amdgcn_exp2f(st.m - msafe);
    const float b0 = msafe - off, b1 = b0 - c32;
    { typedef float f32x2 __attribute__((ext_vector_type(2))); const f32x2 nb0 = {-b0, -b0}, nb1 = {-b1, -b1};
#pragma unroll
      for (int r = 0; r < 16; r += 2) { f32x2 a = {s0[r], s0[r + 1]}, c = {s1[r], s1[r + 1]}; a = a + nb0; c = c + nb1;
          s0[r] = __builtin_amdgcn_exp2f(a.x); s0[r + 1] = __builtin_amdgcn_exp2f(a.y); s1[r] = __builtin_amdgcn_exp2f(c.x); s1[r + 1] = __builtin_amdgcn_exp2f(c.y); } }
    float ps;
    { typedef float f32x8 __attribute__((ext_vector_type(8))); typedef float f32x2 __attribute__((ext_vector_type(2)));
      const f32x16 t16 = s0 + s1; const f32x8 t8 = t16.lo + t16.hi; const f32x4 t4 = t8.lo + t8.hi; const f32x2 t2 = t4.lo + t4.hi; ps = t2.x + t2.y; }
    st.l = st.l * alpha + ps; st.m = mnew;
    if (__any(alpha != 1.f)) {
#pragma unroll
        for (int r = 0; r < 16; ++r) { st.o0[r] *= alpha; st.o1[r] *= alpha; }
    }
    return msafe;
}
template <class TI>
__device__ __forceinline__ void flash_loop(const bf16* __restrict__ Kb, const bf16* __restrict__ Vb, int kt_lo, int kt_hi, unsigned long long tmask,
                                           const bf16x8 (&qr)[4], const CInit& cinit, float c32, FlashSt& st, const TI& ti, LAS unsigned char* lds, int tid) {
    const int lane = tid & 63;
    unsigned long long rem = tmask & ((kt_hi >= 63 ? ~0ull : ((1ull << (kt_hi + 1)) - 1ull)) & ~((1ull << kt_lo) - 1ull));
    rem = (unsigned long long)(unsigned)__builtin_amdgcn_readfirstlane((int)(unsigned)rem) | ((unsigned long long)(unsigned)__builtin_amdgcn_readfirstlane((int)(unsigned)(rem >> 32)) << 32);
    int left = __popcll(rem);
    auto pop = [&]() { const int k = 63 - (int)__builtin_clzll(rem); rem &= ~(1ull << k); return k; };
    auto compute = [&](int buf, int kt) {
        const lds_cptr Kt = (lds_cptr)(lds + buf * 8192), Vt = (lds_cptr)(lds + 16384 + buf * 8192);
        if (__all(ti.skipb(kt) < st.m - 24.f)) return;
        f32x16 s0, s1; const float off = ti.off(kt);
        if (ti.masked(kt)) { const auto pd = ti.prep(kt); (void)flash_probs<true>(Kt, qr, cinit, c32, off, st, [&](int r, int half) { return ti.valid(pd, r, half); }, lane, s0, s1); }
        else (void)flash_probs<false>(Kt, qr, cinit, c32, off, st, [](int, int) { return -1; }, lane, s0, s1);
        pv_tile(Vt, s0, s1, st.o0, st.o1, lane, lane >> 5);
    };
    if (left == 0) return;
    u32x4 krA, vrA, krB, vrB;
    int k0 = pop(), k1 = k0;
    tile_gload(Kb, Vb, k0 * 64, tid, krA, vrA);
    if (left >= 2) { k1 = pop(); tile_gload(Kb, Vb, k1 * 64, tid, krB, vrB); }
#pragma unroll 1
    while (left >= 4) {
        tile_lstore(lds, lds + 16384, tid, krA, vrA);
        LDS_BARRIER();
        const int k2 = pop(); tile_gload(Kb, Vb, k2 * 64, tid, krA, vrA);
        compute(0, k0);
        tile_lstore(lds + 8192, lds + 16384 + 8192, tid, krB, vrB);
        LDS_BARRIER();
        const int k3 = pop(); tile_gload(Kb, Vb, k3 * 64, tid, krB, vrB);
        compute(1, k1);
        k0 = k2; k1 = k3; left -= 2;
    }
    {
        int k2 = k0;
        tile_lstore(lds, lds + 16384, tid, krA, vrA);
        LDS_BARRIER();
        if (left == 3) { k2 = pop(); tile_gload(Kb, Vb, k2 * 64, tid, krA, vrA); }
        compute(0, k0);
        if (left >= 2) {
            tile_lstore(lds + 8192, lds + 16384 + 8192, tid, krB, vrB);
            LDS_BARRIER();
            compute(1, k1);
        }
        if (left == 3) {
            tile_lstore(lds, lds + 16384, tid, krA, vrA);
            LDS_BARRIER();
            compute(0, k2);
        }
    }
    LDS_BARRIER();
}
__device__ __forceinline__ void flash_finish(const FlashSt& st, float gate, f32x16& t0, f32x16& t1) {
    const float l = st.l + __shfl_xor(st.l, 32);
    const float f = (l > 0.f) ? gate / l : 0.f;
#pragma unroll
    for (int r = 0; r < 16; ++r) { t0[r] += f * st.o0[r]; t1[r] += f * st.o1[r]; }
}
__device__ __forceinline__ void store_o(unsigned char* __restrict__ O, size_t elem_off, const f32x16& t0, const f32x16& t1, int hi, float* __restrict__ rown, float so) {
    const float inv = __builtin_amdgcn_rcpf(so);
    { float ss = 0.f;
#pragma unroll
      for (int r = 0; r < 16; ++r) ss += t0[r] * t0[r] + t1[r] * t1[r];
      ss += __shfl_xor(ss, 32);
      if (hi == 0) unsafeAtomicAdd(rown, ss * 2.26f + 1.3e-4f * so * so); }
#pragma unroll
    for (int q = 0; q < 4; ++q) {
        int w0 = __builtin_amdgcn_cvt_pk_fp8_f32(t0[4 * q] * inv, t0[4 * q + 1] * inv, 0, false); w0 = __builtin_amdgcn_cvt_pk_fp8_f32(t0[4 * q + 2] * inv, t0[4 * q + 3] * inv, w0, true);
        int w1 = __builtin_amdgcn_cvt_pk_fp8_f32(t1[4 * q] * inv, t1[4 * q + 1] * inv, 0, false); w1 = __builtin_amdgcn_cvt_pk_fp8_f32(t1[4 * q + 2] * inv, t1[4 * q + 3] * inv, w1, true);
        *(unsigned*)(O + elem_off + 8 * q + 4 * hi) = (unsigned)w0; *(unsigned*)(O + elem_off + 32 + 8 * q + 4 * hi) = (unsigned)w1;
    }
}

constexpr int L_IMPA = 32768, L_IMPC = 65536, L_IMPF = 98304, L_FAC = 106496, L_SELM = 108544, L_UNION = 108544 + 256, L_IQL = 32768, L_MSK = 65536, L_IWL = 73728;

__device__ __forceinline__ void nsa_unit(const Args& a, LAS unsigned char* lds, int b, int g, int qt) {
    int tid_ = threadIdx.x; asm volatile("" : "+v"(tid_));
    const int tid = tid_, lane = tid & 63, wave = __builtin_amdgcn_readfirstlane(tid >> 6), r32 = lane & 31, hi = lane >> 5;
    unsigned char* ws = a.ws;
    const int rh = (wave < 4) ? wave : 7 - wave, th = wave >> 2, head = g * 4 + rh, t0 = qt * 64, tl = th * 32 + r32, token = t0 + tl;
    const size_t row = (size_t)b * SEQ + token;
    bf16x8 qr[4];
#pragma unroll
    for (int d0 = 0; d0 < 4; ++d0) qr[d0] = *(const bf16x8*)((const bf16*)(ws + WS_QA) + row * 512 + head * 64 + 16 * d0 + 8 * hi);
    const float slope2 = __builtin_amdgcn_exp2f(-(float)(head + 1)) * LOG2E;
    const int tokl = tl + 0;
    const float* gn = (const float*)(ws + WS_GN) + row * 24 + head * 3;
    const float g_cmp = gn[0], g_slc = gn[1], g_win = gn[2];
    f32x16 tot0 = {}, tot1 = {};
    const size_t bgoff = ((size_t)(b * 2 + g)) * SEQ * 64;
    LAS float* impa = (LAS float*)(lds + L_IMPA); LAS float* impc = (LAS float*)(lds + L_IMPC); LAS float* impf = (LAS float*)(lds + L_IMPF); LAS float* facl = (LAS float*)(lds + L_FAC);
    LAS unsigned* selm = (LAS unsigned*)(lds + L_SELM); LAS unsigned* uni = (LAS unsigned*)(lds + L_UNION);

    REP(16) {
        tot0 = f32x16{}; tot1 = f32x16{};
        const bf16* Kc = (const bf16*)(ws + WS_KCO) + (size_t)(b * 2 + g) * 128 * 64; const bf16* Vc = (const bf16*)(ws + WS_VCO) + (size_t)(b * 2 + g) * 128 * 64;
        const bool two = (t0 + 63 - 31) / 16 >= 64;
        { u32x4 kr, vr; tile_gload(Kc, Vc, 0, tid, kr, vr); tile_lstore(lds, lds + 16384, tid, kr, vr);
          tile_gload(Kc, Vc, 64, tid, kr, vr); tile_lstore(lds + 8192, lds + 16384 + 8192, tid, kr, vr); }
        if (tid < 64) selm[tid] = 0u; if (tid == 64) *uni = 0u;
        __syncthreads();
        const int nv = (token >= 31) ? (token - 31) / 16 : -1;
        FlashSt st; flash_init(st);
        float ms0 = 0.f;
        const CInit cinitc = make_cinit(16.f * slope2, hi);
#pragma unroll
        for (int tile = 0; tile < 2; ++tile) {
            if (tile == 0 || two) {
                f32x16 s0, s1;
                const int lim = nv - 64 * tile - 4 * hi;
                auto vf = [=](int r, int half) { return ~((lim - ((r & 3) + 8 * (r >> 2) + 32 * half)) >> 31); };
                const float ms = flash_probs<true>((lds_cptr)(lds + tile * 8192), qr, cinitc, 512.f * slope2, 1024.f * slope2 * (float)tile, st, vf, lane, s0, s1);
                if (tile == 0) ms0 = ms;
#pragma unroll
                for (int blk = 0; blk < 2; ++blk) { const f32x16& P = blk ? s1 : s0;
#pragma unroll
                    for (int q = 0; q < 4; ++q) { const int uq = 16 * tile + 8 * blk + 2 * q + hi;
                        impa[(rh * 32 + uq) * 64 + tl] = (P[4 * q] + P[4 * q + 1]) + (P[4 * q + 2] + P[4 * q + 3]); impc[(rh * 32 + uq) * 64 + tl] = P[4 * q + 3]; } }
                pv_tile((lds_cptr)(lds + 16384 + tile * 8192), s0, s1, st.o0, st.o1, lane, hi);
            } else {
#pragma unroll
                for (int k = 0; k < 8; ++k) { const int uq = 16 + 2 * k + hi; impa[(rh * 32 + uq) * 64 + tl] = 0.f; impc[(rh * 32 + uq) * 64 + tl] = 0.f; }
            }
        }
        { const float l = st.l + __shfl_xor(st.l, 32), inv = (l > 0.f) ? 1.f / l : 0.f, mf = (st.m == -INFINITY) ? 0.f : st.m;
          if (hi == 0) { facl[(rh * 2 + 0) * 64 + tl] = __builtin_amdgcn_exp2f(ms0 - mf) * inv; facl[(rh * 2 + 1) * 64 + tl] = inv; } }
        flash_finish(st, g_cmp, tot0, tot1);
        __syncthreads();
        { const int tk = tid & 63, jg = tid >> 6;
#pragma unroll
          for (int jj = 0; jj < 4; ++jj) { const int j = jg * 4 + jj; float v = 0.f;
#pragma unroll
              for (int h4 = 0; h4 < 4; ++h4) { v += impa[(h4 * 32 + j) * 64 + tk] * facl[(h4 * 2 + (j >> 4)) * 64 + tk];
                  if (j > 0) v += impc[(h4 * 32 + j - 1) * 64 + tk] * facl[(h4 * 2 + ((j - 1) >> 4)) * 64 + tk]; }
              const bool forced = (j == 0) || (j == qt) || (j == qt - 1);
              v = forced ? 1e9f : ((j <= qt) ? v : -1e9f);
              impf[j * 64 + tk] = v; } }
        __syncthreads();
        { const int tk = tid & 63, jg = tid >> 6; unsigned bits = 0u;
#pragma unroll
          for (int jj = 0; jj < 4; ++jj) { const int j = jg * 4 + jj; const float v = impf[j * 64 + tk]; int rank = 0;
              for (int j2 = 0; j2 < 32; ++j2) { const float w = impf[j2 * 64 + tk]; rank += (w > v || (w == v && j2 < j)) ? 1 : 0; }
              if (rank < 16) bits |= 1u << j; }
          atomicOr((unsigned*)&selm[tk], bits); atomicOr((unsigned*)uni, bits); }
        __syncthreads();
    }
    const unsigned mysel = selm[tl]; const unsigned long long um = (unsigned long long)(*uni);
    LAS float* stash = (LAS float*)(lds + L_IMPA) + tid;
#pragma unroll
    for (int r = 0; r < 16; ++r) { stash[r * 512] = tot0[r]; stash[(16 + r) * 512] = tot1[r]; }
    const CInit cinit = make_cinit(slope2, hi);

    REP(17) {
        FlashSt st; flash_init(st);
        struct TI { int qt, lim; unsigned mysel; float sl64, sb63;
            __device__ __forceinline__ bool masked(int kt) const { return kt == qt; }
            __device__ __forceinline__ float off(int kt) const { return ((mysel >> kt) & 1u) ? sl64 * (float)kt : -INFINITY; }
            __device__ __forceinline__ float skipb(int kt) const { return sb63 + sl64 * (float)kt; }
            __device__ __forceinline__ int prep(int kt) const { return kt; }
            __device__ __forceinline__ int valid(int, int r, int half) const { return ~((lim - ((r & 3) + 8 * (r >> 2) + 32 * half)) >> 31); } };
        const float sbound = 64.f * QSCALE * 1.01f * wave_max_dpp(fabsf(a.in[I_GQA][lane])) * wave_max_dpp(fabsf(a.in[I_GKS][lane]));
        const TI ti{qt, tokl - 4 * hi, mysel, 64.f * slope2, sbound + 63.f * slope2};
        flash_loop((const bf16*)(ws + WS_KS) + bgoff, (const bf16*)(ws + WS_VS) + bgoff, 0, qt, um, qr, cinit, 32.f * slope2, st, ti, lds, tid);
        f32x16 a0 = {}, a1 = {}; flash_finish(st, g_slc, a0, a1);
        if (rp_ == 0) {
#pragma unroll
        for (int r = 0; r < 16; ++r) { stash[r * 512] += a0[r]; stash[(16 + r) * 512] += a1[r]; } }
    }
    REP(18) {
        FlashSt st; flash_init(st);
        struct TI { int qt, lim; float sl64, sb63;
            __device__ __forceinline__ bool masked(int kt) const { return kt == qt || kt == qt - 8; }
            __device__ __forceinline__ float off(int kt) const { return sl64 * (float)kt; }
            __device__ __forceinline__ float skipb(int kt) const { return sb63 + sl64 * (float)kt; }
            __device__ __forceinline__ int prep(int kt) const { return kt; }
            __device__ __forceinline__ int valid(int kt, int r, int half) const { const int gt = (lim - ((r & 3) + 8 * (r >> 2) + 32 * half)) >> 31; return (kt == qt) ? ~gt : gt; } };
        const float sbound = 64.f * QSCALE * 1.01f * wave_max_dpp(fabsf(a.in[I_GQA][lane])) * wave_max_dpp(fabsf(a.in[I_GKW][lane]));
        const TI ti{qt, tokl - 4 * hi, 64.f * slope2, sbound + 63.f * slope2};
        flash_loop((const bf16*)(ws + WS_KW) + bgoff, (const bf16*)(ws + WS_VW) + bgoff, (qt >= 8) ? qt - 8 : 0, qt, ~0ull, qr, cinit, 32.f * slope2, st, ti, lds, tid);
        f32x16 a0 = {}, a1 = {}; flash_finish(st, g_win, a0, a1);
#pragma unroll
        for (int r = 0; r < 16; ++r) { a0[r] += stash[r * 512]; a1[r] += stash[(16 + r) * 512]; }
        store_o(ws + WS_OA, row * 512 + head * 64, a0, a1, hi, (float*)(ws + WS_ROWNA) + row, so_scale_a((const float*)(ws + WS_VMAX)));
    }
}

__device__ __forceinline__ unsigned ordkey(float f) { f = f + 0.f; const unsigned u = __float_as_uint(f); return u ^ ((unsigned)((int)u >> 31) | 0x80000000u); }

__device__ __forceinline__ int wave_sum_i32(int x) {
    x += __builtin_amdgcn_update_dpp(0, x, 0x111, 0xf, 0xf, true);
    x += __builtin_amdgcn_update_dpp(0, x, 0x112, 0xf, 0xf, true);
    x += __builtin_amdgcn_update_dpp(0, x, 0x114, 0xf, 0xf, true);
    x += __builtin_amdgcn_update_dpp(0, x, 0x118, 0xf, 0xf, true);
    x += __builtin_amdgcn_update_dpp(0, x, 0x142, 0xa, 0xf, false);
    x += __builtin_amdgcn_update_dpp(0, x, 0x143, 0xc, 0xf, false);
    return __builtin_amdgcn_readlane(x, 63);
}
__device__ __forceinline__ unsigned wave_max_u32(unsigned x) {
    unsigned y;
    y = (unsigned)__builtin_amdgcn_update_dpp(0, (int)x, 0x111, 0xf, 0xf, true); x = x > y ? x : y;
    y = (unsigned)__builtin_amdgcn_update_dpp(0, (int)x, 0x112, 0xf, 0xf, true); x = x > y ? x : y;
    y = (unsigned)__builtin_amdgcn_update_dpp(0, (int)x, 0x114, 0xf, 0xf, true); x = x > y ? x : y;
    y = (unsigned)__builtin_amdgcn_update_dpp(0, (int)x, 0x118, 0xf, 0xf, true); x = x > y ? x : y;
    y = (unsigned)__builtin_amdgcn_update_dpp(0, (int)x, 0x142, 0xa, 0xf, false); x = x > y ? x : y;
    y = (unsigned)__builtin_amdgcn_update_dpp(0, (int)x, 0x143, 0xc, 0xf, false); x = x > y ? x : y;
    return (unsigned)__builtin_amdgcn_readlane((int)x, 63);
}
template <int NI>
__device__ __forceinline__ void dsa_select(const float* __restrict__ scr, LAS unsigned long long* msk, int wave, int lane, int t0, int nkt, const unsigned* touch) {
    unsigned pfv = 0u;
    unsigned u[NI], un[NI];
    auto loadrow = [&](int tk, unsigned (&dst)[NI]) {
#pragma unroll
        for (int i = 0; i < NI; ++i) { const int ii = (i < nkt) ? i : 0; const float f = scr[(size_t)tk * 2048 + ii * 64 + lane]; dst[i] = (i < nkt) ? ordkey(f) : 0u; } };
    loadrow(wave * 4, un);
#pragma unroll 1
    for (int tq = 0; tq < 4; ++tq) {
        const int tk = wave * 4 + tq, tpos = t0 + tk;
#pragma unroll
        for (int i = 0; i < NI; ++i) u[i] = un[i];
        if (tq < 3) loadrow(tk + 1, un);
        if (tq == 0 && touch) pfv = *touch;
        if (tpos + 1 <= 256) {
#pragma unroll
            for (int i = 0; i < NI; ++i) { const unsigned long long m = __ballot(i * 64 + lane <= tpos); if (lane == 0) msk[tk * 32 + i] = m; }
        } else {
            int h[NI];
#pragma unroll
            for (int i = 0; i < NI; ++i) h[i] = (int)(u[i] >> 1);
            auto count_ge = [&](int c) { int lt = 0;
#pragma unroll
                for (int i = 0; i < NI; i += 4) { int d0 = h[i] - c, d1 = h[i + 1] - c, d2 = h[i + 2] - c, d3 = h[i + 3] - c;
                    asm volatile("" : "+v"(d0), "+v"(d1), "+v"(d2), "+v"(d3));
                    lt += ((int)((unsigned)d0 >> 31) + (int)((unsigned)d1 >> 31)) + ((int)((unsigned)d2 >> 31) + (int)((unsigned)d3 >> 31)); }
                return NI * 64 - wave_sum_i32(lt); };
            int T31 = 0, bit0 = 30; bool exact = false;
            { int mx = 0;
#pragma unroll
              for (int i = 0; i < NI; ++i) mx = (h[i] > mx) ? h[i] : mx;
              mx = (int)wave_max_u32((unsigned)mx);
              int P = mx >> 22;
#pragma unroll 1
              for (int tr = 0; tr < 4 && P > 0; ++tr, --P) {
                  const int cand = P << 22; const int cnt = count_ge(cand);
                  if (cnt >= 256) { T31 = cand; bit0 = 21; exact = (cnt == 256); break; }
              } }
            if (!exact) {
#pragma unroll 1
                for (int bit = bit0; bit >= 0; --bit) {
                    const int cand = T31 | (1 << bit); const int cnt = count_ge(cand);
                    if (cnt >= 256) { T31 = cand; if (cnt == 256) { exact = true; break; } }
                }
            }
            unsigned T = (unsigned)T31 << 1; int cge = 256;
            if (!exact) { const unsigned Thi = T | 1u; int lc = 0;
#pragma unroll
                for (int i = 0; i < NI; ++i) lc += (u[i] >= Thi) ? 1 : 0;
                const int chi = wave_sum_i32(lc);
                if (chi >= 256) { T = Thi; cge = chi; } else cge = count_ge(T31); }
            if (cge == 256) {
                int mlo = 0, mhi = 0;
#pragma unroll
                for (int i = 0; i < NI; ++i) { const unsigned long long bm = __ballot(u[i] >= T);
                    const bool me = (lane == i); mlo = me ? (int)(unsigned)bm : mlo; mhi = me ? (int)(unsigned)(bm >> 32) : mhi; }
                if (lane < NI) msk[tk * 32 + lane] = ((unsigned long long)(unsigned)mhi << 32) | (unsigned long long)(unsigned)mlo;
                continue;
            }
            int cgt = 0;
#pragma unroll
            for (int i = 0; i < NI; ++i) cgt += __popcll(__ballot(u[i] > T));
            const int need = 256 - cgt;
            int run = 0; const unsigned long long lt = (1ull << lane) - 1ull;
#pragma unroll
            for (int i = 0; i < NI; ++i) {
                const bool eq = (u[i] == T); const unsigned long long eqm = __ballot(eq);
                const int myrank = run + __popcll(eqm & lt); const bool sel = (u[i] > T) || (eq && myrank < need);
                run += __popcll(eqm); const unsigned long long m = __ballot(sel); if (lane == 0) msk[tk * 32 + i] = m; }
        }
    }
    asm volatile("" :: "v"(pfv));
}

__device__ __forceinline__ void dsa_unit(const Args& a, LAS unsigned char* lds, int b, int qt, int inext) {
    int tid_ = threadIdx.x; asm volatile("" : "+v"(tid_));
    __syncthreads();
    const int tid = tid_, lane = tid & 63, wave = __builtin_amdgcn_readfirstlane(tid >> 6), r32 = lane & 31, hi = lane >> 5;
    unsigned char* ws = a.ws;
    const int t0 = qt * 32, token = t0 + r32, nkt = (t0 + 31) / 64 + 1;
    const size_t row = (size_t)b * SEQ + token;
    float* scr = (float*)(ws + WS_SCR) + (size_t)blockIdx.x * 32 * 2048;
    LAS unsigned char* iql = lds + L_IQL; LAS unsigned long long* msk = (LAS unsigned long long*)(lds + L_MSK);
    const unsigned* touch = nullptr;
    if (inext < 2048) { const int k = inext / 256, cc = inext % 256, j = cc / 32, bn = cc % 32, jj = (k & 1) ? 7 - j : j, qtn = 63 - (8 * k + jj);
        const int line = tid & 255; touch = (const unsigned*)(ws + ((tid >> 8) ? WS_QB : WS_IQ) + ((size_t)bn * SEQ + qtn * 32 + (line >> 3)) * 1024 + (line & 7) * 128); }
    REP(13) {
        const bf16* IK = (const bf16*)(ws + WS_IK) + (size_t)b * SEQ * 64;
        bf16x8 kf[8], kn[8];
        auto kload = [&](int kt, bf16x8 (&d)[8]) {
#pragma unroll
            for (int d0 = 0; d0 < 4; ++d0) { d[2 * d0] = *(const bf16x8*)(IK + (size_t)(kt * 64 + r32) * 64 + 16 * d0 + 8 * hi); d[2 * d0 + 1] = *(const bf16x8*)(IK + (size_t)(kt * 64 + 32 + r32) * 64 + 16 * d0 + 8 * hi); } };
        if (wave < nkt) kload(wave, kn);
        const bf16* IQ = (const bf16*)(ws + WS_IQ);
#pragma unroll
        for (int c4 = 0; c4 < 4; ++c4) { const int id = tid + 512 * c4, tok = id >> 6, c = id & 63, h = c >> 3, d0 = (c >> 1) & 3, hh = c & 1;
            const u32x4 v = *(const u32x4*)(IQ + ((size_t)b * SEQ + t0 + tok) * 512 + c * 8);
            *(LAS u32x4*)(iql + (((h * 4 + d0) * 2 + hh) * 32 + tok) * 16) = v; }
        if (tid < 256) { const int tok = tid >> 3, h = tid & 7; ((LAS float*)(lds + L_IWL))[h * 32 + tok] = ((const float*)(ws + WS_IW))[((size_t)b * SEQ + t0 + tok) * 8 + h]; }
        __syncthreads();

#pragma unroll 1
        for (int kt = wave; kt < nkt; kt += NWAVES) {
#pragma unroll
            for (int i = 0; i < 8; ++i) kf[i] = kn[i];
            if (kt + NWAVES < nkt) kload(kt + NWAVES, kn);
            f32x16 acc0 = {}, acc1 = {};
#pragma unroll 1
            for (int h = 0; h < 8; ++h) {
                const float wh = ((const LAS float*)(lds + L_IWL))[h * 32 + r32];
                f32x16 s0 = {}, s1 = {};
#pragma unroll
                for (int d0 = 0; d0 < 4; ++d0) { const bf16x8 q = *(const LAS bf16x8*)(iql + (((h * 4 + d0) * 2 + hi) * 32 + r32) * 16);
                    s0 = MFMA32(kf[2 * d0], q, s0); s1 = MFMA32(kf[2 * d0 + 1], q, s1); }
#pragma unroll
                for (int r = 0; r < 16; ++r) {
                    const int i0 = __float_as_int(s0[r]), i1 = __float_as_int(s1[r]);
                    acc0[r] += wh * __int_as_float(i0 > 0 ? i0 : 0); acc1[r] += wh * __int_as_float(i1 > 0 ? i1 : 0); }
            }
#pragma unroll
            for (int q = 0; q < 4; ++q) { const int k0 = kt * 64 + 8 * q + 4 * hi; f32x4 v0, v1;
#pragma unroll
                for (int e = 0; e < 4; ++e) { v0[e] = (k0 + e <= token) ? acc0[4 * q + e] : -INFINITY; v1[e] = (k0 + 32 + e <= token) ? acc1[4 * q + e] : -INFINITY; }
                *(f32x4*)(scr + (size_t)r32 * 2048 + k0) = v0; *(f32x4*)(scr + (size_t)r32 * 2048 + k0 + 32) = v1; }
        }
        __syncthreads();
    }
    REP(14) {
        if (nkt <= 8) dsa_select<8>(scr, msk, wave, lane, t0, nkt, touch);
        else if (nkt <= 12) dsa_select<12>(scr, msk, wave, lane, t0, nkt, touch);
        else if (nkt <= 16) dsa_select<16>(scr, msk, wave, lane, t0, nkt, touch);
        else if (nkt <= 20) dsa_select<20>(scr, msk, wave, lane, t0, nkt, touch);
        else if (nkt <= 24) dsa_select<24>(scr, msk, wave, lane, t0, nkt, touch);
        else if (nkt <= 28) dsa_select<28>(scr, msk, wave, lane, t0, nkt, touch);
        else dsa_select<32>(scr, msk, wave, lane, t0, nkt, touch);
    }
    __syncthreads();
    REP(15) {
        const int head = (wave < 4) ? wave : 11 - wave;
        bf16x8 qr[4];
#pragma unroll
        for (int d0 = 0; d0 < 4; ++d0) qr[d0] = *(const bf16x8*)((const bf16*)(ws + WS_QB) + row * 512 + head * 64 + 16 * d0 + 8 * hi);
        const float slope2 = __builtin_amdgcn_exp2f(-(float)(head + 1)) * LOG2E;
        const float sbound = 64.f * QSCALE * 1.01f * wave_max_dpp(fabsf(a.in[I_GQB][lane])) * wave_max_dpp(fabsf(a.in[I_GKB][lane]));
        const CInit cinit = make_cinit(slope2, hi);
        FlashSt st; flash_init(st);
        struct TI { const LAS unsigned long long* mrow; int sh; float sl64, sb63;
            __device__ __forceinline__ bool masked(int) const { return true; }
            __device__ __forceinline__ float off(int kt) const { return sl64 * (float)kt; }
            __device__ __forceinline__ float skipb(int kt) const { return sb63 + sl64 * (float)kt; }
            __device__ __forceinline__ u32x2 prep(int kt) const { const unsigned long long mm = mrow[kt] >> sh; u32x2 w; w.x = (unsigned)mm; w.y = (unsigned)(mm >> 32); return w; }
            __device__ __forceinline__ int valid(const u32x2& w, int r, int half) const { return __builtin_amdgcn_sbfe((int)(half ? w.y : w.x), (r & 3) + 8 * (r >> 2), 1); } };
        const TI ti{msk + r32 * 32, 4 * hi, 64.f * slope2, sbound + 63.f * slope2};
        flash_loop((const bf16*)(ws + WS_KB) + (size_t)b * SEQ * 64, (const bf16*)(ws + WS_VB) + (size_t)b * SEQ * 64, 0, nkt - 1, ~0ull, qr, cinit, 32.f * slope2, st, ti, lds, tid);
        f32x16 t0v = {}, t1v = {};
        flash_finish(st, 1.f, t0v, t1v);
        store_o(ws + WS_OB8, row * 512 + head * 64, t0v, t1v, hi, (float*)(ws + WS_ROWNB) + row, so_scale_b((const float*)(ws + WS_VMAX)));
    }
    __syncthreads();
}

__device__ __forceinline__ void attn_phase(const Args& a, LAS unsigned char* lds) {
    const int c = blockIdx.x, G = gridDim.x;
    REP(11) for (int i = c; i < 2048; i += G) { const int k = i / 256, cc = i % 256, j = cc / 64, bg = cc % 64, jj = (k & 1) ? 3 - j : j, qt = 31 - (4 * k + jj);
        nsa_unit(a, lds, bg >> 1, bg & 1, qt); }
    { unsigned* ctr = (unsigned*)(a.ws + WS_DSACTR); volatile LAS int* nxt = (volatile LAS int*)(lds + LDS_BYTES - 128);
      if (threadIdx.x == 0) { const int i0 = (int)atomicAdd(ctr, 1u), i1 = (int)atomicAdd(ctr, 1u); nxt[0] = i0; nxt[1] = i1; }
      __syncthreads();
      int i = nxt[0], inext = nxt[1];
      REP(12) while (i < 2048) {
          int mine = 0; if (threadIdx.x == 0) mine = (int)atomicAdd(ctr, 1u);
          const int k = i / 256, cc = i % 256, j = cc / 32, b = cc % 32, jj = (k & 1) ? 7 - j : j, qt = 63 - (8 * k + jj);
          dsa_unit(a, lds, b, qt, inext);
          if (threadIdx.x == 0) nxt[0] = mine;
          __syncthreads();
          i = inext; inext = nxt[0]; } }
}


#define RLX_AGENT __ATOMIC_RELAXED, __HIP_MEMORY_SCOPE_AGENT
#define XB_TMO      128
#define XB_XCNT(j)  (256  + 64 * (j))
#define XB_XSUB(j)  (1280 + 64 * (j))
#define XB_XGEN(j)  (2304 + 64 * (j))
#define XB_TOP      3328
#define XB_TOPGEN   3392
#define XCD_BAR_WORDS 3456
#define XB_SPIN_CAP (1u << 18)

__device__ __forceinline__ unsigned xb_ld(unsigned* p)              { return __hip_atomic_load(p, __ATOMIC_RELAXED, __HIP_MEMORY_SCOPE_AGENT); }
__device__ __forceinline__ unsigned xb_add(unsigned* p, unsigned v) { return __hip_atomic_fetch_add(p, v, __ATOMIC_RELAXED, __HIP_MEMORY_SCOPE_AGENT); }
__device__ __forceinline__ unsigned xb_xcc_id() { return (unsigned)__builtin_amdgcn_s_getreg((3 << 11) | 20) & 0xFu; }
#define XB_SPIN(cond, bar) do { unsigned _sp = 0; while (cond) { __builtin_amdgcn_s_sleep(1); \
    if ((++_sp & 255u) == 0u) { if (xb_ld(&(bar)[XB_TMO])) break; if (_sp > XB_SPIN_CAP) { atomicAdd(&(bar)[XB_TMO], 1u); break; } } } } while (0)

struct XcdBarrier {
    unsigned* bar; unsigned x;
    volatile LAS unsigned* st;
};

__device__ __forceinline__ XcdBarrier xcd_barrier_post(unsigned* bar, volatile LAS unsigned* st) {
    XcdBarrier b; b.bar = bar; b.x = xb_xcc_id(); b.st = st;
    if (threadIdx.x == 0) (void)xb_add(&bar[XB_XCNT(b.x)], 1u);
    return b;
}
__device__ __forceinline__ void xcd_barrier_complete(unsigned* bar, unsigned x, unsigned& nloc, unsigned& nx) {
    const unsigned G = gridDim.x * gridDim.y * gridDim.z;
    unsigned sum, cnt, mine, sp = 0u;
    for (;;) {
        sum = 0u; cnt = 0u; mine = 0u;
#pragma unroll
        for (unsigned j = 0; j < 16; ++j) { const unsigned c = xb_ld(&bar[XB_XCNT(j)]); sum += c; cnt += (c > 0u) ? 1u : 0u; mine = (j == x) ? c : mine; }
        if (sum == G) break;
        __builtin_amdgcn_s_sleep(1);
        if ((++sp & 255u) == 0u) { if (xb_ld(&bar[XB_TMO])) break; if (sp > XB_SPIN_CAP) { atomicAdd(&bar[XB_TMO], 1u); break; } }
    }
    nloc = mine > 0u ? mine : 1u; nx = cnt > 0u ? cnt : 1u;
}

__device__ __forceinline__ void xcd_barrier(const XcdBarrier& b) {
    asm volatile("s_waitcnt vmcnt(0)" ::: "memory");
    __syncthreads();
    if (threadIdx.x == 0) {
        unsigned* bar = b.bar;
        __builtin_amdgcn_s_waitcnt(0);
        unsigned nloc = b.st[0], nx = b.st[1];
        if (nloc == 0u) { xcd_barrier_complete(bar, b.x, nloc, nx); b.st[0] = nloc; b.st[1] = nx; }
        const unsigned old = xb_add(&bar[XB_XSUB(b.x)], 1u);
        const unsigned gen = old / nloc;
        if (old + 1u == (gen + 1u) * nloc) {
            __builtin_amdgcn_fence(__ATOMIC_RELEASE, "agent");
            asm volatile("s_waitcnt vmcnt(0)" ::: "memory");
            const unsigned og = xb_add(&bar[XB_TOP], 1u);
            const unsigned tg = og / nx;
            if (og + 1u == (tg + 1u) * nx) xb_add(&bar[XB_TOPGEN], 1u);
            else XB_SPIN(xb_ld(&bar[XB_TOPGEN]) == tg, bar);
            __builtin_amdgcn_fence(__ATOMIC_ACQUIRE, "agent");
            xb_add(&bar[XB_XGEN(b.x)], 1u);
            asm volatile("s_waitcnt vmcnt(0)" ::: "memory");
        } else {
            XB_SPIN(xb_ld(&bar[XB_XGEN(b.x)]) == gen, bar);
            __builtin_amdgcn_fence(__ATOMIC_ACQUIRE, "agent");
            asm volatile("s_waitcnt vmcnt(0)" ::: "memory");
        }
    }
    __syncthreads();
}

#ifndef WGM_P2A
#define WGM_P2A 4
#endif
#ifndef WGM_P2B
#define WGM_P2B 4
#endif
#ifndef WGM_P9
#define WGM_P9 4
#endif
#ifndef RUNG
#define RUNG 99
#endif
__global__ void __launch_bounds__(NTHREADS, 2) hybrid_fwd(Args a) {
    extern __shared__ __attribute__((aligned(16))) unsigned char lds_raw[];
    LAS unsigned char* lds = (LAS unsigned char*)lds_raw;
    cg::grid_group grid = cg::this_grid();
    unsigned char* ws = a.ws;
    volatile LAS unsigned* bst = (volatile LAS unsigned*)(lds + LDS_BYTES - 64);
    if (threadIdx.x < 2) bst[threadIdx.x] = 0u;
    __syncthreads();
    XcdBarrier xbar; xbar.bar = (unsigned*)ws; xbar.x = 0u; xbar.st = bst;
    const float* mod = (const float*)(ws + WS_MOD);
    const int lo = a.ph_lo, hi = a.ph_hi;
#define IN(k) (lo <= (k) && (k) < hi)
#define SEAM(k) do { if (IN(k) && IN((k) + 1)) { if ((k) == 0) grid.sync(); else xcd_barrier(xbar); } } while (0)

    if (IN(0)) REP(0) { phase0(a, lds); }
    SEAM(0);
    if (IN(0) && IN(1)) xbar = xcd_barrier_post((unsigned*)ws, bst);
    if (IN(1)) REP(1) { if (blockIdx.x == 0 && threadIdx.x < 64) wnmax_item(ws); wgu_quant_items(a, lds); wing_quant_items(a, lds); wd_quant_items(a, lds); wout_quant_items(a, lds); woab_quant_items(a, lds); norm_dual_phase(a.in[I_X], a.in[I_GN1], mod, 0, DM, (bf16*)(ws + WS_H), (signed char*)(ws + WS_HQ), (float*)(ws + WS_SA1)); }
    SEAM(1);
#if RUNG >= 2
    if (IN(2)) {
        if constexpr (NBFT > 0) { pg8::Gemm g{(const bf16*)(ws + WS_H), (const bf16*)(ws + WS_WIN), MROWS, NBFROWS, DM}; pg8::StaticOrder S; S.init(MROWS, NBFROWS, gridDim.x, blockIdx.x, WGM_P2A);
          EpiProj<false> E{ws, a.in[I_GQA], a.in[I_GKS], a.in[I_GKW], a.in[I_GQB], a.in[I_GKB]};
          pg8::gemm_phase<EpiProj<false>, pg8::StaticOrder, true, true>(lds, g, S, E); }
        { pg8::Gemm g{(const bf16*)(ws + WS_HQ), (const bf16*)(ws + WS_WINGQ), MROWS, NI8ROWS, DM / 2}; pg8::StaticOrder S; S.init(MROWS, NI8ROWS, gridDim.x, blockIdx.x, WGM_P2B);
          EpiProj<true> E{ws, a.in[I_GQA], a.in[I_GKS], a.in[I_GKW], a.in[I_GQB], a.in[I_GKB]};
          pg8::gemm_phase<EpiProj<true>, pg8::StaticOrder, true, true, true>(lds, g, S, E); }
    }
    SEAM(2);
    if (IN(3)) REP(3) { compress_phase(a, lds); }
    SEAM(3);
    if (IN(4)) { attn_phase(a, lds); }
    SEAM(4);
    if (IN(5)) {
        pg8::Gemm g{(const bf16*)(ws + WS_OA), (const bf16*)(ws + WS_WOA), 2 * MROWS, 2 * DM, 256}; PairOrder S; S.init(gridDim.x, blockIdx.x);
        EpiYPair E{ws + WS_GA, ws + WS_GB, (bf16*)(ws + WS_Y), ws + WS_Y8, (const float*)(ws + WS_ROWNA), (const float*)(ws + WS_ROWNB), (const float*)(ws + WS_WNMAX),
                   (const float*)(ws + WS_VMAX), (const float*)(ws + WS_SBWO)};
        pg8::gemm_phase<EpiYPair, PairOrder, true, true, false, true>(lds, g, S, E);
    }
    SEAM(6);
    if (IN(7)) {
        pg8::Gemm g{(const bf16*)(ws + WS_Y8), (const bf16*)(ws + WS_WOUT), MROWS, DM, DM / 2}; pg8::StaticOrder S; S.init(MROWS, DM, gridDim.x, blockIdx.x);
        EpiX1 E{a.in[I_X], (bf16*)(ws + WS_X1B), (float*)(ws + WS_ROWSS), mod, (const float*)(ws + WS_ROWNA), (const float*)(ws + WS_ROWNB), (const float*)(ws + WS_WNMAX), (const float*)(ws + WS_SBO)};
        pg8::gemm_phase<EpiX1, pg8::StaticOrder, true, true, false, true>(lds, g, S, E);
    }
    SEAM(7);
#endif
    if (IN(8)) { norm2_quant_phase((const bf16*)(ws + WS_X1B), (const float*)(ws + WS_ROWSS), a.in[I_GN2], mod, (signed char*)(ws + WS_H2), (float*)(ws + WS_SA2), (float*)(ws + WS_SACT), (const float*)(ws + WS_WNMAX)); }
    SEAM(8);
    if (IN(9)) {
        pg8::Gemm g{(const bf16*)(ws + WS_H2), (const bf16*)(ws + WS_WGU), MROWS, 2 * DFF, DM / 2}; pg8::StaticOrder S; S.init(MROWS, 2 * DFF, gridDim.x, blockIdx.x, WGM_P9);
        EpiAct3 E{ws + WS_ACT, (const float*)(ws + WS_SA2), (const float*)(ws + WS_SBWGU), (const float*)(ws + WS_SACT)};
        pg8::gemm_phase<EpiAct3, pg8::StaticOrder, true, true, true>(lds, g, S, E);
    }
    SEAM(9);
    if (IN(10)) {
        pg8::Gemm g{(const bf16*)(ws + WS_ACT), (const bf16*)(ws + WS_WD), MROWS, DM, DFF / 2}; pg8::StaticOrder S; S.init(MROWS, DM, gridDim.x, blockIdx.x);
        EpiOut E{(const bf16*)(ws + WS_X1B), a.out, mod, (const float*)(ws + WS_SACT), (const float*)(ws + WS_SBD)};
        pg8::gemm_phase<EpiOut, pg8::StaticOrder, true, true, false, true>(lds, g, S, E);
    }
#undef IN
#undef SEAM
}

#ifndef N_LAUNCH_MODE
#define N_LAUNCH_MODE 1
#endif
extern "C" void kernel_launch(void* const* d_in, const int* in_sizes, int n_in, void* d_out, int out_size, void* d_ws, size_t ws_size, hipStream_t stream) {
    static int grid = 0;
    if (grid == 0) {
        if (n_in != 25 || out_size != MROWS * DM || ws_size < WS_END) { fprintf(stderr, "kernel_launch: unexpected problem (n_in %d, out %d, ws %zu)\n", n_in, out_size, ws_size); grid = -1; return; }
        int dev = 0, cus = 0, per_cu = 0;
        hipGetDevice(&dev); hipDeviceGetAttribute(&cus, hipDeviceAttributeMultiprocessorCount, dev);
        if (hipFuncSetAttribute((const void*)hybrid_fwd, hipFuncAttributeMaxDynamicSharedMemorySize, LDS_BYTES) != hipSuccess) { fprintf(stderr, "kernel_launch: hipFuncSetAttribute failed\n"); grid = -1; return; }
        if (hipOccupancyMaxActiveBlocksPerMultiprocessor(&per_cu, (const void*)hybrid_fwd, NTHREADS, LDS_BYTES) != hipSuccess || per_cu < 1) { fprintf(stderr, "kernel_launch: occupancy query says %d\n", per_cu); per_cu = 1; }
        (void)hipGetLastError();
        grid = cus * (per_cu > 1 ? 1 : per_cu);
        if (grid > MAXGRID) grid = MAXGRID;
        if (grid < 1) grid = 1;
    }
    if (grid < 0) return;
    Args a{};
    for (int i = 0; i < 25; ++i) a.in[i] = (const float*)d_in[i];
    a.out = (float*)d_out; a.ws = (unsigned char*)d_ws;
#if N_LAUNCH_MODE == 1
    a.ph_lo = 0; a.ph_hi = 11;
    void* args[] = {&a};
    hipError_t e = hipLaunchCooperativeKernel((const void*)hybrid_fwd, dim3(grid), dim3(NTHREADS), args, LDS_BYTES, stream);
    if (e != hipSuccess) fprintf(stderr, "kernel_launch: cooperative launch failed: %s (grid %d)\n", hipGetErrorString(e), grid);
#else
    for (int p = 0; p < 11; ++p) { a.ph_lo = p; a.ph_hi = p + 1; hipLaunchKernelGGL(hybrid_fwd, dim3(grid), dim3(NTHREADS), LDS_BYTES, stream, a); }
#endif
}
```
